# Optimizing an MI355X kernel written in HIP

```python
import math
import jax, jax.numpy as jnp
from jax import lax
import numpy as np

D_MODEL = 1024
BATCH = 8
SEQ = 4096
DEPTH = 2

N_META = 16
CHUNK = 64
Q_BLOCK = 128
MIX_WIDTH = D_MODEL
LRU_WIDTH = MIX_WIDTH // 2
LRU_BLOCKS = 8
LRU_BLOCK_DIM = LRU_WIDTH // LRU_BLOCKS
LRU_CONV = 4
LRU_C = 8.0
ATT_WIDTH = MIX_WIDTH - LRU_WIDTH
DIFF_HEADS = 4
DIFF_HEAD_DIM = ATT_WIDTH // (2 * DIFF_HEADS)
V_HEAD_DIM = 2 * DIFF_HEAD_DIM
ROPE_THETA = 10000.0
D_FF = 3 * D_MODEL
FFN_CONV = 3
NORM_EPS = 1e-6
SUBLN_EPS = 1e-5
IN_WIDTH = 2 * LRU_WIDTH + 3 * ATT_WIDTH
NEG_INF = -1e30

kernel_name = "hymba_rglru_diffattn_convffn"


def rms_norm(x, g, eps=NORM_EPS):
    xf = x.astype(jnp.float32)
    y = xf * lax.rsqrt(jnp.mean(xf * xf, axis=-1, keepdims=True) + eps)
    return (y * g.astype(jnp.float32)).astype(x.dtype)


def causal_depthwise_conv(x, w, b):
    K = w.shape[0]
    T = x.shape[1]
    xp = jnp.pad(x, ((0, 0), (K - 1, 0), (0, 0)))
    y = b
    for k in range(K):
        y = y + xp[:, k:k + T, :] * w[k]
    return y


def rope_tables(T, dim):
    inv = 1.0 / (ROPE_THETA ** (jnp.arange(0, dim, 2, dtype=jnp.float32) / dim))
    ang = jnp.arange(T, dtype=jnp.float32)[:, None] * inv[None, :]
    return jnp.cos(ang), jnp.sin(ang)


def apply_rope(x, cos, sin):
    x1, x2 = jnp.split(x, 2, axis=-1)
    c = cos.astype(x.dtype)
    s = sin.astype(x.dtype)
    return jnp.concatenate([x1 * c - x2 * s, x2 * c + x1 * s], axis=-1)


def chunk_ids(T_pad, T):
    p = jnp.arange(T_pad, dtype=jnp.int32)
    cid = jnp.where(p < N_META, 0, 1 + (p - N_META) // CHUNK)
    return jnp.where(p < T, cid, jnp.iinfo(jnp.int32).max).astype(jnp.int32)


def rg_lru(x, wa, ba, wx, bx, a_param):
    B, T, _ = x.shape
    xb = x.reshape(B, T, LRU_BLOCKS, LRU_BLOCK_DIM)
    r = jax.nn.sigmoid(jnp.einsum('btnc,ncd->btnd', xb, wa) + ba).reshape(B, T, LRU_WIDTH)
    i = jax.nn.sigmoid(jnp.einsum('btnc,ncd->btnd', xb, wx) + bx).reshape(B, T, LRU_WIDTH)
    log_a = LRU_C * r.astype(jnp.float32) * jax.nn.log_sigmoid(a_param.astype(jnp.float32))
    a = jnp.exp(log_a)
    mult = jnp.sqrt(-jnp.expm1(2.0 * log_a))
    bterm = mult * (i * x).astype(jnp.float32)

    def combine(left, right):
        a1, b1 = left
        a2, b2 = right
        return a1 * a2, a2 * b1 + b2

    _, h = lax.associative_scan(combine, (a, bterm), axis=1)
    return h.astype(x.dtype)


def diff_attention(q, k, v, lam_q1, lam_k1, lam_q2, lam_k2, subln, lambda_init):
    B, T, _ = q.shape
    T_pad = -(-T // Q_BLOCK) * Q_BLOCK
    n_blk = T_pad // Q_BLOCK
    pad = T_pad - T
    q = q.reshape(B, T, DIFF_HEADS, 2, DIFF_HEAD_DIM).transpose(3, 0, 2, 1, 4)
    k = k.reshape(B, T, DIFF_HEADS, 2, DIFF_HEAD_DIM).transpose(3, 0, 2, 1, 4)
    v = v.reshape(B, T, DIFF_HEADS, V_HEAD_DIM).transpose(0, 2, 1, 3)
    cos, sin = rope_tables(T, DIFF_HEAD_DIM)
    q = apply_rope(q, cos, sin) * (DIFF_HEAD_DIM ** -0.5)
    k = apply_rope(k, cos, sin)
    q = jnp.pad(q, ((0, 0), (0, 0), (0, 0), (0, pad), (0, 0)))
    k = jnp.pad(k, ((0, 0), (0, 0), (0, 0), (0, pad), (0, 0)))
    v = jnp.pad(v, ((0, 0), (0, 0), (0, pad), (0, 0)))
    cid = chunk_ids(T_pad, T)
    lam = (jnp.exp(jnp.sum(lam_q1.astype(jnp.float32) * lam_k1.astype(jnp.float32)))
           - jnp.exp(jnp.sum(lam_q2.astype(jnp.float32) * lam_k2.astype(jnp.float32)))
           + lambda_init)
    qb = q.reshape(2, B, DIFF_HEADS, n_blk, Q_BLOCK, DIFF_HEAD_DIM).transpose(3, 0, 1, 2, 4, 5)
    cb = cid.reshape(n_blk, Q_BLOCK)

    def block(args):
        qi, ci = args
        s = jnp.einsum('mbhqd,mbhkd->mbhqk', qi, k).astype(jnp.float32)
        mask = cid[None, :] <= ci[:, None]
        s = jnp.where(mask, s, NEG_INF)
        p = jax.nn.softmax(s, axis=-1)
        w = p[0] - lam * p[1]
        return jnp.einsum('bhqk,bhke->bhqe', w.astype(v.dtype), v)

    o = lax.map(block, (qb, cb))
    o = o.transpose(1, 2, 0, 3, 4).reshape(B, DIFF_HEADS, T_pad, V_HEAD_DIM)[:, :, :T]
    o = rms_norm(o, subln, SUBLN_EPS) * (1.0 - lambda_init)
    return o.transpose(0, 2, 1, 3).reshape(B, T, ATT_WIDTH)


def setup_inputs(seed: int = 0) -> dict:
    key = jax.random.key(seed)
    ks = jax.random.split(key, 26)
    f32 = jnp.float32
    L = DEPTH

    def nrm(k, shape, scale):
        return jax.random.normal(k, shape, f32) * scale

    def gain(k, shape):
        return 1.0 + 0.02 * jax.random.normal(k, shape, f32)

    u = jax.random.uniform(ks[13], (L, LRU_WIDTH), f32, 0.9, 0.999)
    s = u ** (1.0 / LRU_C)
    a_param = jnp.log(s) - jnp.log1p(-s)
    return {
        "x": nrm(ks[0], (BATCH, SEQ, D_MODEL), 1.0),
        "meta_tokens": nrm(ks[1], (N_META, D_MODEL), 1.0),
        "ln_mix_pre": gain(ks[2], (L, D_MODEL)),
        "ln_mix_post": gain(ks[3], (L, D_MODEL)),
        "ln_ffn_pre": gain(ks[4], (L, D_MODEL)),
        "ln_ffn_post": gain(ks[5], (L, D_MODEL)),
        "w_in": nrm(ks[6], (L, D_MODEL, IN_WIDTH), D_MODEL ** -0.5),
        "lru_conv_w": nrm(ks[7], (L, LRU_CONV, LRU_WIDTH), LRU_CONV ** -0.5),
        "lru_conv_b": nrm(ks[8], (L, LRU_WIDTH), 0.01),
        "lru_wa": nrm(ks[9], (L, LRU_BLOCKS, LRU_BLOCK_DIM, LRU_BLOCK_DIM), LRU_BLOCK_DIM ** -0.5),
        "lru_ba": nrm(ks[10], (L, LRU_BLOCKS, LRU_BLOCK_DIM), 0.01),
        "lru_wx": nrm(ks[11], (L, LRU_BLOCKS, LRU_BLOCK_DIM, LRU_BLOCK_DIM), LRU_BLOCK_DIM ** -0.5),
        "lru_bx": nrm(ks[12], (L, LRU_BLOCKS, LRU_BLOCK_DIM), 0.01),
        "lru_a_param": a_param,
        "lru_out_norm": gain(ks[14], (L, LRU_WIDTH)),
        "lam_q1": nrm(ks[15], (L, DIFF_HEAD_DIM), 0.1),
        "lam_k1": nrm(ks[16], (L, DIFF_HEAD_DIM), 0.1),
        "lam_q2": nrm(ks[17], (L, DIFF_HEAD_DIM), 0.1),
        "lam_k2": nrm(ks[18], (L, DIFF_HEAD_DIM), 0.1),
        "diff_subln": gain(ks[19], (L, V_HEAD_DIM)),
        "w_out": nrm(ks[20], (L, MIX_WIDTH, D_MODEL), MIX_WIDTH ** -0.5),
        "w_up": nrm(ks[21], (L, D_MODEL, 2 * D_FF), D_MODEL ** -0.5),
        "ffn_conv_w": nrm(ks[22], (L, FFN_CONV, D_FF), FFN_CONV ** -0.5),
        "ffn_conv_b": nrm(ks[23], (L, D_FF), 0.01),
        "w_down": nrm(ks[24], (L, D_FF, D_MODEL), D_FF ** -0.5),
    }


def reference(x, meta_tokens, ln_mix_pre, ln_mix_post, ln_ffn_pre, ln_ffn_post, w_in,
              lru_conv_w, lru_conv_b, lru_wa, lru_ba, lru_wx, lru_bx, lru_a_param,
              lru_out_norm, lam_q1, lam_k1, lam_q2, lam_k2, diff_subln, w_out,
              w_up, ffn_conv_w, ffn_conv_b, w_down):
    B = x.shape[0]
    meta = jnp.broadcast_to(meta_tokens[None].astype(x.dtype), (B, N_META, D_MODEL))
    h = jnp.concatenate([meta, x], axis=1)
    splits = [LRU_WIDTH, 2 * LRU_WIDTH, 2 * LRU_WIDTH + ATT_WIDTH, 2 * LRU_WIDTH + 2 * ATT_WIDTH]
    for l in range(DEPTH):
        lambda_init = 0.8 - 0.6 * math.exp(-0.3 * l)
        u = rms_norm(h, ln_mix_pre[l])
        z = u @ w_in[l]
        xr, gr, q, k, v = jnp.split(z, splits, axis=-1)
        xr = causal_depthwise_conv(xr, lru_conv_w[l], lru_conv_b[l])
        hr = rg_lru(xr, lru_wa[l], lru_ba[l], lru_wx[l], lru_bx[l], lru_a_param[l])
        yr = rms_norm(hr * jax.nn.gelu(gr), lru_out_norm[l])
        ya = diff_attention(q, k, v, lam_q1[l], lam_k1[l], lam_q2[l], lam_k2[l],
                            diff_subln[l], lambda_init)
        y = jnp.concatenate([yr, ya], axis=-1) @ w_out[l]
        h = h + rms_norm(y, ln_mix_post[l])
        u = rms_norm(h, ln_ffn_pre[l])
        g, val = jnp.split(u @ w_up[l], 2, axis=-1)
        g = causal_depthwise_conv(g, ffn_conv_w[l], ffn_conv_b[l])
        f = (jax.nn.gelu(g) * val) @ w_down[l]
        h = h + rms_norm(f, ln_ffn_post[l])
    return h[:, N_META:]
```

```cpp
#include <hip/hip_runtime.h>
#include <cstdint>
#include <cstdio>

typedef unsigned short bf16_t;
typedef short bf16x8 __attribute__((ext_vector_type(8)));
typedef float f32x4 __attribute__((ext_vector_type(4)));
typedef unsigned u32x2 __attribute__((ext_vector_type(2)));
typedef unsigned u32x4 __attribute__((ext_vector_type(4)));

constexpr int DM = 1024, NBATCH = 8, SEQ = 4096, NMETA = 16, TT = SEQ + NMETA, DEPTH = 2;
constexpr int MR = NBATCH * SEQ;
constexpr int LRUW = 512, NH = 4, DFF = 3072, INW = 2560;
constexpr int NT = 512;

constexpr size_t MiB = 1u << 20;
constexpr size_t WS_W = 2 * MiB, W_LAYER = 25 * MiB;
constexpr size_t OFF_WIN = 0, OFF_WOUT = 5 * MiB, OFF_WUP = 7 * MiB, OFF_WDN = 19 * MiB;
constexpr size_t WS_ROPEC = 52 * MiB, WS_ROPES = 53 * MiB;
constexpr size_t WS_META = 54 * MiB;
constexpr size_t M_H = 0, M_U = 64 << 10, M_ZB = 128 << 10, M_T1 = 256 << 10, M_YC = 320 << 10, M_Y = 384 << 10, M_GV = 512 << 10, M_HID = 768 << 10;
constexpr size_t WS_U = 64 * MiB, WS_YC = 128 * MiB, WS_ZB = 192 * MiB, WS_T1 = 352 * MiB, WS_Y1 = 384 * MiB;
constexpr size_t WS_GV = 128 * MiB, WS_HID = 320 * MiB, WS_Y2 = 128 * MiB, WS_END = 512 * MiB;

struct P { const float* in[25]; float* out; unsigned char* ws; };

__device__ __forceinline__ float bf2f(bf16_t v) { return __uint_as_float((unsigned)v << 16); }
__device__ __forceinline__ unsigned f2bf(float f) { unsigned u = __float_as_uint(f); return (u + 0x7fffu + ((u >> 16) & 1u)) >> 16; }
__device__ __forceinline__ unsigned pk2(float lo, float hi) { return f2bf(lo) | (f2bf(hi) << 16); }
__device__ __forceinline__ float wave_sum(float v) {
#pragma unroll
    for (int o = 1; o < 64; o <<= 1) v += __shfl_xor(v, o);
    return v;
}
__device__ __forceinline__ float wave_max(float v) {
#pragma unroll
    for (int o = 1; o < 64; o <<= 1) v = fmaxf(v, __shfl_xor(v, o));
    return v;
}
__device__ __forceinline__ void wsync() { asm volatile("s_waitcnt lgkmcnt(0)" ::: "memory"); }
__device__ __forceinline__ float gelu_tanh(float x) { return 0.5f * x * (1.f + tanhf(0.7978845608028654f * (x + 0.044715f * x * x * x))); }
__device__ __forceinline__ float lambda_init_of(int l) { return l == 0 ? 0.2f : (0.8f - 0.6f * 0.7408182206817179f); }

__device__ __forceinline__ void transpose_item(const float* W, int K, int N, bf16_t* WT, float* scr, int item, int lane) {
    const int nblk = N / 32, kb = item / nblk, nb = item % nblk, k0 = 64 * kb, n0 = 32 * nb;
#pragma unroll 8
    for (int i = 0; i < 32; ++i) { const int kk = 2 * i + (lane >> 5); scr[kk * 33 + (lane & 31)] = W[(size_t)(k0 + kk) * N + n0 + (lane & 31)]; }
    wsync();
    const int c = lane & 7;
#pragma unroll
    for (int j = 0; j < 4; ++j) { const int n = (lane >> 3) + 8 * j; const float* s = scr + (8 * c) * 33 + n;
        u32x4 o; o.x = pk2(s[0 * 33], s[1 * 33]); o.y = pk2(s[2 * 33], s[3 * 33]); o.z = pk2(s[4 * 33], s[5 * 33]); o.w = pk2(s[6 * 33], s[7 * 33]);
        *(u32x4*)(WT + (size_t)(n0 + n) * K + k0 + 8 * c) = o; }
    wsync();
}
__device__ __forceinline__ void rms_row_to_bf16(const float* xrow, const float* gain, bf16_t* orow, int lane) {
    f32x4 v[4]; float s = 0.f;
#pragma unroll
    for (int j = 0; j < 4; ++j) { v[j] = *(const f32x4*)(xrow + 4 * lane + 256 * j); s += (v[j].x * v[j].x + v[j].y * v[j].y) + (v[j].z * v[j].z + v[j].w * v[j].w); }
    const float r = rsqrtf(wave_sum(s) * (1.f / DM) + 1e-6f);
#pragma unroll
    for (int j = 0; j < 4; ++j) { const f32x4 g = *(const f32x4*)(gain + 4 * lane + 256 * j);
        u32x2 o; o.x = pk2(v[j].x * r * g.x, v[j].y * r * g.y); o.y = pk2(v[j].z * r * g.z, v[j].w * r * g.w);
        *(u32x2*)(orow + 4 * lane + 256 * j) = o; }
}
__global__ void __launch_bounds__(NT) k_prologue(P p) {
    __shared__ float scr_all[8 * 64 * 33];
    const int tid = threadIdx.x, lane = tid & 63, wave = tid >> 6;
    const int gw = blockIdx.x * 8 + wave, ngw = gridDim.x * 8;
    float* scr = scr_all + wave * 64 * 33;
    constexpr int I_IN = 16 * 80, I_OUT = 16 * 32, I_UP = 16 * 192, I_DN = 48 * 32, I_L = I_IN + I_OUT + I_UP + I_DN;
    for (int it = gw; it < DEPTH * I_L; it += ngw) {
        const int l = it / I_L; int r = it % I_L; unsigned char* wb = p.ws + WS_W + l * W_LAYER;
        if (r < I_IN) { transpose_item(p.in[6] + (size_t)l * DM * INW, DM, INW, (bf16_t*)(wb + OFF_WIN), scr, r, lane); continue; } r -= I_IN;
        if (r < I_OUT) { transpose_item(p.in[20] + (size_t)l * DM * DM, DM, DM, (bf16_t*)(wb + OFF_WOUT), scr, r, lane); continue; } r -= I_OUT;
        if (r < I_UP) { transpose_item(p.in[21] + (size_t)l * DM * 2 * DFF, DM, 2 * DFF, (bf16_t*)(wb + OFF_WUP), scr, r, lane); continue; } r -= I_UP;
        transpose_item(p.in[24] + (size_t)l * DFF * DM, DFF, DM, (bf16_t*)(wb + OFF_WDN), scr, r, lane);
    }
    float* rc = (float*)(p.ws + WS_ROPEC); float* rs = (float*)(p.ws + WS_ROPES);
    for (int i = blockIdx.x * NT + tid; i < TT * 32; i += gridDim.x * NT) {
        const int t = i >> 5, f = i & 31;
        const double inv = exp(-(double)f / 32.0 * log(10000.0));
        const double ang = (double)t * inv;
        rc[i] = (float)cos(ang); rs[i] = (float)sin(ang);
    }
    bf16_t* U = (bf16_t*)(p.ws + WS_U);
    for (int m = gw; m < MR; m += ngw) rms_row_to_bf16(p.in[0] + (size_t)m * DM, p.in[2], U + (size_t)m * DM, lane);
    float* Hm = (float*)(p.ws + WS_META + M_H); bf16_t* Um = (bf16_t*)(p.ws + WS_META + M_U);
    for (int m = gw; m < NMETA; m += ngw) {
        rms_row_to_bf16(p.in[1] + (size_t)m * DM, p.in[2], Um + (size_t)m * DM, lane);
        for (int j = 0; j < 4; ++j) *(f32x4*)(Hm + (size_t)m * DM + 4 * lane + 256 * j) = *(const f32x4*)(p.in[1] + (size_t)m * DM + 4 * lane + 256 * j);
    }
}

template <int MT, class Epi>
__device__ __forceinline__ void gemm_naive(const bf16_t* A, const bf16_t* Bt, int M, int N, int K, const Epi& epi, int gw, int ngw, int lane) {
    const int fr = lane & 15, fq = lane >> 4;
    const int tilesM = M / (16 * MT), tilesN = N / 64;
    for (int tile = gw; tile < tilesM * tilesN; tile += ngw) {
        const int tm = tile / tilesN, tn = tile % tilesN;
        f32x4 acc[MT][4];
#pragma unroll
        for (int m = 0; m < MT; ++m)
#pragma unroll
            for (int n = 0; n < 4; ++n) acc[m][n] = (f32x4){0.f, 0.f, 0.f, 0.f};
        const bf16_t* Ap = A + (size_t)(tm * 16 * MT + fr) * K + fq * 8;
        const bf16_t* Bp = Bt + (size_t)(tn * 64 + fr) * K + fq * 8;
        for (int k = 0; k < K; k += 32) {
            bf16x8 a[MT], b[4];
#pragma unroll
            for (int m = 0; m < MT; ++m) a[m] = *(const bf16x8*)(Ap + (size_t)m * 16 * K + k);
#pragma unroll
            for (int n = 0; n < 4; ++n) b[n] = *(const bf16x8*)(Bp + (size_t)n * 16 * K + k);
#pragma unroll
            for (int m = 0; m < MT; ++m)
#pragma unroll
                for (int n = 0; n < 4; ++n) acc[m][n] = __builtin_amdgcn_mfma_f32_16x16x32_bf16(b[n], a[m], acc[m][n], 0, 0, 0);
        }
        epi.template run<MT>(acc, tm * 16 * MT, tn * 64, fr, fq);
    }
}
struct EpiF32 {
    float* C; int ldc, pad;
    template <int MT> __device__ __forceinline__ void run(const f32x4 (&acc)[MT][4], int row0, int col0, int fr, int fq) const {
#pragma unroll
        for (int m = 0; m < MT; ++m)
#pragma unroll
            for (int n = 0; n < 4; ++n) *(f32x4*)(C + (size_t)(row0 + 16 * m + fr) * ldc + col0 + 16 * n + 4 * fq) = acc[m][n];
    }
};
struct EpiBf16 {
    bf16_t* C; int ldc, pad;
    template <int MT> __device__ __forceinline__ void run(const f32x4 (&acc)[MT][4], int row0, int col0, int fr, int fq) const {
#pragma unroll
        for (int m = 0; m < MT; ++m)
#pragma unroll
            for (int n = 0; n < 4; ++n) { u32x2 o; o.x = pk2(acc[m][n][0], acc[m][n][1]); o.y = pk2(acc[m][n][2], acc[m][n][3]);
                *(u32x2*)(C + (size_t)(row0 + 16 * m + fr) * ldc + col0 + 16 * n + 4 * fq) = o; }
    }
};
struct EpiWin {
    bf16_t* Z; const float* rc; const float* rs; int meta, pad;
    template <int MT> __device__ __forceinline__ void run(const f32x4 (&acc)[MT][4], int row0, int col0, int fr, int fq) const {
        const bool qk = col0 >= 1024 && col0 < 2048; const float sc = (col0 < 1536) ? 0.125f : 1.f;
#pragma unroll
        for (int m = 0; m < MT; ++m) {
            const int row = row0 + 16 * m + fr; const int t = meta ? row : 16 + (row & (SEQ - 1));
            f32x4 v[4];
#pragma unroll
            for (int n = 0; n < 4; ++n) v[n] = acc[m][n];
            if (qk) {
#pragma unroll
                for (int n = 0; n < 2; ++n) { const f32x4 c = *(const f32x4*)(rc + t * 32 + 16 * n + 4 * fq), s = *(const f32x4*)(rs + t * 32 + 16 * n + 4 * fq);
                    const f32x4 x1 = acc[m][n], x2 = acc[m][n + 2];
                    v[n] = (x1 * c - x2 * s) * sc; v[n + 2] = (x2 * c + x1 * s) * sc; }
            }
#pragma unroll
            for (int n = 0; n < 4; ++n) { u32x2 o; o.x = pk2(v[n][0], v[n][1]); o.y = pk2(v[n][2], v[n][3]);
                *(u32x2*)(Z + (size_t)row * INW + col0 + 16 * n + 4 * fq) = o; }
        }
    }
};
template <int MT, class Epi>
__global__ void __launch_bounds__(NT) k_gemm(const bf16_t* A, const bf16_t* Bt, int M, int N, int K, int pad, Epi epi) {
    const int lane = threadIdx.x & 63, wave = threadIdx.x >> 6;
    gemm_naive<MT, Epi>(A, Bt, M, N, K, epi, blockIdx.x * 8 + wave, gridDim.x * 8, lane);
}

__global__ void __launch_bounds__(NT) k_lru(P p, int l, int pad) {
    __shared__ float xs_all[8 * 64];
    const int lane = threadIdx.x & 63, wave = threadIdx.x >> 6, u = blockIdx.x * 8 + wave;
    if (u >= 64) return;
    float* xs = xs_all + wave * 64;
    const int b = u >> 3, n = u & 7, ch = n * 64 + lane;
    const bf16_t* ZB = (const bf16_t*)(p.ws + WS_ZB); const bf16_t* ZBm = (const bf16_t*)(p.ws + WS_META + M_ZB);
    float* T1 = (float*)(p.ws + WS_T1); float* T1m = (float*)(p.ws + WS_META + M_T1);
    float wa[64], wx[64];
#pragma unroll
    for (int i = 0; i < 64; ++i) { wa[i] = p.in[9][((size_t)(l * 8 + n) * 64 + i) * 64 + lane]; wx[i] = p.in[11][((size_t)(l * 8 + n) * 64 + i) * 64 + lane]; }
    const float ba = p.in[10][(l * 8 + n) * 64 + lane], bx = p.in[12][(l * 8 + n) * 64 + lane];
    const float cw0 = p.in[7][(l * 4 + 0) * LRUW + ch], cw1 = p.in[7][(l * 4 + 1) * LRUW + ch], cw2 = p.in[7][(l * 4 + 2) * LRUW + ch], cw3 = p.in[7][(l * 4 + 3) * LRUW + ch];
    const float cb = p.in[8][l * LRUW + ch];
    const float ap = p.in[13][l * LRUW + ch];
    const float la8 = -8.f * log1pf(expf(-ap));
    float h = 0.f, x1 = 0.f, x2 = 0.f, x3 = 0.f;
    for (int t = 0; t < TT; ++t) {
        const bf16_t* zrow = t < NMETA ? ZBm + (size_t)t * INW : ZB + ((size_t)b * SEQ + (t - NMETA)) * INW;
        const float xr = bf2f(zrow[ch]), gr = bf2f(zrow[LRUW + ch]);
        const float xc = cb + cw0 * x3 + cw1 * x2 + cw2 * x1 + cw3 * xr; x3 = x2; x2 = x1; x1 = xr;
        xs[lane] = xc; wsync();
        float rp = ba, ip = bx;
#pragma unroll
        for (int i = 0; i < 64; i += 4) { const f32x4 xv = *(const f32x4*)(xs + i);
            rp += xv.x * wa[i] + xv.y * wa[i + 1] + xv.z * wa[i + 2] + xv.w * wa[i + 3];
            ip += xv.x * wx[i] + xv.y * wx[i + 1] + xv.z * wx[i + 2] + xv.w * wx[i + 3]; }
        wsync();
        const float r = 1.f / (1.f + expf(-rp)), ig = 1.f / (1.f + expf(-ip));
        const float la = la8 * r, a = expf(la), mult = sqrtf(fmaxf(-expm1f(2.f * la), 0.f));
        h = a * h + mult * (ig * xc);
        const float o = h * gelu_tanh(gr);
        if (t < NMETA) { if (b == 0) T1m[t * LRUW + ch] = o; } else T1[((size_t)b * SEQ + (t - NMETA)) * LRUW + ch] = o;
    }
}
__global__ void __launch_bounds__(NT) k_lrunorm(P p, int l, int pad) {
    const int lane = threadIdx.x & 63, wave = threadIdx.x >> 6, gw = blockIdx.x * 8 + wave, ngw = gridDim.x * 8;
    const float* g = p.in[14] + l * LRUW;
    for (int m = gw; m < MR + NMETA; m += ngw) {
        const float* src = m < MR ? (const float*)(p.ws + WS_T1) + (size_t)m * LRUW : (const float*)(p.ws + WS_META + M_T1) + (size_t)(m - MR) * LRUW;
        bf16_t* dst = m < MR ? (bf16_t*)(p.ws + WS_YC) + (size_t)m * DM : (bf16_t*)(p.ws + WS_META + M_YC) + (size_t)(m - MR) * DM;
        f32x4 v[2]; float s = 0.f;
#pragma unroll
        for (int j = 0; j < 2; ++j) { v[j] = *(const f32x4*)(src + 4 * lane + 256 * j); s += (v[j].x * v[j].x + v[j].y * v[j].y) + (v[j].z * v[j].z + v[j].w * v[j].w); }
        const float r = rsqrtf(wave_sum(s) * (1.f / LRUW) + 1e-6f);
#pragma unroll
        for (int j = 0; j < 2; ++j) { const f32x4 gg = *(const f32x4*)(g + 4 * lane + 256 * j);
            u32x2 o; o.x = pk2(v[j].x * r * gg.x, v[j].y * r * gg.y); o.y = pk2(v[j].z * r * gg.z, v[j].w * r * gg.w);
            *(u32x2*)(dst + 4 * lane + 256 * j) = o; }
    }
}

__device__ __forceinline__ void score2(const bf16_t* krow, const float* sm, float& s1, float& s2) {
    float a = 0.f, b = 0.f;
#pragma unroll
    for (int d = 0; d < 64; d += 8) {
        const bf16x8 k1 = *(const bf16x8*)(krow + d), k2 = *(const bf16x8*)(krow + 64 + d);
        const f32x4 qa = *(const f32x4*)(sm + d), qb = *(const f32x4*)(sm + d + 4), qc = *(const f32x4*)(sm + 64 + d), qd = *(const f32x4*)(sm + 64 + d + 4);
        a += qa.x * bf2f((bf16_t)k1[0]) + qa.y * bf2f((bf16_t)k1[1]) + qa.z * bf2f((bf16_t)k1[2]) + qa.w * bf2f((bf16_t)k1[3])
           + qb.x * bf2f((bf16_t)k1[4]) + qb.y * bf2f((bf16_t)k1[5]) + qb.z * bf2f((bf16_t)k1[6]) + qb.w * bf2f((bf16_t)k1[7]);
        b += qc.x * bf2f((bf16_t)k2[0]) + qc.y * bf2f((bf16_t)k2[1]) + qc.z * bf2f((bf16_t)k2[2]) + qc.w * bf2f((bf16_t)k2[3])
           + qd.x * bf2f((bf16_t)k2[4]) + qd.y * bf2f((bf16_t)k2[5]) + qd.z * bf2f((bf16_t)k2[6]) + qd.w * bf2f((bf16_t)k2[7]);
    }
    s1 = a; s2 = b;
}
__global__ void __launch_bounds__(NT) k_attn(P p, int l, int pad) {
    __shared__ float sm_all[8 * 192];
    const int lane = threadIdx.x & 63, wave = threadIdx.x >> 6, gw = blockIdx.x * 8 + wave, ngw = gridDim.x * 8;
    float* sm = sm_all + wave * 192;
    const bf16_t* ZB = (const bf16_t*)(p.ws + WS_ZB); const bf16_t* ZBm = (const bf16_t*)(p.ws + WS_META + M_ZB);
    bf16_t* YC = (bf16_t*)(p.ws + WS_YC); bf16_t* YCm = (bf16_t*)(p.ws + WS_META + M_YC);
    const float li = lambda_init_of(l);
    const float lam = expf(wave_sum(p.in[15][l * 64 + lane] * p.in[16][l * 64 + lane])) - expf(wave_sum(p.in[17][l * 64 + lane] * p.in[18][l * 64 + lane])) + li;
    const float g0 = p.in[19][l * 128 + lane] * (1.f - li), g1 = p.in[19][l * 128 + 64 + lane] * (1.f - li);
    constexpr int NQR = NBATCH * NH * SEQ, NQ = NQR + NH * NMETA;
    for (int qi = gw; qi < NQ; qi += ngw) {
        int b, h, t;
        if (qi < NQR) { b = qi / (NH * SEQ); h = (qi / SEQ) % NH; t = NMETA + qi % SEQ; } else { const int m = qi - NQR; b = 0; h = m / NMETA; t = m % NMETA; }
        const bf16_t* qrow = (t < NMETA ? ZBm + (size_t)t * INW : ZB + ((size_t)b * SEQ + (t - NMETA)) * INW) + 1024 + h * 128;
        sm[lane] = bf2f(qrow[lane]); sm[64 + lane] = bf2f(qrow[64 + lane]);
        wsync();
        const int nch = t < NMETA ? 0 : (t - NMETA) / 64 + 1;
        const bf16_t* kmeta = ZBm + 1536 + h * 128; const bf16_t* kreal = ZB + (size_t)b * SEQ * INW + 1536 + h * 128;
        float m1 = -1e30f, l1 = 0.f, m2 = -1e30f, l2 = 0.f;
        for (int c = -1; c < nch; ++c) {
            const bool valid = c >= 0 || lane < NMETA;
            if (valid) {
                const bf16_t* krow = c < 0 ? kmeta + (size_t)lane * INW : kreal + (size_t)(c * 64 + lane) * INW;
                float s1, s2; score2(krow, sm, s1, s2);
                float mn = fmaxf(m1, s1); l1 = l1 * expf(m1 - mn) + expf(s1 - mn); m1 = mn;
                mn = fmaxf(m2, s2); l2 = l2 * expf(m2 - mn) + expf(s2 - mn); m2 = mn;
            }
        }
        const float M1 = wave_max(m1), M2 = wave_max(m2);
        const float L1 = wave_sum(l1 * expf(m1 - M1)), L2 = wave_sum(l2 * expf(m2 - M2));
        const float i1 = 1.f / L1, i2 = lam / L2;
        float acc0 = 0.f, acc1 = 0.f;
        for (int c = -1; c < nch; ++c) {
            const bool valid = c >= 0 || lane < NMETA;
            float w = 0.f;
            if (valid) {
                const bf16_t* krow = c < 0 ? kmeta + (size_t)lane * INW : kreal + (size_t)(c * 64 + lane) * INW;
                float s1, s2; score2(krow, sm, s1, s2);
                w = expf(s1 - M1) * i1 - expf(s2 - M2) * i2;
            }
            sm[128 + lane] = w; wsync();
            const int nk = c < 0 ? NMETA : 64;
            const bf16_t* vbase = (c < 0 ? kmeta : kreal + (size_t)(c * 64) * INW) + 512;
            for (int j = 0; j < nk; ++j) { const float wj = sm[128 + j]; const bf16_t* vr = vbase + (size_t)j * INW;
                acc0 += wj * bf2f(vr[lane]); acc1 += wj * bf2f(vr[64 + lane]); }
            wsync();
        }
        const float ss = wave_sum(acc0 * acc0 + acc1 * acc1);
        const float r = rsqrtf(ss * (1.f / 128.f) + 1e-5f);
        bf16_t* orow = (t < NMETA ? YCm + (size_t)t * DM : YC + ((size_t)b * SEQ + (t - NMETA)) * DM) + 512 + h * 128;
        orow[lane] = (bf16_t)f2bf(acc0 * r * g0); orow[64 + lane] = (bf16_t)f2bf(acc1 * r * g1);
        wsync();
    }
}

__global__ void __launch_bounds__(NT) k_normres(const float* Y, const float* Ym, const float* base, float* out, float* Hm, const float* Hm_base, const float* gpost, const float* gnext, bf16_t* U, bf16_t* Um) {
    const int lane = threadIdx.x & 63, wave = threadIdx.x >> 6, gw = blockIdx.x * 8 + wave, ngw = gridDim.x * 8;
    for (int m = gw; m < MR + NMETA; m += ngw) {
        const bool meta = m >= MR; const int r_ = meta ? m - MR : m;
        const float* y = (meta ? Ym : Y) + (size_t)r_ * DM; const float* bs = (meta ? Hm_base : base) + (size_t)r_ * DM; float* o = (meta ? Hm : out) + (size_t)r_ * DM;
        f32x4 v[4]; float s = 0.f;
#pragma unroll
        for (int j = 0; j < 4; ++j) { v[j] = *(const f32x4*)(y + 4 * lane + 256 * j); s += (v[j].x * v[j].x + v[j].y * v[j].y) + (v[j].z * v[j].z + v[j].w * v[j].w); }
        const float r = rsqrtf(wave_sum(s) * (1.f / DM) + 1e-6f);
        float s2 = 0.f;
#pragma unroll
        for (int j = 0; j < 4; ++j) { const f32x4 g = *(const f32x4*)(gpost + 4 * lane + 256 * j), bb = *(const f32x4*)(bs + 4 * lane + 256 * j);
            v[j] = bb + v[j] * r * g; *(f32x4*)(o + 4 * lane + 256 * j) = v[j];
            s2 += (v[j].x * v[j].x + v[j].y * v[j].y) + (v[j].z * v[j].z + v[j].w * v[j].w); }
        if (gnext) {
            const float r2 = rsqrtf(wave_sum(s2) * (1.f / DM) + 1e-6f);
            bf16_t* u = (meta ? Um : U) + (size_t)r_ * DM;
#pragma unroll
            for (int j = 0; j < 4; ++j) { const f32x4 g = *(const f32x4*)(gnext + 4 * lane + 256 * j);
                u32x2 w; w.x = pk2(v[j].x * r2 * g.x, v[j].y * r2 * g.y); w.y = pk2(v[j].z * r2 * g.z, v[j].w * r2 * g.w);
                *(u32x2*)(u + 4 * lane + 256 * j) = w; }
        }
    }
}

__global__ void __launch_bounds__(NT) k_ffnconv(P p, int l, int row_lo, int nrows, int do_meta) {
    const bf16_t* GV = (const bf16_t*)(p.ws + WS_GV); const bf16_t* GVm = (const bf16_t*)(p.ws + WS_META + M_GV);
    bf16_t* HID = (bf16_t*)(p.ws + WS_HID); bf16_t* HIDm = (bf16_t*)(p.ws + WS_META + M_HID);
    const float* cw = p.in[22] + (size_t)l * 3 * DFF; const float* cb = p.in[23] + (size_t)l * DFF;
    const int total = (nrows + (do_meta ? NMETA : 0)) * (DFF / 4);
    for (int i = blockIdx.x * NT + threadIdx.x; i < total; i += gridDim.x * NT) {
        const int rr = i / (DFF / 4), c = (i % (DFF / 4)) * 4;
        const bool meta = rr >= nrows; const int row = meta ? rr - nrows : row_lo + rr;
        const bf16_t* g0; const bf16_t* g1 = nullptr; const bf16_t* g2 = nullptr;
        if (meta) { g0 = GVm + (size_t)row * 2 * DFF; if (row >= 1) g1 = g0 - 2 * DFF; if (row >= 2) g2 = g0 - 4 * DFF; }
        else { const int tt = row & (SEQ - 1); g0 = GV + (size_t)rr * 2 * DFF;
            g1 = tt >= 1 ? g0 - 2 * DFF : GVm + (size_t)15 * 2 * DFF;
            g2 = tt >= 2 ? g0 - 4 * DFF : GVm + (size_t)(14 + tt) * 2 * DFF; }
        float o[4];
#pragma unroll
        for (int j = 0; j < 4; ++j) {
            float x = cb[c + j] + cw[2 * DFF + c + j] * bf2f(g0[c + j]);
            if (g1) x += cw[DFF + c + j] * bf2f(g1[c + j]);
            if (g2) x += cw[c + j] * bf2f(g2[c + j]);
            o[j] = gelu_tanh(x) * bf2f(g0[DFF + c + j]);
        }
        u32x2 w; w.x = pk2(o[0], o[1]); w.y = pk2(o[2], o[3]);
        *(u32x2*)((meta ? HIDm + (size_t)row * DFF : HID + (size_t)row * DFF) + c) = w;
    }
}

extern "C" void kernel_launch(void* const* d_in, const int* in_sizes, int n_in, void* d_out, int out_size, void* d_ws, size_t ws_size, hipStream_t stream) {
    if (n_in != 25 || ws_size < WS_END) { fprintf(stderr, "kernel_launch: unexpected n_in %d or ws_size %zu\n", n_in, ws_size); return; }
    P p{};
    for (int i = 0; i < 25; ++i) p.in[i] = (const float*)d_in[i];
    p.out = (float*)d_out; p.ws = (unsigned char*)d_ws;
    unsigned char* ws = p.ws;
    const int G = 512;
    k_prologue<<<G, NT, 0, stream>>>(p);
    bf16_t* U = (bf16_t*)(ws + WS_U); bf16_t* Um = (bf16_t*)(ws + WS_META + M_U);
    bf16_t* YC = (bf16_t*)(ws + WS_YC); bf16_t* YCm = (bf16_t*)(ws + WS_META + M_YC);
    float* Hm = (float*)(ws + WS_META + M_H); float* Ym = (float*)(ws + WS_META + M_Y);
    const float* rc = (const float*)(ws + WS_ROPEC); const float* rs = (const float*)(ws + WS_ROPES);
    for (int l = 0; l < DEPTH; ++l) {
        unsigned char* wb = ws + WS_W + l * W_LAYER;
        const bf16_t* Win = (const bf16_t*)(wb + OFF_WIN); const bf16_t* Wout = (const bf16_t*)(wb + OFF_WOUT); const bf16_t* Wup = (const bf16_t*)(wb + OFF_WUP); const bf16_t* Wdn = (const bf16_t*)(wb + OFF_WDN);
        k_gemm<4, EpiWin><<<2048, NT, 0, stream>>>(U, Win, MR, INW, DM, 0, EpiWin{(bf16_t*)(ws + WS_ZB), rc, rs, 0});
        k_gemm<1, EpiWin><<<8, NT, 0, stream>>>(Um, Win, NMETA, INW, DM, 0, EpiWin{(bf16_t*)(ws + WS_META + M_ZB), rc, rs, 1});
        k_lru<<<8, NT, 0, stream>>>(p, l, 0);
        k_lrunorm<<<1024, NT, 0, stream>>>(p, l, 0);
        k_attn<<<2048, NT, 0, stream>>>(p, l, 0);
        k_gemm<4, EpiF32><<<2048, NT, 0, stream>>>(YC, Wout, MR, DM, DM, 0, EpiF32{(float*)(ws + WS_Y1), DM});
        k_gemm<1, EpiF32><<<2, NT, 0, stream>>>(YCm, Wout, NMETA, DM, DM, 0, EpiF32{Ym, DM});
        k_normres<<<1024, NT, 0, stream>>>((const float*)(ws + WS_Y1), Ym, l == 0 ? p.in[0] : p.out, p.out, Hm, l == 0 ? p.in[1] : Hm,
                                           p.in[3] + l * DM, p.in[4] + l * DM, U, Um);
        k_gemm<1, EpiBf16><<<12, NT, 0, stream>>>(Um, Wup, NMETA, 2 * DFF, DM, 0, EpiBf16{(bf16_t*)(ws + WS_META + M_GV), 2 * DFF});
        for (int hf = 0; hf < 2; ++hf) {
            k_gemm<4, EpiBf16><<<2048, NT, 0, stream>>>(U + (size_t)hf * (MR / 2) * DM, Wup, MR / 2, 2 * DFF, DM, 0, EpiBf16{(bf16_t*)(ws + WS_GV), 2 * DFF});
            k_ffnconv<<<2048, NT, 0, stream>>>(p, l, hf * (MR / 2), MR / 2, hf == 0);
        }
        k_gemm<4, EpiF32><<<2048, NT, 0, stream>>>((const bf16_t*)(ws + WS_HID), Wdn, MR, DM, DFF, 0, EpiF32{(float*)(ws + WS_Y2), DM});
        k_gemm<1, EpiF32><<<2, NT, 0, stream>>>((const bf16_t*)(ws + WS_META + M_HID), Wdn, NMETA, DM, DFF, 0, EpiF32{Ym, DM});
        k_normres<<<1024, NT, 0, stream>>>((const float*)(ws + WS_Y2), Ym, p.out, p.out, Hm, Hm, p.in[5] + l * DM, l + 1 < DEPTH ? p.in[2] + (l + 1) * DM : nullptr, U, Um);
    }
}
```

```cpp
#include <hip/hip_runtime.h>
#include <cstdint>
#include <cstdio>

typedef unsigned short bf16_t;
typedef short bf16x8 __attribute__((ext_vector_type(8)));
typedef float f32x4 __attribute__((ext_vector_type(4)));
typedef unsigned u32x2 __attribute__((ext_vector_type(2)));
typedef unsigned u32x4 __attribute__((ext_vector_type(4)));

constexpr int DM = 1024, NBATCH = 8, SEQ = 4096, NMETA = 16, TT = SEQ + NMETA, DEPTH = 2;
constexpr int MR = NBATCH * SEQ;
constexpr int LRUW = 512, NH = 4, DFF = 3072, INW = 2560;
constexpr int NT = 512;

constexpr size_t MiB = 1u << 20;
constexpr size_t WS_W = 2 * MiB, W_LAYER = 25 * MiB;
constexpr size_t OFF_WIN = 0, OFF_WOUT = 5 * MiB, OFF_WUP = 7 * MiB, OFF_WDN = 19 * MiB;
constexpr size_t WS_ROPEC = 52 * MiB, WS_ROPES = 53 * MiB;
constexpr size_t WS_META = 54 * MiB;
constexpr size_t M_H = 0, M_U = 64 << 10, M_ZB = 128 << 10, M_T1 = 256 << 10, M_YC = 320 << 10, M_Y = 384 << 10, M_GV = 512 << 10, M_HID = 768 << 10;
constexpr size_t WS_U = 64 * MiB, WS_YC = 128 * MiB, WS_ZB = 192 * MiB, WS_T1 = 352 * MiB, WS_Y1 = 384 * MiB;
constexpr size_t WS_GV = 128 * MiB, WS_HID = 320 * MiB, WS_Y2 = 128 * MiB, WS_END = 512 * MiB;

struct P { const float* in[25]; float* out; unsigned char* ws; };

__device__ __forceinline__ float bf2f(bf16_t v) { return __uint_as_float((unsigned)v << 16); }
__device__ __forceinline__ unsigned f2bf(float f) { unsigned u = __float_as_uint(f); return (u + 0x7fffu + ((u >> 16) & 1u)) >> 16; }
__device__ __forceinline__ unsigned pk2(float lo, float hi) { return f2bf(lo) | (f2bf(hi) << 16); }
__device__ __forceinline__ float wave_sum(float v) {
#pragma unroll
    for (int o = 1; o < 64; o <<= 1) v += __shfl_xor(v, o);
    return v;
}
__device__ __forceinline__ float wave_max(float v) {
#pragma unroll
    for (int o = 1; o < 64; o <<= 1) v = fmaxf(v, __shfl_xor(v, o));
    return v;
}
__device__ __forceinline__ void wsync() { asm volatile("s_waitcnt lgkmcnt(0)" ::: "memory"); }
__device__ __forceinline__ float gelu_tanh(float x) { return 0.5f * x * (1.f + tanhf(0.7978845608028654f * (x + 0.044715f * x * x * x))); }
__device__ __forceinline__ float lambda_init_of(int l) { return l == 0 ? 0.2f : (0.8f - 0.6f * 0.7408182206817179f); }

__device__ __forceinline__ void transpose_item(const float* W, int K, int N, bf16_t* WT, float* scr, int item, int lane) {
    const int nblk = N / 32, kb = item / nblk, nb = item % nblk, k0 = 64 * kb, n0 = 32 * nb;
#pragma unroll 8
    for (int i = 0; i < 32; ++i) { const int kk = 2 * i + (lane >> 5); scr[kk * 33 + (lane & 31)] = W[(size_t)(k0 + kk) * N + n0 + (lane & 31)]; }
    wsync();
    const int c = lane & 7;
#pragma unroll
    for (int j = 0; j < 4; ++j) { const int n = (lane >> 3) + 8 * j; const float* s = scr + (8 * c) * 33 + n;
        u32x4 o; o.x = pk2(s[0 * 33], s[1 * 33]); o.y = pk2(s[2 * 33], s[3 * 33]); o.z = pk2(s[4 * 33], s[5 * 33]); o.w = pk2(s[6 * 33], s[7 * 33]);
        *(u32x4*)(WT + (size_t)(n0 + n) * K + k0 + 8 * c) = o; }
    wsync();
}
__device__ __forceinline__ void rms_row_to_bf16(const float* xrow, const float* gain, bf16_t* orow, int lane) {
    f32x4 v[4]; float s = 0.f;
#pragma unroll
    for (int j = 0; j < 4; ++j) { v[j] = *(const f32x4*)(xrow + 4 * lane + 256 * j); s += (v[j].x * v[j].x + v[j].y * v[j].y) + (v[j].z * v[j].z + v[j].w * v[j].w); }
    const float r = rsqrtf(wave_sum(s) * (1.f / DM) + 1e-6f);
#pragma unroll
    for (int j = 0; j < 4; ++j) { const f32x4 g = *(const f32x4*)(gain + 4 * lane + 256 * j);
        u32x2 o; o.x = pk2(v[j].x * r * g.x, v[j].y * r * g.y); o.y = pk2(v[j].z * r * g.z, v[j].w * r * g.w);
        *(u32x2*)(orow + 4 * lane + 256 * j) = o; }
}
__device__ __forceinline__ void ph_prologue(const P& p, unsigned char* lds) {
    float* scr_all = (float*)lds;
    const int tid = threadIdx.x, lane = tid & 63, wave = tid >> 6;
    const int gw = blockIdx.x * 8 + wave, ngw = gridDim.x * 8;
    float* scr = scr_all + wave * 64 * 33;
    constexpr int I_IN = 16 * 80, I_OUT = 16 * 32, I_UP = 16 * 192, I_DN = 48 * 32, I_L = I_IN + I_OUT + I_UP + I_DN;
    for (int it = gw; it < DEPTH * I_L; it += ngw) {
        const int l = it / I_L; int r = it % I_L; unsigned char* wb = p.ws + WS_W + l * W_LAYER;
        if (r < I_IN) { transpose_item(p.in[6] + (size_t)l * DM * INW, DM, INW, (bf16_t*)(wb + OFF_WIN), scr, r, lane); continue; } r -= I_IN;
        if (r < I_OUT) { transpose_item(p.in[20] + (size_t)l * DM * DM, DM, DM, (bf16_t*)(wb + OFF_WOUT), scr, r, lane); continue; } r -= I_OUT;
        if (r < I_UP) { transpose_item(p.in[21] + (size_t)l * DM * 2 * DFF, DM, 2 * DFF, (bf16_t*)(wb + OFF_WUP), scr, r, lane); continue; } r -= I_UP;
        transpose_item(p.in[24] + (size_t)l * DFF * DM, DFF, DM, (bf16_t*)(wb + OFF_WDN), scr, r, lane);
    }
    float* rc = (float*)(p.ws + WS_ROPEC); float* rs = (float*)(p.ws + WS_ROPES);
    for (int i = blockIdx.x * NT + tid; i < TT * 32; i += gridDim.x * NT) {
        const int t = i >> 5, f = i & 31;
        const double inv = exp(-(double)f / 32.0 * log(10000.0));
        const double ang = (double)t * inv;
        rc[i] = (float)cos(ang); rs[i] = (float)sin(ang);
    }
    bf16_t* U = (bf16_t*)(p.ws + WS_U);
    for (int m = gw; m < MR; m += ngw) rms_row_to_bf16(p.in[0] + (size_t)m * DM, p.in[2], U + (size_t)m * DM, lane);
    float* Hm = (float*)(p.ws + WS_META + M_H); bf16_t* Um = (bf16_t*)(p.ws + WS_META + M_U);
    for (int m = gw; m < NMETA; m += ngw) {
        rms_row_to_bf16(p.in[1] + (size_t)m * DM, p.in[2], Um + (size_t)m * DM, lane);
        for (int j = 0; j < 4; ++j) *(f32x4*)(Hm + (size_t)m * DM + 4 * lane + 256 * j) = *(const f32x4*)(p.in[1] + (size_t)m * DM + 4 * lane + 256 * j);
    }
}

template <int MT, class Epi>
__device__ __forceinline__ void gemm_naive(const bf16_t* A, const bf16_t* Bt, int M, int N, int K, const Epi& epi, int gw, int ngw, int lane) {
    const int fr = lane & 15, fq = lane >> 4;
    const int tilesM = M / (16 * MT), tilesN = N / 64;
    for (int tile = gw; tile < tilesM * tilesN; tile += ngw) {
        const int tm = tile / tilesN, tn = tile % tilesN;
        f32x4 acc[MT][4];
#pragma unroll
        for (int m = 0; m < MT; ++m)
#pragma unroll
            for (int n = 0; n < 4; ++n) acc[m][n] = (f32x4){0.f, 0.f, 0.f, 0.f};
        const bf16_t* Ap = A + (size_t)(tm * 16 * MT + fr) * K + fq * 8;
        const bf16_t* Bp = Bt + (size_t)(tn * 64 + fr) * K + fq * 8;
        for (int k = 0; k < K; k += 32) {
            bf16x8 a[MT], b[4];
#pragma unroll
            for (int m = 0; m < MT; ++m) a[m] = *(const bf16x8*)(Ap + (size_t)m * 16 * K + k);
#pragma unroll
            for (int n = 0; n < 4; ++n) b[n] = *(const bf16x8*)(Bp + (size_t)n * 16 * K + k);
#pragma unroll
            for (int m = 0; m < MT; ++m)
#pragma unroll
                for (int n = 0; n < 4; ++n) acc[m][n] = __builtin_amdgcn_mfma_f32_16x16x32_bf16(b[n], a[m], acc[m][n], 0, 0, 0);
        }
        epi.template run<MT>(acc, tm * 16 * MT, tn * 64, fr, fq);
    }
}
struct EpiF32 {
    float* C; int ldc, pad;
    template <int MT> __device__ __forceinline__ void run(const f32x4 (&acc)[MT][4], int row0, int col0, int fr, int fq) const {
#pragma unroll
        for (int m = 0; m < MT; ++m)
#pragma unroll
            for (int n = 0; n < 4; ++n) *(f32x4*)(C + (size_t)(row0 + 16 * m + fr) * ldc + col0 + 16 * n + 4 * fq) = acc[m][n];
    }
};
struct EpiBf16 {
    bf16_t* C; int ldc, pad;
    template <int MT> __device__ __forceinline__ void run(const f32x4 (&acc)[MT][4], int row0, int col0, int fr, int fq) const {
#pragma unroll
        for (int m = 0; m < MT; ++m)
#pragma unroll
            for (int n = 0; n < 4; ++n) { u32x2 o; o.x = pk2(acc[m][n][0], acc[m][n][1]); o.y = pk2(acc[m][n][2], acc[m][n][3]);
                *(u32x2*)(C + (size_t)(row0 + 16 * m + fr) * ldc + col0 + 16 * n + 4 * fq) = o; }
    }
};
struct EpiWin {
    bf16_t* Z; const float* rc; const float* rs; int meta, pad;
    template <int MT> __device__ __forceinline__ void run(const f32x4 (&acc)[MT][4], int row0, int col0, int fr, int fq) const {
        const bool qk = col0 >= 1024 && col0 < 2048; const float sc = (col0 < 1536) ? 0.125f : 1.f;
#pragma unroll
        for (int m = 0; m < MT; ++m) {
            const int row = row0 + 16 * m + fr; const int t = meta ? row : 16 + (row & (SEQ - 1));
            f32x4 v[4];
#pragma unroll
            for (int n = 0; n < 4; ++n) v[n] = acc[m][n];
            if (qk) {
#pragma unroll
                for (int n = 0; n < 2; ++n) { const f32x4 c = *(const f32x4*)(rc + t * 32 + 16 * n + 4 * fq), s = *(const f32x4*)(rs + t * 32 + 16 * n + 4 * fq);
                    const f32x4 x1 = acc[m][n], x2 = acc[m][n + 2];
                    v[n] = (x1 * c - x2 * s) * sc; v[n + 2] = (x2 * c + x1 * s) * sc; }
            }
#pragma unroll
            for (int n = 0; n < 4; ++n) { u32x2 o; o.x = pk2(v[n][0], v[n][1]); o.y = pk2(v[n][2], v[n][3]);
                *(u32x2*)(Z + (size_t)row * INW + col0 + 16 * n + 4 * fq) = o; }
        }
    }
};
template <int MT, class Epi>
__device__ __forceinline__ void ph_gemm(const bf16_t* A, const bf16_t* Bt, int M, int N, int K, Epi epi) {
    const int lane = threadIdx.x & 63, wave = threadIdx.x >> 6;
    gemm_naive<MT, Epi>(A, Bt, M, N, K, epi, blockIdx.x * 8 + wave, gridDim.x * 8, lane);
}

__device__ __forceinline__ void ph_lru(const P& p, int l, unsigned char* lds) {
    float* xs_all = (float*)lds;
    const int lane = threadIdx.x & 63, wave = threadIdx.x >> 6, u = blockIdx.x * 8 + wave;
    if (u >= 64) return;
    float* xs = xs_all + wave * 64;
    const int b = u >> 3, n = u & 7, ch = n * 64 + lane;
    const bf16_t* ZB = (const bf16_t*)(p.ws + WS_ZB); const bf16_t* ZBm = (const bf16_t*)(p.ws + WS_META + M_ZB);
    float* T1 = (float*)(p.ws + WS_T1); float* T1m = (float*)(p.ws + WS_META + M_T1);
    const float* wa = p.in[9] + (size_t)(l * 8 + n) * 4096 + lane; const float* wx = p.in[11] + (size_t)(l * 8 + n) * 4096 + lane;
    const float ba = p.in[10][(l * 8 + n) * 64 + lane], bx = p.in[12][(l * 8 + n) * 64 + lane];
    const float cw0 = p.in[7][(l * 4 + 0) * LRUW + ch], cw1 = p.in[7][(l * 4 + 1) * LRUW + ch], cw2 = p.in[7][(l * 4 + 2) * LRUW + ch], cw3 = p.in[7][(l * 4 + 3) * LRUW + ch];
    const float cb = p.in[8][l * LRUW + ch];
    const float ap = p.in[13][l * LRUW + ch];
    const float la8 = -8.f * log1pf(expf(-ap));
    float h = 0.f, x1 = 0.f, x2 = 0.f, x3 = 0.f;
    for (int t = 0; t < TT; ++t) {
        const bf16_t* zrow = t < NMETA ? ZBm + (size_t)t * INW : ZB + ((size_t)b * SEQ + (t - NMETA)) * INW;
        const float xr = bf2f(zrow[ch]), gr = bf2f(zrow[LRUW + ch]);
        const float xc = cb + cw0 * x3 + cw1 * x2 + cw2 * x1 + cw3 * xr; x3 = x2; x2 = x1; x1 = xr;
        xs[lane] = xc; wsync();
        float rp = ba, ip = bx;
#pragma unroll 4
        for (int i = 0; i < 64; i += 4) { const f32x4 xv = *(const f32x4*)(xs + i);
            rp += xv.x * wa[i * 64] + xv.y * wa[(i + 1) * 64] + xv.z * wa[(i + 2) * 64] + xv.w * wa[(i + 3) * 64];
            ip += xv.x * wx[i * 64] + xv.y * wx[(i + 1) * 64] + xv.z * wx[(i + 2) * 64] + xv.w * wx[(i + 3) * 64]; }
        wsync();
        const float r = 1.f / (1.f + expf(-rp)), ig = 1.f / (1.f + expf(-ip));
        const float la = la8 * r, a = expf(la), mult = sqrtf(fmaxf(-expm1f(2.f * la), 0.f));
        h = a * h + mult * (ig * xc);
        const float o = h * gelu_tanh(gr);
        if (t < NMETA) { if (b == 0) T1m[t * LRUW + ch] = o; } else T1[((size_t)b * SEQ + (t - NMETA)) * LRUW + ch] = o;
    }
}
__device__ __forceinline__ void ph_lrunorm(const P& p, int l) {
    const int lane = threadIdx.x & 63, wave = threadIdx.x >> 6, gw = blockIdx.x * 8 + wave, ngw = gridDim.x * 8;
    const float* g = p.in[14] + l * LRUW;
    for (int m = gw; m < MR + NMETA; m += ngw) {
        const float* src = m < MR ? (const float*)(p.ws + WS_T1) + (size_t)m * LRUW : (const float*)(p.ws + WS_META + M_T1) + (size_t)(m - MR) * LRUW;
        bf16_t* dst = m < MR ? (bf16_t*)(p.ws + WS_YC) + (size_t)m * DM : (bf16_t*)(p.ws + WS_META + M_YC) + (size_t)(m - MR) * DM;
        f32x4 v[2]; float s = 0.f;
#pragma unroll
        for (int j = 0; j < 2; ++j) { v[j] = *(const f32x4*)(src + 4 * lane + 256 * j); s += (v[j].x * v[j].x + v[j].y * v[j].y) + (v[j].z * v[j].z + v[j].w * v[j].w); }
        const float r = rsqrtf(wave_sum(s) * (1.f / LRUW) + 1e-6f);
#pragma unroll
        for (int j = 0; j < 2; ++j) { const f32x4 gg = *(const f32x4*)(g + 4 * lane + 256 * j);
            u32x2 o; o.x = pk2(v[j].x * r * gg.x, v[j].y * r * gg.y); o.y = pk2(v[j].z * r * gg.z, v[j].w * r * gg.w);
            *(u32x2*)(dst + 4 * lane + 256 * j) = o; }
    }
}

__device__ __forceinline__ void score2(const bf16_t* krow, const float* sm, float& s1, float& s2) {
    float a = 0.f, b = 0.f;
#pragma unroll
    for (int d = 0; d < 64; d += 8) {
        const bf16x8 k1 = *(const bf16x8*)(krow + d), k2 = *(const bf16x8*)(krow + 64 + d);
        const f32x4 qa = *(const f32x4*)(sm + d), qb = *(const f32x4*)(sm + d + 4), qc = *(const f32x4*)(sm + 64 + d), qd = *(const f32x4*)(sm + 64 + d + 4);
        a += qa.x * bf2f((bf16_t)k1[0]) + qa.y * bf2f((bf16_t)k1[1]) + qa.z * bf2f((bf16_t)k1[2]) + qa.w * bf2f((bf16_t)k1[3])
           + qb.x * bf2f((bf16_t)k1[4]) + qb.y * bf2f((bf16_t)k1[5]) + qb.z * bf2f((bf16_t)k1[6]) + qb.w * bf2f((bf16_t)k1[7]);
        b += qc.x * bf2f((bf16_t)k2[0]) + qc.y * bf2f((bf16_t)k2[1]) + qc.z * bf2f((bf16_t)k2[2]) + qc.w * bf2f((bf16_t)k2[3])
           + qd.x * bf2f((bf16_t)k2[4]) + qd.y * bf2f((bf16_t)k2[5]) + qd.z * bf2f((bf16_t)k2[6]) + qd.w * bf2f((bf16_t)k2[7]);
    }
    s1 = a; s2 = b;
}
__device__ __forceinline__ void ph_attn(const P& p, int l, unsigned char* lds) {
    float* sm_all = (float*)(lds + 4096);
    const int lane = threadIdx.x & 63, wave = threadIdx.x >> 6, gw = blockIdx.x * 8 + wave, ngw = gridDim.x * 8;
    float* sm = sm_all + wave * 192;
    const bf16_t* ZB = (const bf16_t*)(p.ws + WS_ZB); const bf16_t* ZBm = (const bf16_t*)(p.ws + WS_META + M_ZB);
    bf16_t* YC = (bf16_t*)(p.ws + WS_YC); bf16_t* YCm = (bf16_t*)(p.ws + WS_META + M_YC);
    const float li = lambda_init_of(l);
    const float lam = expf(wave_sum(p.in[15][l * 64 + lane] * p.in[16][l * 64 + lane])) - expf(wave_sum(p.in[17][l * 64 + lane] * p.in[18][l * 64 + lane])) + li;
    const float g0 = p.in[19][l * 128 + lane] * (1.f - li), g1 = p.in[19][l * 128 + 64 + lane] * (1.f - li);
    constexpr int NQR = NBATCH * NH * SEQ, NQ = NQR + NH * NMETA;
    for (int qi = gw; qi < NQ; qi += ngw) {
        int b, h, t;
        if (qi < NQR) { b = qi / (NH * SEQ); h = (qi / SEQ) % NH; t = NMETA + qi % SEQ; } else { const int m = qi - NQR; b = 0; h = m / NMETA; t = m % NMETA; }
        const bf16_t* qrow = (t < NMETA ? ZBm + (size_t)t * INW : ZB + ((size_t)b * SEQ + (t - NMETA)) * INW) + 1024 + h * 128;
        sm[lane] = bf2f(qrow[lane]); sm[64 + lane] = bf2f(qrow[64 + lane]);
        wsync();
        const int nch = t < NMETA ? 0 : (t - NMETA) / 64 + 1;
        const bf16_t* kmeta = ZBm + 1536 + h * 128; const bf16_t* kreal = ZB + (size_t)b * SEQ * INW + 1536 + h * 128;
        float m1 = -1e30f, l1 = 0.f, m2 = -1e30f, l2 = 0.f;
        for (int c = -1; c < nch; ++c) {
            const bool valid = c >= 0 || lane < NMETA;
            if (valid) {
                const bf16_t* krow = c < 0 ? kmeta + (size_t)lane * INW : kreal + (size_t)(c * 64 + lane) * INW;
                float s1, s2; score2(krow, sm, s1, s2);
                float mn = fmaxf(m1, s1); l1 = l1 * expf(m1 - mn) + expf(s1 - mn); m1 = mn;
                mn = fmaxf(m2, s2); l2 = l2 * expf(m2 - mn) + expf(s2 - mn); m2 = mn;
            }
        }
        const float M1 = wave_max(m1), M2 = wave_max(m2);
        const float L1 = wave_sum(l1 * expf(m1 - M1)), L2 = wave_sum(l2 * expf(m2 - M2));
        const float i1 = 1.f / L1, i2 = lam / L2;
        float acc0 = 0.f, acc1 = 0.f;
        for (int c = -1; c < nch; ++c) {
            const bool valid = c >= 0 || lane < NMETA;
            float w = 0.f;
            if (valid) {
                const bf16_t* krow = c < 0 ? kmeta + (size_t)lane * INW : kreal + (size_t)(c * 64 + lane) * INW;
                float s1, s2; score2(krow, sm, s1, s2);
                w = expf(s1 - M1) * i1 - expf(s2 - M2) * i2;
            }
            sm[128 + lane] = w; wsync();
            const int nk = c < 0 ? NMETA : 64;
            const bf16_t* vbase = (c < 0 ? kmeta : kreal + (size_t)(c * 64) * INW) + 512;
            for (int j = 0; j < nk; ++j) { const float wj = sm[128 + j]; const bf16_t* vr = vbase + (size_t)j * INW;
                acc0 += wj * bf2f(vr[lane]); acc1 += wj * bf2f(vr[64 + lane]); }
            wsync();
        }
        const float ss = wave_sum(acc0 * acc0 + acc1 * acc1);
        const float r = rsqrtf(ss * (1.f / 128.f) + 1e-5f);
        bf16_t* orow = (t < NMETA ? YCm + (size_t)t * DM : YC + ((size_t)b * SEQ + (t - NMETA)) * DM) + 512 + h * 128;
        orow[lane] = (bf16_t)f2bf(acc0 * r * g0); orow[64 + lane] = (bf16_t)f2bf(acc1 * r * g1);
        wsync();
    }
}

__device__ __forceinline__ void ph_normres(const float* Y, const float* Ym, const float* base, float* out, float* Hm, const float* Hm_base, const float* gpost, const float* gnext, bf16_t* U, bf16_t* Um) {
    const int lane = threadIdx.x & 63, wave = threadIdx.x >> 6, gw = blockIdx.x * 8 + wave, ngw = gridDim.x * 8;
    for (int m = gw; m < MR + NMETA; m += ngw) {
        const bool meta = m >= MR; const int r_ = meta ? m - MR : m;
        const float* y = (meta ? Ym : Y) + (size_t)r_ * DM; const float* bs = (meta ? Hm_base : base) + (size_t)r_ * DM; float* o = (meta ? Hm : out) + (size_t)r_ * DM;
        f32x4 v[4]; float s = 0.f;
#pragma unroll
        for (int j = 0; j < 4; ++j) { v[j] = *(const f32x4*)(y + 4 * lane + 256 * j); s += (v[j].x * v[j].x + v[j].y * v[j].y) + (v[j].z * v[j].z + v[j].w * v[j].w); }
        const float r = rsqrtf(wave_sum(s) * (1.f / DM) + 1e-6f);
        float s2 = 0.f;
#pragma unroll
        for (int j = 0; j < 4; ++j) { const f32x4 g = *(const f32x4*)(gpost + 4 * lane + 256 * j), bb = *(const f32x4*)(bs + 4 * lane + 256 * j);
            v[j] = bb + v[j] * r * g; *(f32x4*)(o + 4 * lane + 256 * j) = v[j];
            s2 += (v[j].x * v[j].x + v[j].y * v[j].y) + (v[j].z * v[j].z + v[j].w * v[j].w); }
        if (gnext) {
            const float r2 = rsqrtf(wave_sum(s2) * (1.f / DM) + 1e-6f);
            bf16_t* u = (meta ? Um : U) + (size_t)r_ * DM;
#pragma unroll
            for (int j = 0; j < 4; ++j) { const f32x4 g = *(const f32x4*)(gnext + 4 * lane + 256 * j);
                u32x2 w; w.x = pk2(v[j].x * r2 * g.x, v[j].y * r2 * g.y); w.y = pk2(v[j].z * r2 * g.z, v[j].w * r2 * g.w);
                *(u32x2*)(u + 4 * lane + 256 * j) = w; }
        }
    }
}

__device__ __forceinline__ void ph_ffnconv(const P& p, int l, int row_lo, int nrows, int do_meta) {
    const bf16_t* GV = (const bf16_t*)(p.ws + WS_GV); const bf16_t* GVm = (const bf16_t*)(p.ws + WS_META + M_GV);
    bf16_t* HID = (bf16_t*)(p.ws + WS_HID); bf16_t* HIDm = (bf16_t*)(p.ws + WS_META + M_HID);
    const float* cw = p.in[22] + (size_t)l * 3 * DFF; const float* cb = p.in[23] + (size_t)l * DFF;
    const int total = (nrows + (do_meta ? NMETA : 0)) * (DFF / 4);
    for (int i = blockIdx.x * NT + threadIdx.x; i < total; i += gridDim.x * NT) {
        const int rr = i / (DFF / 4), c = (i % (DFF / 4)) * 4;
        const bool meta = rr >= nrows; const int row = meta ? rr - nrows : row_lo + rr;
        const bf16_t* g0; const bf16_t* g1 = nullptr; const bf16_t* g2 = nullptr;
        if (meta) { g0 = GVm + (size_t)row * 2 * DFF; if (row >= 1) g1 = g0 - 2 * DFF; if (row >= 2) g2 = g0 - 4 * DFF; }
        else { const int tt = row & (SEQ - 1); g0 = GV + (size_t)rr * 2 * DFF;
            g1 = tt >= 1 ? g0 - 2 * DFF : GVm + (size_t)15 * 2 * DFF;
            g2 = tt >= 2 ? g0 - 4 * DFF : GVm + (size_t)(14 + tt) * 2 * DFF; }
        float o[4];
#pragma unroll
        for (int j = 0; j < 4; ++j) {
            float x = cb[c + j] + cw[2 * DFF + c + j] * bf2f(g0[c + j]);
            if (g1) x += cw[DFF + c + j] * bf2f(g1[c + j]);
            if (g2) x += cw[c + j] * bf2f(g2[c + j]);
            o[j] = gelu_tanh(x) * bf2f(g0[DFF + c + j]);
        }
        u32x2 w; w.x = pk2(o[0], o[1]); w.y = pk2(o[2], o[3]);
        *(u32x2*)((meta ? HIDm + (size_t)row * DFF : HID + (size_t)row * DFF) + c) = w;
    }
}


#define LAS __attribute__((address_space(3)))
#define XB_TMO      128
#define XB_XCNT(j)  (256  + 64 * (j))
#define XB_XSUB(j)  (1280 + 64 * (j))
#define XB_XGEN(j)  (2304 + 64 * (j))
#define XB_TOP      3328
#define XB_TOPGEN   3392
#define XCD_BAR_WORDS 3456
#define XB_SPIN_CAP (1u << 22)
__device__ __forceinline__ unsigned xb_ld(unsigned* p)              { return __hip_atomic_load(p, __ATOMIC_RELAXED, __HIP_MEMORY_SCOPE_AGENT); }
__device__ __forceinline__ unsigned xb_add(unsigned* p, unsigned v) { return __hip_atomic_fetch_add(p, v, __ATOMIC_RELAXED, __HIP_MEMORY_SCOPE_AGENT); }
__device__ __forceinline__ unsigned xb_xcc_id() { return (unsigned)__builtin_amdgcn_s_getreg((3 << 11) | 20) & 0xFu; }
#define XB_SPIN(cond, bar) do { unsigned _sp = 0; while (cond) { __builtin_amdgcn_s_sleep(1); \
    if ((++_sp & 255u) == 0u) { if (xb_ld(&(bar)[XB_TMO])) break; if (_sp > XB_SPIN_CAP) { atomicAdd(&(bar)[XB_TMO], 1u); break; } } } } while (0)
struct XcdBarrier { unsigned* bar; unsigned x; volatile LAS unsigned* st; };
__device__ __forceinline__ XcdBarrier xcd_barrier_post(unsigned* bar, volatile LAS unsigned* st) {
    XcdBarrier b; b.bar = bar; b.x = xb_xcc_id(); b.st = st;
    if (threadIdx.x == 0) (void)xb_add(&bar[XB_XCNT(b.x)], 1u);
    return b;
}
__device__ __forceinline__ void xcd_barrier_complete(unsigned* bar, unsigned x, unsigned& nloc, unsigned& nx) {
    const unsigned G = gridDim.x * gridDim.y * gridDim.z;
    unsigned sum, cnt, mine, sp = 0u;
    for (;;) {
        sum = 0u; cnt = 0u; mine = 0u;
#pragma unroll
        for (unsigned j = 0; j < 16; ++j) { const unsigned c = xb_ld(&bar[XB_XCNT(j)]); sum += c; cnt += (c > 0u) ? 1u : 0u; mine = (j == x) ? c : mine; }
        if (sum == G) break;
        __builtin_amdgcn_s_sleep(1);
        if ((++sp & 255u) == 0u) { if (xb_ld(&bar[XB_TMO])) break; if (sp > XB_SPIN_CAP) { atomicAdd(&bar[XB_TMO], 1u); break; } }
    }
    nloc = mine > 0u ? mine : 1u; nx = cnt > 0u ? cnt : 1u;
}
__device__ __forceinline__ void xcd_barrier(const XcdBarrier& b) {
    asm volatile("s_waitcnt vmcnt(0)" ::: "memory");
    __syncthreads();
    if (threadIdx.x == 0) {
        unsigned* bar = b.bar;
        __builtin_amdgcn_s_waitcnt(0);
        unsigned nloc = b.st[0], nx = b.st[1];
        if (nloc == 0u) { xcd_barrier_complete(bar, b.x, nloc, nx); b.st[0] = nloc; b.st[1] = nx; }
        const unsigned old = xb_add(&bar[XB_XSUB(b.x)], 1u);
        const unsigned gen = old / nloc;
        if (old + 1u == (gen + 1u) * nloc) {
            __builtin_amdgcn_fence(__ATOMIC_RELEASE, "agent");
            asm volatile("s_waitcnt vmcnt(0)" ::: "memory");
            const unsigned og = xb_add(&bar[XB_TOP], 1u);
            const unsigned tg = og / nx;
            if (og + 1u == (tg + 1u) * nx) xb_add(&bar[XB_TOPGEN], 1u);
            else XB_SPIN(xb_ld(&bar[XB_TOPGEN]) == tg, bar);
            __builtin_amdgcn_fence(__ATOMIC_ACQUIRE, "agent");
            xb_add(&bar[XB_XGEN(b.x)], 1u);
            asm volatile("s_waitcnt vmcnt(0)" ::: "memory");
        } else {
            XB_SPIN(xb_ld(&bar[XB_XGEN(b.x)]) == gen, bar);
            __builtin_amdgcn_fence(__ATOMIC_ACQUIRE, "agent");
            asm volatile("s_waitcnt vmcnt(0)" ::: "memory");
        }
    }
    __syncthreads();
}

constexpr int LDS_BYTES = 147456;
constexpr int MISC_OFF = 131072 + 320;
constexpr size_t CTL_ZERO_BYTES = 64 << 10;

__global__ void __launch_bounds__(NT, 2) mk_fwd(P p) {
    extern __shared__ __attribute__((aligned(16))) unsigned char lds[];
    volatile LAS unsigned* MISC = (volatile LAS unsigned*)((LAS unsigned char*)lds + MISC_OFF);
    if (threadIdx.x < 32) MISC[threadIdx.x] = 0u;
    __syncthreads();
    XcdBarrier bar = xcd_barrier_post((unsigned*)p.ws, MISC + 8);
#define GRID_BAR() xcd_barrier(bar)
    unsigned char* ws = p.ws;
    bf16_t* U = (bf16_t*)(ws + WS_U); bf16_t* Um = (bf16_t*)(ws + WS_META + M_U);
    bf16_t* YC = (bf16_t*)(ws + WS_YC); bf16_t* YCm = (bf16_t*)(ws + WS_META + M_YC);
    float* Hm = (float*)(ws + WS_META + M_H); float* Ym = (float*)(ws + WS_META + M_Y);
    const float* rc = (const float*)(ws + WS_ROPEC); const float* rs = (const float*)(ws + WS_ROPES);

    ph_prologue(p, lds);
    GRID_BAR();
    for (int l = 0; l < DEPTH; ++l) {
        unsigned char* wb = ws + WS_W + l * W_LAYER;
        const bf16_t* Win = (const bf16_t*)(wb + OFF_WIN); const bf16_t* Wout = (const bf16_t*)(wb + OFF_WOUT); const bf16_t* Wup = (const bf16_t*)(wb + OFF_WUP); const bf16_t* Wdn = (const bf16_t*)(wb + OFF_WDN);
        ph_gemm<4, EpiWin>(U, Win, MR, INW, DM, EpiWin{(bf16_t*)(ws + WS_ZB), rc, rs, 0, 0});
        ph_gemm<1, EpiWin>(Um, Win, NMETA, INW, DM, EpiWin{(bf16_t*)(ws + WS_META + M_ZB), rc, rs, 1, 0});
        GRID_BAR();
        ph_lru(p, l, lds);
        ph_attn(p, l, lds);
        GRID_BAR();
        ph_lrunorm(p, l);
        GRID_BAR();
        ph_gemm<4, EpiF32>(YC, Wout, MR, DM, DM, EpiF32{(float*)(ws + WS_Y1), DM, 0});
        ph_gemm<1, EpiF32>(YCm, Wout, NMETA, DM, DM, EpiF32{Ym, DM, 0});
        GRID_BAR();
        ph_normres((const float*)(ws + WS_Y1), Ym, l == 0 ? p.in[0] : p.out, p.out, Hm, l == 0 ? p.in[1] : Hm, p.in[3] + l * DM, p.in[4] + l * DM, U, Um);
        GRID_BAR();
        ph_gemm<1, EpiBf16>(Um, Wup, NMETA, 2 * DFF, DM, EpiBf16{(bf16_t*)(ws + WS_META + M_GV), 2 * DFF, 0});
        for (int hf = 0; hf < 2; ++hf) {
            ph_gemm<4, EpiBf16>(U + (size_t)hf * (MR / 2) * DM, Wup, MR / 2, 2 * DFF, DM, EpiBf16{(bf16_t*)(ws + WS_GV), 2 * DFF, 0});
            GRID_BAR();
            ph_ffnconv(p, l, hf * (MR / 2), MR / 2, hf == 0);
            GRID_BAR();
        }
        ph_gemm<4, EpiF32>((const bf16_t*)(ws + WS_HID), Wdn, MR, DM, DFF, EpiF32{(float*)(ws + WS_Y2), DM, 0});
        ph_gemm<1, EpiF32>((const bf16_t*)(ws + WS_META + M_HID), Wdn, NMETA, DM, DFF, EpiF32{Ym, DM, 0});
        GRID_BAR();
        ph_normres((const float*)(ws + WS_Y2), Ym, p.out, p.out, Hm, Hm, p.in[5] + l * DM, l + 1 < DEPTH ? p.in[2] + (l + 1) * DM : nullptr, U, Um);
        if (l + 1 < DEPTH) GRID_BAR();
    }
}

extern "C" void kernel_launch(void* const* d_in, const int* in_sizes, int n_in, void* d_out, int out_size, void* d_ws, size_t ws_size, hipStream_t stream) {
    static int grid = 0;
    if (grid == 0) {
        if (n_in != 25 || ws_size < WS_END) { fprintf(stderr, "kernel_launch: unexpected n_in %d or ws_size %zu\n", n_in, ws_size); grid = -1; return; }
        int dev = 0, cus = 0, per_cu = 0;
        hipGetDevice(&dev);
        hipDeviceGetAttribute(&cus, hipDeviceAttributeMultiprocessorCount, dev);
        if (hipFuncSetAttribute((const void*)mk_fwd, hipFuncAttributeMaxDynamicSharedMemorySize, LDS_BYTES) != hipSuccess) { fprintf(stderr, "kernel_launch: hipFuncSetAttribute failed\n"); grid = -1; return; }
        hipOccupancyMaxActiveBlocksPerMultiprocessor(&per_cu, (const void*)mk_fwd, NT, LDS_BYTES);
        (void)hipGetLastError();
        if (per_cu < 1) { fprintf(stderr, "kernel_launch: occupancy query says %d blocks/CU\n", per_cu); per_cu = 1; }
        grid = cus;
    }
    if (grid < 0) return;
    hipMemsetAsync(d_ws, 0, CTL_ZERO_BYTES, stream);
    P p{};
    for (int i = 0; i < 25; ++i) p.in[i] = (const float*)d_in[i];
    p.out = (float*)d_out; p.ws = (unsigned char*)d_ws;
    void* args[] = {&p};
    hipError_t e = hipLaunchCooperativeKernel((const void*)mk_fwd, dim3(grid), dim3(NT), args, LDS_BYTES, stream);
    if (e != hipSuccess) fprintf(stderr, "kernel_launch: cooperative launch failed: %s (grid %d)\n", hipGetErrorString(e), grid);
}
```

```cpp
#include <hip/hip_runtime.h>
#include <cstdint>
#include <cstdio>

typedef unsigned short bf16_t;
typedef short bf16x8 __attribute__((ext_vector_type(8)));
typedef float f32x4 __attribute__((ext_vector_type(4)));
typedef unsigned u32x2 __attribute__((ext_vector_type(2)));
typedef unsigned u32x4 __attribute__((ext_vector_type(4)));

constexpr int DM = 1024, NBATCH = 8, SEQ = 4096, NMETA = 16, TT = SEQ + NMETA, DEPTH = 2;
constexpr int MR = NBATCH * SEQ;
constexpr int LRUW = 512, NH = 4, DFF = 3072, INW = 2560;
constexpr int NT = 512;
constexpr float QSCALE = 0.125f * 1.4426950408889634f;

constexpr size_t MiB = 1u << 20;
constexpr size_t WS_W = 2 * MiB, W_LAYER = 25 * MiB;
constexpr size_t OFF_WIN = 0, OFF_WOUT = 5 * MiB, OFF_WUP = 7 * MiB, OFF_WDN = 19 * MiB;
constexpr size_t WS_ROPEC = 52 * MiB, WS_ROPES = 53 * MiB;
constexpr size_t WS_META = 54 * MiB;
constexpr size_t M_H = 0, M_U = 64 << 10, M_ZB = 128 << 10, M_T1 = 256 << 10, M_YC = 320 << 10, M_Y = 384 << 10, M_GV = 512 << 10, M_HID = 768 << 10;
constexpr size_t WS_WG = 55 * MiB;
constexpr size_t WS_CA = 56 * MiB, WS_CB = 58 * MiB;
constexpr size_t M_HME = 896 << 10;
constexpr size_t WS_GVM = 60 * MiB;
constexpr size_t WS_GH = 128 * MiB, WS_GT = 140 * MiB, WS_VH = 152 * MiB;
constexpr size_t WS_XA = 61 * MiB, WS_XB = 62 * MiB;
constexpr int CW_SEAM = 16384, SEAM_BANK = 128 * 64;
constexpr size_t WS_RS = 63 * MiB;
constexpr size_t M_RS = 960 << 10;
constexpr size_t WS_YB1 = 192 * MiB, WS_YB2 = 128 * MiB;
constexpr size_t WS_U = 64 * MiB, WS_YC = 128 * MiB, WS_ZB = 192 * MiB, WS_T1 = 352 * MiB, WS_Y1 = 384 * MiB;
constexpr size_t WS_GV = 128 * MiB, WS_HID = 320 * MiB, WS_Y2 = 128 * MiB, WS_END = 512 * MiB;

struct P { const float* in[25]; float* out; unsigned char* ws; };

__device__ __forceinline__ float bf2f(bf16_t v) { return __uint_as_float((unsigned)v << 16); }
__device__ __forceinline__ unsigned f2bf(float f) { unsigned u = __float_as_uint(f); return (u + 0x7fffu + ((u >> 16) & 1u)) >> 16; }
__device__ __forceinline__ unsigned pk2(float lo, float hi) { return f2bf(lo) | (f2bf(hi) << 16); }
__device__ __forceinline__ float shx(float v, int mask, int lane) { return __int_as_float(__builtin_amdgcn_ds_bpermute((lane ^ mask) << 2, __float_as_int(v))); }
__device__ __forceinline__ float wave_sum(float v, int lane) {
#pragma unroll
    for (int o = 1; o < 64; o <<= 1) v += shx(v, o, lane);
    return v;
}
__device__ __forceinline__ float wave_max(float v, int lane) {
#pragma unroll
    for (int o = 1; o < 64; o <<= 1) v = fmaxf(v, shx(v, o, lane));
    return v;
}
__device__ __forceinline__ int otid(int wv) { int l; asm volatile("v_mbcnt_lo_u32_b32 %0, -1, 0\n\tv_mbcnt_hi_u32_b32 %0, -1, %0" : "=v"(l)); return wv * 64 + l; }
__device__ __forceinline__ void wsync() { asm volatile("s_waitcnt lgkmcnt(0)" ::: "memory"); }
__device__ __forceinline__ float gelu_tanh(float x) { return 0.5f * x * (1.f + tanhf(0.7978845608028654f * (x + 0.044715f * x * x * x))); }
__device__ __forceinline__ float lambda_init_of(int l) { return l == 0 ? 0.2f : (0.8f - 0.6f * 0.7408182206817179f); }

__device__ __forceinline__ int win_col(int slot) { const int s = slot & 31, n = s >> 4, fq = (s >> 2) & 3, i = s & 3;
    if (slot >= 1024 && slot < 2048) return (slot & ~63) + 16 * ((slot >> 5) & 1) + 4 * fq + i + 32 * n;
    return (slot & ~31) + 8 * fq + 4 * n + i; }
__device__ __forceinline__ int wup_col(int slot) { const int s = slot & 255, hid = 128 * (slot >> 8) + 32 * ((s >> 5) & 3) + 8 * ((s >> 2) & 3) + 4 * ((s >> 7) & 1) + (s & 3); return ((s >> 4) & 1) ? DFF + hid : hid; }
__device__ __forceinline__ int wup_slot(int hid) { return 256 * (hid >> 7) + 128 * ((hid >> 2) & 1) + 32 * ((hid >> 5) & 3) + 4 * ((hid >> 3) & 3) + (hid & 3); }
template <int PERMQK, bool DEEP = false>
__device__ __forceinline__ void transpose_item(const float* W, int K, int N, bf16_t* WT, float* scr, int item, int lane, const float* gk = nullptr) {
    const int nblk = N / 32, kb = item / nblk, nb = item % nblk, k0 = 64 * kb, n0 = 32 * nb;
    if (DEEP) {
        float v[32];
#pragma unroll
        for (int i = 0; i < 32; ++i) { const int kk = 2 * i + (lane >> 5); v[i] = W[(size_t)(k0 + kk) * N + (PERMQK == 1 ? win_col(n0 + (lane & 31)) : PERMQK == 2 ? wup_col(n0 + (lane & 31)) : n0 + (lane & 31))]; }
        if (gk) {
#pragma unroll
            for (int i = 0; i < 32; ++i) v[i] *= gk[k0 + 2 * i + (lane >> 5)];
        }
#pragma unroll
        for (int i = 0; i < 32; ++i) scr[(2 * i + (lane >> 5)) * 33 + (lane & 31)] = v[i];
    } else
#pragma unroll 8
    for (int i = 0; i < 32; ++i) { const int kk = 2 * i + (lane >> 5); scr[kk * 33 + (lane & 31)] = W[(size_t)(k0 + kk) * N + (PERMQK == 1 ? win_col(n0 + (lane & 31)) : PERMQK == 2 ? wup_col(n0 + (lane & 31)) : n0 + (lane & 31))] * (gk ? gk[k0 + kk] : 1.f); }
    wsync();
    const int c = lane & 7;
#pragma unroll
    for (int j = 0; j < 4; ++j) { const int n = (lane >> 3) + 8 * j; const float* s = scr + (8 * c) * 33 + n;
        u32x4 o; o.x = pk2(s[0 * 33], s[1 * 33]); o.y = pk2(s[2 * 33], s[3 * 33]); o.z = pk2(s[4 * 33], s[5 * 33]); o.w = pk2(s[6 * 33], s[7 * 33]);
        *(u32x4*)(WT + (size_t)(n0 + n) * K + k0 + 8 * c) = o; }
    wsync();
}
__device__ __forceinline__ void row_to_bf16_rs(const float* xrow, bf16_t* orow, float* rs, int lane) {
    f32x4 v[4]; float s = 0.f;
#pragma unroll
    for (int j = 0; j < 4; ++j) { v[j] = *(const f32x4*)(xrow + 4 * lane + 256 * j); s += (v[j].x * v[j].x + v[j].y * v[j].y) + (v[j].z * v[j].z + v[j].w * v[j].w); }
    const float r = rsqrtf(wave_sum(s, lane) * (1.f / DM) + 1e-6f);
    if (lane == 0) *rs = r;
#pragma unroll
    for (int j = 0; j < 4; ++j) { u32x2 o; o.x = pk2(v[j].x, v[j].y); o.y = pk2(v[j].z, v[j].w); *(u32x2*)(orow + 4 * lane + 256 * j) = o; }
}
__device__ __forceinline__ void rms_row_to_bf16(const float* xrow, const float* gain, bf16_t* orow, int lane) {
    f32x4 v[4]; float s = 0.f;
#pragma unroll
    for (int j = 0; j < 4; ++j) { v[j] = *(const f32x4*)(xrow + 4 * lane + 256 * j); s += (v[j].x * v[j].x + v[j].y * v[j].y) + (v[j].z * v[j].z + v[j].w * v[j].w); }
    const float r = rsqrtf(wave_sum(s, lane) * (1.f / DM) + 1e-6f);
#pragma unroll
    for (int j = 0; j < 4; ++j) { const f32x4 g = *(const f32x4*)(gain + 4 * lane + 256 * j);
        u32x2 o; o.x = pk2(v[j].x * r * g.x, v[j].y * r * g.y); o.y = pk2(v[j].z * r * g.z, v[j].w * r * g.w);
        *(u32x2*)(orow + 4 * lane + 256 * j) = o; }
}
__device__ __forceinline__ void ph_prologue(const P& p, unsigned char* lds, int wv) {
    float* scr_all = (float*)lds;
    const int tid = otid(wv), lane = tid & 63, wave = tid >> 6;
    const int gw = blockIdx.x * 8 + wave, ngw = gridDim.x * 8;
    float* scr = scr_all + wave * 64 * 33;
    if (gw < NMETA) { const int m = gw; const float* src = p.in[1] + (size_t)m * DM;
        float* Hm = (float*)(p.ws + WS_META + M_H); bf16_t* Um = (bf16_t*)(p.ws + WS_META + M_U);
        f32x4 v[4]; float sq = 0.f;
#pragma unroll
        for (int j = 0; j < 4; ++j) v[j] = *(const f32x4*)(src + 4 * lane + 256 * j);
#pragma unroll
        for (int j = 0; j < 4; ++j) sq += (v[j].x * v[j].x + v[j].y * v[j].y) + (v[j].z * v[j].z + v[j].w * v[j].w);
        const float r = rsqrtf(wave_sum(sq, lane) * (1.f / DM) + 1e-6f);
        if (lane == 0) ((float*)(p.ws + WS_META + M_RS))[m] = r;
#pragma unroll
        for (int j = 0; j < 4; ++j) { *(f32x4*)(Hm + (size_t)m * DM + 4 * lane + 256 * j) = v[j];
            u32x2 o; o.x = pk2(v[j].x, v[j].y); o.y = pk2(v[j].z, v[j].w); *(u32x2*)(Um + (size_t)m * DM + 4 * lane + 256 * j) = o; }
    }
    constexpr int I_IN = 16 * 80, I_OUT = 16 * 32, I_UP = 16 * 192, I_DN = 48 * 32, I_L = I_IN + I_OUT + I_UP + I_DN;
    for (int it = gw; it < I_IN; it += ngw) transpose_item<1>(p.in[6], DM, INW, (bf16_t*)(p.ws + WS_W + OFF_WIN), scr, it, lane, p.in[2]);
    { bf16_t* WG = (bf16_t*)(p.ws + WS_WG);
      for (int i = blockIdx.x * NT + tid; i < DEPTH * 2 * 8 * 4096; i += gridDim.x * NT) {
          const int in_ = i & 63, out_ = (i >> 6) & 63, n = (i >> 12) & 7, g = (i >> 15) & 1, l = i >> 16;
          WG[i] = (bf16_t)f2bf(p.in[g ? 11 : 9][((size_t)(l * 8 + n) * 64 + in_) * 64 + out_]); } }
    float* rc = (float*)(p.ws + WS_ROPEC); float* rs = (float*)(p.ws + WS_ROPES);
    for (int i = blockIdx.x * NT + tid; i < TT * 32; i += gridDim.x * NT) {
        const int t = i >> 5, f = i & 31;
        const double inv = exp(-(double)f / 32.0 * log(10000.0));
        const double ang = (double)t * inv;
        rc[i] = (float)cos(ang); rs[i] = (float)sin(ang);
    }
    bf16_t* U = (bf16_t*)(p.ws + WS_U);
    float* RS = (float*)(p.ws + WS_RS);
    for (int m = gw; m < MR; m += 2 * ngw) {
        const float* x0 = p.in[0] + (size_t)m * DM; const float* x1 = p.in[0] + (size_t)(m + ngw) * DM;
        f32x4 v0[4], v1[4]; float s0 = 0.f, s1 = 0.f;
#pragma unroll
        for (int j = 0; j < 4; ++j) { v0[j] = *(const f32x4*)(x0 + 4 * lane + 256 * j); v1[j] = *(const f32x4*)(x1 + 4 * lane + 256 * j); }
#pragma unroll
        for (int j = 0; j < 4; ++j) { s0 += (v0[j].x * v0[j].x + v0[j].y * v0[j].y) + (v0[j].z * v0[j].z + v0[j].w * v0[j].w); s1 += (v1[j].x * v1[j].x + v1[j].y * v1[j].y) + (v1[j].z * v1[j].z + v1[j].w * v1[j].w); }
        const float r0 = rsqrtf(wave_sum(s0, lane) * (1.f / DM) + 1e-6f), r1 = rsqrtf(wave_sum(s1, lane) * (1.f / DM) + 1e-6f);
        if (lane == 0) { RS[m] = r0; RS[m + ngw] = r1; }
#pragma unroll
        for (int j = 0; j < 4; ++j) { u32x2 o; o.x = pk2(v0[j].x, v0[j].y); o.y = pk2(v0[j].z, v0[j].w); *(u32x2*)(U + (size_t)m * DM + 4 * lane + 256 * j) = o;
            u32x2 q; q.x = pk2(v1[j].x, v1[j].y); q.y = pk2(v1[j].z, v1[j].w); *(u32x2*)(U + (size_t)(m + ngw) * DM + 4 * lane + 256 * j) = q; }
    }
}

constexpr int FILL_PER_BAR = 256 * 7, FILL_ITEMS = 2 * (16 * 32 + 16 * 192 + 48 * 32) + 16 * 80;
__device__ __forceinline__ void fill_item(const P& p, unsigned char* lds, int k, int wv) {
    int it = k * FILL_PER_BAR + (int)blockIdx.x * 7 + (wv - 1);
    if (k < 0 || it >= FILL_ITEMS) return;
    const int lane = otid(wv) & 63;
    float* scr = (float*)lds + wv * 64 * 33;
    constexpr int I_IN = 16 * 80, I_OUT = 16 * 32, I_UP = 16 * 192, I_DN = 48 * 32;
    int l = 0;
    if (it >= I_OUT + I_UP + I_DN) { it -= I_OUT + I_UP + I_DN; l = 1;
        if (it < I_IN) { transpose_item<1, true>(p.in[6] + (size_t)DM * INW, DM, INW, (bf16_t*)(p.ws + WS_W + W_LAYER + OFF_WIN), scr, it, lane, p.in[2] + DM); return; }
        it -= I_IN; }
    unsigned char* wb = p.ws + WS_W + l * W_LAYER;
    if (it < I_OUT) { transpose_item<0, true>(p.in[20] + (size_t)l * DM * DM, DM, DM, (bf16_t*)(wb + OFF_WOUT), scr, it, lane); return; } it -= I_OUT;
    if (it < I_UP) { transpose_item<2, true>(p.in[21] + (size_t)l * DM * 2 * DFF, DM, 2 * DFF, (bf16_t*)(wb + OFF_WUP), scr, it, lane, p.in[4] + l * DM); return; } it -= I_UP;
    transpose_item<0, true>(p.in[24] + (size_t)l * DFF * DM, DFF, DM, (bf16_t*)(wb + OFF_WDN), scr, it, lane);
}

template <int MT, int NTL, class Epi>
__device__ __forceinline__ void gemm_naive(const bf16_t* A, const bf16_t* Bt, int M, int N, int K, const Epi& epi, int gw, int ngw, int lane) {
    const int fr = lane & 15, fq = lane >> 4;
    const int tilesM = M / (16 * MT), tilesN = N / (16 * NTL);
    for (int tile = gw; tile < tilesM * tilesN; tile += ngw) {
        const int tm = tile / tilesN, tn = tile % tilesN;
        f32x4 acc[MT][NTL];
#pragma unroll
        for (int m = 0; m < MT; ++m)
#pragma unroll
            for (int n = 0; n < NTL; ++n) acc[m][n] = (f32x4){0.f, 0.f, 0.f, 0.f};
        const bf16_t* Ap = A + (size_t)(tm * 16 * MT + fr) * K + fq * 8;
        const bf16_t* Bp = Bt + (size_t)(tn * 16 * NTL + fr) * K + fq * 8;
#pragma unroll 8
        for (int k = 0; k < K; k += 32) {
            bf16x8 a[MT], b[NTL];
#pragma unroll
            for (int m = 0; m < MT; ++m) a[m] = *(const bf16x8*)(Ap + (size_t)m * 16 * K + k);
#pragma unroll
            for (int n = 0; n < NTL; ++n) b[n] = *(const bf16x8*)(Bp + (size_t)n * 16 * K + k);
#pragma unroll
            for (int m = 0; m < MT; ++m)
#pragma unroll
                for (int n = 0; n < NTL; ++n) acc[m][n] = __builtin_amdgcn_mfma_f32_16x16x32_bf16(b[n], a[m], acc[m][n], 0, 0, 0);
        }
        epi.template run<MT, NTL>(acc, tm * 16 * MT, tn * 16 * NTL, fr, fq);
    }
}
struct EpiF32 {
    float* C; int ldc, pad;
    template <int MT, int NTL> __device__ __forceinline__ void run(const f32x4 (&acc)[MT][NTL], int row0, int col0, int fr, int fq) const {
#pragma unroll
        for (int m = 0; m < MT; ++m)
#pragma unroll
            for (int n = 0; n < NTL; ++n) *(f32x4*)(C + (size_t)(row0 + 16 * m + fr) * ldc + col0 + 16 * n + 4 * fq) = acc[m][n];
    }
};
struct EpiBf16 {
    bf16_t* C; int ldc, pad;
    template <int MT, int NTL> __device__ __forceinline__ void run(const f32x4 (&acc)[MT][NTL], int row0, int col0, int fr, int fq) const {
#pragma unroll
        for (int m = 0; m < MT; ++m)
#pragma unroll
            for (int n = 0; n < NTL; ++n) { u32x2 o; o.x = pk2(acc[m][n][0], acc[m][n][1]); o.y = pk2(acc[m][n][2], acc[m][n][3]);
                *(u32x2*)(C + (size_t)(row0 + 16 * m + fr) * ldc + col0 + 16 * n + 4 * fq) = o; }
    }
};
struct EpiWin {
    bf16_t* Z; const float* rc; const float* rs; const float* RSr; int meta, pad;
    template <int MT, int NTL> __device__ __forceinline__ void run(const f32x4 (&acc)[MT][NTL], int row0, int col0, int fr, int fq) const {
        static_assert(NTL == 2, "EpiWin: 32-slot tiles");
        int c0_ = col0; asm volatile("" : "+s"(c0_));
        const bool qk = col0 >= 1024 && col0 < 2048; const float sc = (c0_ < 1536) ? QSCALE : 1.f;
        const int fo = 16 * ((col0 >> 5) & 1) + 4 * fq;
#pragma unroll
        for (int m = 0; m < MT; ++m) {
            const int row = row0 + 16 * m + fr; const int t = meta ? row : 16 + (row & (SEQ - 1));
            const float rsr = RSr[row]; f32x4 v0 = acc[m][0] * rsr, v1 = acc[m][1] * rsr;
            if (qk) { const f32x4 c = *(const f32x4*)(rc + t * 32 + fo), s = *(const f32x4*)(rs + t * 32 + fo);
                const f32x4 x1 = v0, x2 = v1; v0 = (x1 * c - x2 * s) * sc; v1 = (x2 * c + x1 * s) * sc; }
            u32x4 o; o.x = pk2(v0[0], v0[1]); o.y = pk2(v0[2], v0[3]); o.z = pk2(v1[0], v1[1]); o.w = pk2(v1[2], v1[3]);
            *(u32x4*)(Z + (size_t)row * INW + col0 + 8 * fq) = o;
        }
    }
};
template <int MT, int NTL, class Epi>
__device__ __forceinline__ void ph_gemm(const bf16_t* A, const bf16_t* Bt, int M, int N, int K, Epi epi, int wv) {
    const int tid = otid(wv), lane = tid & 63, wave = tid >> 6;
    gemm_naive<MT, NTL, Epi>(A, Bt, M, N, K, epi, blockIdx.x * 8 + wave, gridDim.x * 8, lane);
}

__device__ __forceinline__ void ph_lru(const P& p, int l, unsigned char* lds, int wv) {
    if (blockIdx.x >= 8) return;
    const int lane = otid(wv) & 63, w = wv, n = blockIdx.x, ch = n * 64 + lane, t0 = 2 * w;
    float* xsT = (float*)lds;
    float* PG = (float*)lds + 1024;
    float* AB = (float*)lds + 1024 + 16384;
    float* HS = AB + 2048;
    const bf16_t* ZBm = (const bf16_t*)(p.ws + WS_META + M_ZB);
    float* T1m = (float*)(p.ws + WS_META + M_T1);
    const float cw0 = p.in[7][(l * 4 + 0) * LRUW + ch], cw1 = p.in[7][(l * 4 + 1) * LRUW + ch], cw2 = p.in[7][(l * 4 + 2) * LRUW + ch], cw3 = p.in[7][(l * 4 + 3) * LRUW + ch];
    const float cb = p.in[8][l * LRUW + ch];
    float xr[5];
#pragma unroll
    for (int k = 0; k < 5; ++k) { const int row = t0 - 3 + k; const float xv = bf2f(ZBm[(size_t)(row >= 0 ? row : 0) * INW + ch]); xr[k] = row >= 0 ? xv : 0.f; }
    const float g0 = bf2f(ZBm[(size_t)t0 * INW + LRUW + ch]), g1 = bf2f(ZBm[(size_t)(t0 + 1) * INW + LRUW + ch]);
    const float* wa = p.in[9] + (size_t)(l * 8 + n) * 4096 + lane; const float* wx = p.in[11] + (size_t)(l * 8 + n) * 4096 + lane;
    float wav[8], wxv[8];
#pragma unroll
    for (int ii = 0; ii < 8; ++ii) { wav[ii] = wa[(8 * w + ii) * 64]; wxv[ii] = wx[(8 * w + ii) * 64]; }
    const float ba = p.in[10][(l * 8 + n) * 64 + lane], bx = p.in[12][(l * 8 + n) * 64 + lane];
    constexpr float L2E_ = 1.4426950408889634f;
    const float la8 = -8.f * log1pf(expf(-p.in[13][l * LRUW + ch])) * L2E_;
    const float xc0 = cb + cw0 * xr[0] + cw1 * xr[1] + cw2 * xr[2] + cw3 * xr[3], xc1 = cb + cw0 * xr[1] + cw1 * xr[2] + cw2 * xr[3] + cw3 * xr[4];
    xsT[lane * 16 + t0] = xc0; xsT[lane * 16 + t0 + 1] = xc1;
    __syncthreads();
    float rp[16], ip[16];
#pragma unroll
    for (int t = 0; t < 16; ++t) { rp[t] = 0.f; ip[t] = 0.f; }
#pragma unroll
    for (int ii = 0; ii < 8; ++ii) {
#pragma unroll
        for (int q = 0; q < 4; ++q) { const f32x4 xv = *(const f32x4*)(xsT + (8 * w + ii) * 16 + 4 * q);
            rp[4 * q] += xv.x * wav[ii]; rp[4 * q + 1] += xv.y * wav[ii]; rp[4 * q + 2] += xv.z * wav[ii]; rp[4 * q + 3] += xv.w * wav[ii];
            ip[4 * q] += xv.x * wxv[ii]; ip[4 * q + 1] += xv.y * wxv[ii]; ip[4 * q + 2] += xv.z * wxv[ii]; ip[4 * q + 3] += xv.w * wxv[ii]; } }
#pragma unroll
    for (int t = 0; t < 16; ++t) { PG[((w * 2 + 0) * 16 + t) * 64 + lane] = rp[t]; PG[((w * 2 + 1) * 16 + t) * 64 + lane] = ip[t]; }
    __syncthreads();
    float r0 = ba, r1 = ba, i0 = bx, i1 = bx;
#pragma unroll
    for (int k = 0; k < 8; ++k) { r0 += PG[((k * 2 + 0) * 16 + t0) * 64 + lane]; r1 += PG[((k * 2 + 0) * 16 + t0 + 1) * 64 + lane]; i0 += PG[((k * 2 + 1) * 16 + t0) * 64 + lane]; i1 += PG[((k * 2 + 1) * 16 + t0 + 1) * 64 + lane]; }
    { const float r = __builtin_amdgcn_rcpf(1.f + __builtin_amdgcn_exp2f(-L2E_ * r0)), ig = __builtin_amdgcn_rcpf(1.f + __builtin_amdgcn_exp2f(-L2E_ * i0));
      const float a = __builtin_amdgcn_exp2f(la8 * r), mult = __builtin_amdgcn_sqrtf(fmaxf(1.f - a * a, 0.f));
      AB[t0 * 64 + lane] = a; AB[1024 + t0 * 64 + lane] = mult * (ig * xc0); }
    { const float r = __builtin_amdgcn_rcpf(1.f + __builtin_amdgcn_exp2f(-L2E_ * r1)), ig = __builtin_amdgcn_rcpf(1.f + __builtin_amdgcn_exp2f(-L2E_ * i1));
      const float a = __builtin_amdgcn_exp2f(la8 * r), mult = __builtin_amdgcn_sqrtf(fmaxf(1.f - a * a, 0.f));
      AB[(t0 + 1) * 64 + lane] = a; AB[1024 + (t0 + 1) * 64 + lane] = mult * (ig * xc1); }
    __syncthreads();
    if (w == 0) { float h = 0.f;
#pragma unroll
        for (int t = 0; t < 16; ++t) { h = AB[t * 64 + lane] * h + AB[1024 + t * 64 + lane]; HS[t * 64 + lane] = h; }
        ((float*)(p.ws + WS_META + M_HME))[ch] = h; }
    __syncthreads();
    T1m[t0 * LRUW + ch] = HS[t0 * 64 + lane] * g0 * __builtin_amdgcn_rcpf(1.f + __builtin_amdgcn_exp2f(-2.302208198f * (g0 + 0.044715f * g0 * g0 * g0)));
    T1m[(t0 + 1) * LRUW + ch] = HS[(t0 + 1) * 64 + lane] * g1 * __builtin_amdgcn_rcpf(1.f + __builtin_amdgcn_exp2f(-2.302208198f * (g1 + 0.044715f * g1 * g1 * g1)));
}
__device__ __forceinline__ void ph_lrunorm(const P& p, int l, int wv) {
    if (blockIdx.x < 8 || blockIdx.x >= 10) return;
    const int tid = otid(wv), lane = tid & 63, wave = tid >> 6, gw = ((int)blockIdx.x - 8) * 8 + wave, ngw = gridDim.x * 8;
    const float* g = p.in[14] + l * LRUW;
    for (int m = MR + gw; m < MR + NMETA; m += ngw) {
        const float* src = m < MR ? (const float*)(p.ws + WS_T1) + (size_t)m * LRUW : (const float*)(p.ws + WS_META + M_T1) + (size_t)(m - MR) * LRUW;
        bf16_t* dst = m < MR ? (bf16_t*)(p.ws + WS_YC) + (size_t)m * DM : (bf16_t*)(p.ws + WS_META + M_YC) + (size_t)(m - MR) * DM;
        f32x4 v[2]; float s = 0.f;
#pragma unroll
        for (int j = 0; j < 2; ++j) { v[j] = *(const f32x4*)(src + 4 * lane + 256 * j); s += (v[j].x * v[j].x + v[j].y * v[j].y) + (v[j].z * v[j].z + v[j].w * v[j].w); }
        const float r = rsqrtf(wave_sum(s, lane) * (1.f / LRUW) + 1e-6f);
#pragma unroll
        for (int j = 0; j < 2; ++j) { const f32x4 gg = *(const f32x4*)(g + 4 * lane + 256 * j);
            u32x2 o; o.x = pk2(v[j].x * r * gg.x, v[j].y * r * gg.y); o.y = pk2(v[j].z * r * gg.z, v[j].w * r * gg.w);
            *(u32x2*)(dst + 4 * lane + 256 * j) = o; }
    }
}

__device__ __forceinline__ void score2(const bf16_t* krow, const float* sm, float& s1, float& s2) {
    float a = 0.f, b = 0.f;
#pragma unroll
    for (int d = 0; d < 64; d += 8) {
        const bf16x8 k1 = *(const bf16x8*)(krow + d), k2 = *(const bf16x8*)(krow + 64 + d);
        const f32x4 qa = *(const f32x4*)(sm + d), qb = *(const f32x4*)(sm + d + 4), qc = *(const f32x4*)(sm + 64 + d), qd = *(const f32x4*)(sm + 64 + d + 4);
        a += qa.x * bf2f((bf16_t)k1[0]) + qa.y * bf2f((bf16_t)k1[1]) + qa.z * bf2f((bf16_t)k1[2]) + qa.w * bf2f((bf16_t)k1[3])
           + qb.x * bf2f((bf16_t)k1[4]) + qb.y * bf2f((bf16_t)k1[5]) + qb.z * bf2f((bf16_t)k1[6]) + qb.w * bf2f((bf16_t)k1[7]);
        b += qc.x * bf2f((bf16_t)k2[0]) + qc.y * bf2f((bf16_t)k2[1]) + qc.z * bf2f((bf16_t)k2[2]) + qc.w * bf2f((bf16_t)k2[3])
           + qd.x * bf2f((bf16_t)k2[4]) + qd.y * bf2f((bf16_t)k2[5]) + qd.z * bf2f((bf16_t)k2[6]) + qd.w * bf2f((bf16_t)k2[7]);
    }
    s1 = a; s2 = b;
}
__device__ __forceinline__ void ph_attn(const P& p, int l, unsigned char* lds, bool meta_only, int wv) {
    float* sm_all = (float*)(lds + 4096);
    const int tid = otid(wv), lane = tid & 63, wave = tid >> 6, gw = blockIdx.x * 8 + wave, ngw = gridDim.x * 8;
    float* sm = sm_all + wave * 192;
    const bf16_t* ZB = (const bf16_t*)(p.ws + WS_ZB); const bf16_t* ZBm = (const bf16_t*)(p.ws + WS_META + M_ZB);
    bf16_t* YC = (bf16_t*)(p.ws + WS_YC); bf16_t* YCm = (bf16_t*)(p.ws + WS_META + M_YC);
    const float li = lambda_init_of(l);
    const float lam = expf(wave_sum(p.in[15][l * 64 + lane] * p.in[16][l * 64 + lane], lane)) - expf(wave_sum(p.in[17][l * 64 + lane] * p.in[18][l * 64 + lane], lane)) + li;
    const float g0 = p.in[19][l * 128 + lane] * (1.f - li), g1 = p.in[19][l * 128 + 64 + lane] * (1.f - li);
    constexpr int NQR = NBATCH * NH * SEQ, NQ = NQR + NH * NMETA;
    for (int qi = (meta_only ? NQR : 0) + gw; qi < NQ; qi += ngw) {
        int b, h, t;
        if (qi < NQR) { b = qi / (NH * SEQ); h = (qi / SEQ) % NH; t = NMETA + qi % SEQ; } else { const int m = qi - NQR; b = 0; h = m / NMETA; t = m % NMETA; }
        const bf16_t* qrow = (t < NMETA ? ZBm + (size_t)t * INW : ZB + ((size_t)b * SEQ + (t - NMETA)) * INW) + 1024 + h * 128;
        sm[lane] = bf2f(qrow[lane]); sm[64 + lane] = bf2f(qrow[64 + lane]);
        wsync();
        const int nch = t < NMETA ? 0 : (t - NMETA) / 64 + 1;
        const bf16_t* kmeta = ZBm + 1536 + h * 128; const bf16_t* kreal = ZB + (size_t)b * SEQ * INW + 1536 + h * 128;
        float m1 = -1e30f, l1 = 0.f, m2 = -1e30f, l2 = 0.f;
        for (int c = -1; c < nch; ++c) {
            const bool valid = c >= 0 || lane < NMETA;
            if (valid) {
                const bf16_t* krow = c < 0 ? kmeta + (size_t)lane * INW : kreal + (size_t)(c * 64 + lane) * INW;
                float s1, s2; score2(krow, sm, s1, s2);
                float mn = fmaxf(m1, s1); l1 = l1 * exp2f(m1 - mn) + exp2f(s1 - mn); m1 = mn;
                mn = fmaxf(m2, s2); l2 = l2 * exp2f(m2 - mn) + exp2f(s2 - mn); m2 = mn;
            }
        }
        const float M1 = wave_max(m1, lane), M2 = wave_max(m2, lane);
        const float L1 = wave_sum(l1 * exp2f(m1 - M1), lane), L2 = wave_sum(l2 * exp2f(m2 - M2), lane);
        const float i1 = 1.f / L1, i2 = lam / L2;
        float acc0 = 0.f, acc1 = 0.f;
        for (int c = -1; c < nch; ++c) {
            const bool valid = c >= 0 || lane < NMETA;
            float w = 0.f;
            if (valid) {
                const bf16_t* krow = c < 0 ? kmeta + (size_t)lane * INW : kreal + (size_t)(c * 64 + lane) * INW;
                float s1, s2; score2(krow, sm, s1, s2);
                w = exp2f(s1 - M1) * i1 - exp2f(s2 - M2) * i2;
            }
            sm[128 + lane] = w; wsync();
            const int nk = c < 0 ? NMETA : 64;
            const bf16_t* vbase = (c < 0 ? kmeta : kreal + (size_t)(c * 64) * INW) + 512;
            for (int j = 0; j < nk; ++j) { const float wj = sm[128 + j]; const bf16_t* vr = vbase + (size_t)j * INW;
                acc0 += wj * bf2f(vr[lane]); acc1 += wj * bf2f(vr[64 + lane]); }
            wsync();
        }
        const float ss = wave_sum(acc0 * acc0 + acc1 * acc1, lane);
        const float r = rsqrtf(ss * (1.f / 128.f) + 1e-5f);
        bf16_t* orow = (t < NMETA ? YCm + (size_t)t * DM : YC + ((size_t)b * SEQ + (t - NMETA)) * DM) + 512 + h * 128;
        orow[lane] = (bf16_t)f2bf(acc0 * r * g0); orow[64 + lane] = (bf16_t)f2bf(acc1 * r * g1);
        wsync();
    }
}


__device__ __forceinline__ void ph_attn_meta(const P& p, int l, unsigned char* lds, int wv) {
    if (blockIdx.x >= 8) return;
    __syncthreads();
    const int lane = otid(wv) & 63, m = blockIdx.x * 8 + wv, h = m / NMETA, t = m % NMETA;
    float* sm = (float*)(lds + 4096) + wv * 192;
    unsigned char* wsl = p.ws; asm volatile("" : "+s"(wsl));
    const bf16_t* ZBm = (const bf16_t*)(wsl + WS_META + M_ZB); bf16_t* YCm = (bf16_t*)(wsl + WS_META + M_YC);
    const bf16_t* qrow = ZBm + (size_t)t * INW + 1024 + h * 128; const bf16_t* kmeta = ZBm + 1536 + h * 128;
    float v0[NMETA], v1[NMETA];
#pragma unroll
    for (int j = 0; j < NMETA; ++j) { v0[j] = bf2f(kmeta[(size_t)j * INW + 512 + lane]); v1[j] = bf2f(kmeta[(size_t)j * INW + 512 + 64 + lane]); }
    sm[lane] = bf2f(qrow[lane]); sm[64 + lane] = bf2f(qrow[64 + lane]);
    const float li = lambda_init_of(l);
    const float lam = expf(wave_sum(p.in[15][l * 64 + lane] * p.in[16][l * 64 + lane], lane)) - expf(wave_sum(p.in[17][l * 64 + lane] * p.in[18][l * 64 + lane], lane)) + li;
    const float g0 = p.in[19][l * 128 + lane] * (1.f - li), g1 = p.in[19][l * 128 + 64 + lane] * (1.f - li);
    wsync();
    float s1 = -1e30f, s2 = -1e30f;
    if (lane < NMETA) score2(kmeta + (size_t)lane * INW, sm, s1, s2);
    const float M1 = wave_max(s1, lane), M2 = wave_max(s2, lane);
    const float e1 = lane < NMETA ? exp2f(s1 - M1) : 0.f, e2 = lane < NMETA ? exp2f(s2 - M2) : 0.f;
    const float L1 = wave_sum(e1, lane), L2 = wave_sum(e2, lane);
    const float w = e1 * (1.f / L1) - e2 * (lam / L2);
    float acc0 = 0.f, acc1 = 0.f;
#pragma unroll
    for (int j = 0; j < NMETA; ++j) { const float wj = __int_as_float(__builtin_amdgcn_readlane(__float_as_int(w), j)); acc0 += wj * v0[j]; acc1 += wj * v1[j]; }
    const float ss = wave_sum(acc0 * acc0 + acc1 * acc1, lane);
    const float r = rsqrtf(ss * (1.f / 128.f) + 1e-5f);
    bf16_t* orow = YCm + (size_t)t * DM + 512 + h * 128;
    orow[lane] = (bf16_t)f2bf(acc0 * r * g0); orow[64 + lane] = (bf16_t)f2bf(acc1 * r * g1);
}


namespace att {
typedef float f32x16 __attribute__((ext_vector_type(16)));
typedef short s16x4 __attribute__((ext_vector_type(4)));
#define ATT_LAS __attribute__((address_space(3)))
constexpr float THR = 8.f;
__device__ __forceinline__ s16x4 vtr(const ATT_LAS unsigned char* p) { return __builtin_bit_cast(s16x4, __builtin_amdgcn_ds_read_tr16_b64_v4i16((ATT_LAS s16x4*)p)); }
__device__ __forceinline__ unsigned cvtpk(float lo, float hi) { typedef float f2 __attribute__((ext_vector_type(2))); typedef __bf16 b2 __attribute__((ext_vector_type(2))); f2 v = {lo, hi}; b2 b = __builtin_convertvector(v, b2); return __builtin_bit_cast(unsigned, b); }

template <bool META>
__device__ __forceinline__ void tile(const ATT_LAS unsigned char* Kb, const ATT_LAS unsigned char* Vb, const bf16x8 (&qf)[4], f32x16 (&o)[4], float& m, float& lsum, float (&prs)[16], int map, int lane) {
    const int r = lane & 31, hh = lane >> 5;
    f32x16 S0, S1;
#pragma unroll
    for (int i = 0; i < 16; ++i) { S0[i] = META ? 0.f : -m; S1[i] = META ? 0.f : -m; }
    {
        bf16x8 ka[4], kb[4];
#pragma unroll
        for (int s4 = 0; s4 < 4; ++s4) { const int chunk = map * 8 + 2 * s4 + hh;
            ka[s4] = *(const ATT_LAS bf16x8*)(Kb + r * 256 + ((chunk ^ (r & 15)) << 4));
            if (!META) kb[s4] = *(const ATT_LAS bf16x8*)(Kb + (32 + r) * 256 + ((chunk ^ (r & 15)) << 4)); }
        if (!META) {
            const float a0 = (prs[0] + prs[1]) + (prs[2] + prs[3]), a1 = (prs[4] + prs[5]) + (prs[6] + prs[7]), a2 = (prs[8] + prs[9]) + (prs[10] + prs[11]), a3 = (prs[12] + prs[13]) + (prs[14] + prs[15]);
            lsum += (a0 + a1) + (a2 + a3); }
#pragma unroll
        for (int s4 = 0; s4 < 4; ++s4) { S0 = __builtin_amdgcn_mfma_f32_32x32x16_bf16(ka[s4], qf[s4], S0, 0, 0, 0);
            if (!META) S1 = __builtin_amdgcn_mfma_f32_32x32x16_bf16(kb[s4], qf[s4], S1, 0, 0, 0); }
    }
    float mt = -1e30f;
    if (META) {
#pragma unroll
        for (int i = 0; i < 8; ++i) mt = fmaxf(mt, S0[i]);
    } else {
        {
            float q0 = fmaxf(fmaxf(S0[0], S0[1]), S1[0]), q1 = fmaxf(fmaxf(S0[2], S0[3]), S1[1]), q2 = fmaxf(fmaxf(S0[4], S0[5]), S1[2]), q3 = fmaxf(fmaxf(S0[6], S0[7]), S1[3]);
            q0 = fmaxf(fmaxf(q0, S0[8]), S0[9]); q1 = fmaxf(fmaxf(q1, S0[10]), S0[11]); q2 = fmaxf(fmaxf(q2, S0[12]), S0[13]); q3 = fmaxf(fmaxf(q3, S0[14]), S0[15]);
            q0 = fmaxf(fmaxf(q0, S1[4]), S1[5]); q1 = fmaxf(fmaxf(q1, S1[6]), S1[7]); q2 = fmaxf(fmaxf(q2, S1[8]), S1[9]); q3 = fmaxf(fmaxf(q3, S1[10]), S1[11]);
            q0 = fmaxf(fmaxf(q0, S1[12]), S1[13]); q1 = fmaxf(fmaxf(q1, S1[14]), S1[15]);
            mt = fmaxf(fmaxf(q0, q1), fmaxf(q2, q3)); }
    }
    { auto rr = __builtin_amdgcn_permlane32_swap(__float_as_uint(mt), __float_as_uint(mt), false, false); mt = fmaxf(__uint_as_float(rr[0]), __uint_as_float(rr[1])); }
    if (META) {
        if (__any(mt > m + THR)) {
            const float mn = fmaxf(m, mt), alpha = __builtin_amdgcn_exp2f(m - mn);
            lsum *= alpha; m = mn;
#pragma unroll
            for (int e = 0; e < 4; ++e) o[e] = o[e] * alpha;
        }
#pragma unroll
        for (int i = 0; i < 8; ++i) S0[i] -= m;
    } else if (__any(mt > THR)) {
        const float d = fmaxf(mt, 0.f), alpha = __builtin_amdgcn_exp2f(-d);
        lsum *= alpha; m += d;
#pragma unroll
        for (int e = 0; e < 4; ++e) o[e] = o[e] * alpha;
#pragma unroll
        for (int i = 0; i < 16; ++i) { S0[i] -= d; S1[i] -= d; }
    }
    unsigned pw[4][4];
#pragma unroll
    for (int i = 0; i < 16; i += 2) {
        if (META && i >= 8) { prs[i >> 1] = 0.f; continue; }
        const float p0 = __builtin_amdgcn_exp2f(S0[i]), p1 = __builtin_amdgcn_exp2f(S0[i + 1]); prs[i >> 1] = p0 + p1; pw[i >> 3][(i >> 1) & 3] = cvtpk(p0, p1); }
#pragma unroll
    for (int i = 0; i < 16; i += 2) {
        if (META) { prs[8 + (i >> 1)] = 0.f; continue; }
        const float p0 = __builtin_amdgcn_exp2f(S1[i]), p1 = __builtin_amdgcn_exp2f(S1[i + 1]); prs[8 + (i >> 1)] = p0 + p1; pw[2 + (i >> 3)][(i >> 1) & 3] = cvtpk(p0, p1); }
    const int g = (lane >> 4) & 1, q = (lane & 15) >> 2, pp = lane & 3;
    const ATT_LAS unsigned char* vbase = Vb + (4 * hh + q) * 256 + (pp & 1) * 8;
    int cho[4];
#pragma unroll
    for (int eb = 0; eb < 4; ++eb) cho[eb] = ((4 * eb + 2 * g + (pp >> 1)) ^ (q << 2)) << 4;
    constexpr int NKS = META ? 1 : 4;
    s16x4 lo[2][4], hi[2][4];
#pragma unroll
    for (int eb = 0; eb < 4; ++eb) { lo[0][eb] = vtr(vbase + cho[eb]); hi[0][eb] = vtr(vbase + cho[eb] + 8 * 256); }
#pragma unroll
    for (int ks = 0; ks < NKS; ++ks) {
        if (ks + 1 < NKS) {
#pragma unroll
            for (int eb = 0; eb < 4; ++eb) { lo[(ks + 1) & 1][eb] = vtr(vbase + (ks + 1) * 16 * 256 + cho[eb]); hi[(ks + 1) & 1][eb] = vtr(vbase + (ks + 1) * 16 * 256 + cho[eb] + 8 * 256); }
        }
        const u32x4 pu = {pw[ks][0], pw[ks][1], pw[ks][2], pw[ks][3]};
        const bf16x8 pf = __builtin_bit_cast(bf16x8, pu);
#pragma unroll
        for (int eb = 0; eb < 4; ++eb) { const s16x4 a = lo[ks & 1][eb], c = hi[ks & 1][eb];
            const bf16x8 vf = {a[0], a[1], a[2], a[3], c[0], c[1], c[2], c[3]};
            o[eb] = __builtin_amdgcn_mfma_f32_32x32x16_bf16(vf, pf, o[eb], 0, 0, 0); }
    }
}

__device__ __forceinline__ void unit(const P& p, int l, unsigned char* lds_, int b, int h, int qb, float lam, float li, int wv) {
    const ATT_LAS unsigned char* lds = (const ATT_LAS unsigned char*)lds_;
    ATT_LAS unsigned char* ldsw = (ATT_LAS unsigned char*)lds_;
    const int tid = otid(wv), lane = tid & 63, wid = __builtin_amdgcn_readfirstlane(tid >> 6), r = lane & 31, hh = lane >> 5;
    const int map = wid >> 2, qs = wid & 3;
    const bf16_t* ZB = (const bf16_t*)(p.ws + WS_ZB); const bf16_t* ZBm = (const bf16_t*)(p.ws + WS_META + M_ZB);
    const size_t rowbase = (size_t)b * SEQ;
    const int q0 = qb * 128 + qs * 32;
    const int nt_unit = 2 * qb + 2, nt_wave = 2 * qb + 1 + (qs >> 1);
    bf16x8 qf[4];
    { const bf16_t* qp = ZB + (rowbase + q0 + r) * INW + 1024 + h * 128 + map * 64 + hh * 8;
#pragma unroll
      for (int s4 = 0; s4 < 4; ++s4) qf[s4] = *(const bf16x8*)(qp + 16 * s4); }
    f32x16 o[4] = {}; float m = -1e30f, lsum = 0.f;
    float prs[16];
#pragma unroll
    for (int i = 0; i < 16; ++i) prs[i] = 0.f;
#define ATT_DMA(tt, img) do { _Pragma("unroll") for (int j_ = 0; j_ < 2; ++j_) { const int q_ = 2 * wid + j_, row_ = 4 * q_ + (lane >> 4), slot_ = lane & 15; \
        const bf16_t* rp_ = (tt) == 0 ? ZBm + (size_t)(row_ & 15) * INW : ZB + (rowbase + 64 * ((tt) - 1) + row_) * INW; \
        __builtin_amdgcn_global_load_lds((const unsigned*)(rp_ + 1536 + h * 128 + (slot_ ^ (row_ & 15)) * 8), (ATT_LAS unsigned*)(ldsw + (img) * 32768 + q_ * 1024), 16, 0, 0); \
        __builtin_amdgcn_global_load_lds((const unsigned*)(rp_ + 2048 + h * 128 + (slot_ ^ ((row_ & 3) << 2)) * 8), (ATT_LAS unsigned*)(ldsw + (img) * 32768 + 16384 + q_ * 1024), 16, 0, 0); } } while (0)
    ATT_DMA(0, 0);
    asm volatile("s_waitcnt vmcnt(0)" ::: "memory");
    __syncthreads();
    for (int tt = 0; tt <= nt_unit; ++tt) {
        const int buf = tt & 1;
        if (tt < nt_unit) ATT_DMA(tt + 1, buf ^ 1);
        if (tt <= nt_wave) {
            if (tt == 0) tile<true>(lds + buf * 32768, lds + buf * 32768 + 16384, qf, o, m, lsum, prs, map, lane);
            else tile<false>(lds + buf * 32768, lds + buf * 32768 + 16384, qf, o, m, lsum, prs, map, lane);
        }
        asm volatile("s_waitcnt vmcnt(0)" ::: "memory");
        __syncthreads();
    }
#undef ATT_DMA
    lsum += ((prs[0] + prs[1]) + (prs[2] + prs[3])) + ((prs[4] + prs[5]) + (prs[6] + prs[7])) + (((prs[8] + prs[9]) + (prs[10] + prs[11])) + ((prs[12] + prs[13]) + (prs[14] + prs[15])));
    { auto rr = __builtin_amdgcn_permlane32_swap(__float_as_uint(lsum), __float_as_uint(lsum), false, false); lsum = __uint_as_float(rr[0]) + __uint_as_float(rr[1]); }
    const float inv = 1.f / lsum;
    ATT_LAS float* X = (ATT_LAS float*)ldsw;
    if (map == 1) {
        const float f = inv * lam;
#pragma unroll
        for (int eb = 0; eb < 4; ++eb)
#pragma unroll
            for (int i = 0; i < 16; ++i) X[(eb * 16 + i) * 256 + qs * 64 + lane] = o[eb][i] * f;
    }
    __syncthreads();
    if (map == 0) {
        float ss = 0.f;
#pragma unroll
        for (int eb = 0; eb < 4; ++eb)
#pragma unroll
            for (int i = 0; i < 16; ++i) { const float v = o[eb][i] * inv - X[(eb * 16 + i) * 256 + qs * 64 + lane]; o[eb][i] = v; ss += v * v; }
        { auto rr = __builtin_amdgcn_permlane32_swap(__float_as_uint(ss), __float_as_uint(ss), false, false); ss = __uint_as_float(rr[0]) + __uint_as_float(rr[1]); }
        const float rs = rsqrtf(ss * (1.f / 128.f) + 1e-5f) * (1.f - li);
        const float* gsub = p.in[19] + l * 128;
        bf16_t* orow = (bf16_t*)(p.ws + WS_YC) + (rowbase + q0 + r) * DM + 512 + h * 128;
#pragma unroll
        for (int eb = 0; eb < 4; ++eb)
#pragma unroll
            for (int i4 = 0; i4 < 4; ++i4) { const int e0 = 32 * eb + 8 * i4 + 4 * hh; const f32x4 g = *(const f32x4*)(gsub + e0);
                u32x2 w; w.x = cvtpk(o[eb][4 * i4] * rs * g.x, o[eb][4 * i4 + 1] * rs * g.y); w.y = cvtpk(o[eb][4 * i4 + 2] * rs * g.z, o[eb][4 * i4 + 3] * rs * g.w);
                *(u32x2*)(orow + e0) = w; }
    }
    __syncthreads();
}

__device__ __forceinline__ void phase(const P& p, int l, unsigned char* lds, int wv) {
    const int lane = otid(wv) & 63;
    const float li = lambda_init_of(l);
    const float lam = expf(wave_sum(p.in[15][l * 64 + lane] * p.in[16][l * 64 + lane], lane)) - expf(wave_sum(p.in[17][l * 64 + lane] * p.in[18][l * 64 + lane], lane)) + li;
    const int G = gridDim.x, bx = blockIdx.x;
    const int vcu = (G % 8 == 0) ? (bx % 8) * (G / 8) + bx / 8 : bx;
    if (G == 256) {
        const int x = vcu >> 5, c = vcu & 31;
#pragma unroll 1
        for (int j = 0; j < 4; ++j) { const int bh = 4 * x + j; unit(p, l, lds, bh >> 2, bh & 3, (j & 1) ? 31 - c : c, lam, li, wv); }
    } else {
        for (int it = vcu; it < 32 * 32; it += G) unit(p, l, lds, (it >> 5) >> 2, (it >> 5) & 3, it & 31, lam, li, wv);
    }
}
}


namespace lru {
#define LRU_LAS __attribute__((address_space(3)))
typedef float f32x16 __attribute__((ext_vector_type(16)));
constexpr float L2E = 1.4426950408889634f;
__device__ __forceinline__ float sigm(float x) { return __builtin_amdgcn_rcpf(1.f + __builtin_amdgcn_exp2f(-L2E * x)); }
__device__ __forceinline__ float gelu_t(float x) { return x * sigm(1.5957691216057308f * (x + 0.044715f * x * x * x)); }
__device__ __forceinline__ float bc_lo(float v) { auto rr = __builtin_amdgcn_permlane32_swap(__float_as_uint(v), __float_as_uint(v), false, false); return __uint_as_float(rr[0]); }
__device__ __forceinline__ float bc_hi(float v) { auto rr = __builtin_amdgcn_permlane32_swap(__float_as_uint(v), __float_as_uint(v), false, false); return __uint_as_float(rr[1]); }
constexpr int PART_OFF = 131072 + 1024;

constexpr size_t WS_AB = 416 * MiB;
template <int PASS>
__device__ __forceinline__ void unit(const P& p, int l, unsigned char* lds_, int b, int c, int par, int wv) {
    const int tid = otid(wv), lane = tid & 63, n = __builtin_amdgcn_readfirstlane(tid >> 6), r = lane & 31, hh = lane >> 5, tq = lane >> 3, cq = lane & 7;
    LRU_LAS unsigned char* T = (LRU_LAS unsigned char*)lds_ + n * 16384;
    const bf16_t* ZB = (const bf16_t*)(p.ws + WS_ZB); const bf16_t* ZBm = (const bf16_t*)(p.ws + WS_META + M_ZB);
    unsigned* AB = (unsigned*)(p.ws + WS_AB) + ((size_t)((b * 64 + c) * 8 + n)) * 4096 + lane;
    float hc[2] = {0.f, 0.f}, aprod[2] = {1.f, 1.f};
    if (PASS == 0) {
        bf16x8 wf[2][2][4];
        { const bf16_t* WG = (const bf16_t*)(p.ws + WS_WG);
#pragma unroll
          for (int g = 0; g < 2; ++g)
#pragma unroll
            for (int ob = 0; ob < 2; ++ob)
#pragma unroll
                for (int s = 0; s < 4; ++s) wf[g][ob][s] = *(const bf16x8*)(WG + ((size_t)((l * 2 + g) * 8 + n)) * 4096 + (32 * ob + r) * 64 + 16 * s + 8 * hh); }
        float ba_[2], bx_[2], la8_[2];
#pragma unroll
        for (int ob = 0; ob < 2; ++ob) { const int ch = n * 64 + 32 * ob + r;
            ba_[ob] = p.in[10][l * LRUW + ch]; bx_[ob] = p.in[12][l * LRUW + ch];
            la8_[ob] = -8.f * log1pf(expf(-p.in[13][l * LRUW + ch])) * L2E; }
        {
            const float* cw = p.in[7] + (size_t)l * 4 * LRUW + n * 64 + 8 * cq; const float* cb = p.in[8] + (size_t)l * LRUW + n * 64 + 8 * cq;
            bf16x8 xr[11];
#pragma unroll
            for (int k = 0; k < 11; ++k) { const int grow = 64 * c + 8 * tq - 3 + k;
                const bf16_t* ptr = grow >= 0 ? ZB + ((size_t)b * SEQ + grow) * INW : ZBm + (size_t)(NMETA + grow) * INW;
                xr[k] = *(const bf16x8*)(ptr + n * 64 + 8 * cq); }
            float w[4][8], bia[8];
#pragma unroll
            for (int k = 0; k < 4; ++k) { const f32x4 a = *(const f32x4*)(cw + k * LRUW), bq = *(const f32x4*)(cw + k * LRUW + 4);
                w[k][0] = a.x; w[k][1] = a.y; w[k][2] = a.z; w[k][3] = a.w; w[k][4] = bq.x; w[k][5] = bq.y; w[k][6] = bq.z; w[k][7] = bq.w; }
            { const f32x4 a = *(const f32x4*)cb, bq = *(const f32x4*)(cb + 4); bia[0] = a.x; bia[1] = a.y; bia[2] = a.z; bia[3] = a.w; bia[4] = bq.x; bia[5] = bq.y; bia[6] = bq.z; bia[7] = bq.w; }
#pragma unroll
            for (int j = 0; j < 8; ++j) { const int tok = 8 * tq + j; float o[8];
#pragma unroll
                for (int e = 0; e < 8; ++e) o[e] = bia[e] + w[0][e] * bf2f((bf16_t)xr[j][e]) + w[1][e] * bf2f((bf16_t)xr[j + 1][e]) + w[2][e] * bf2f((bf16_t)xr[j + 2][e]) + w[3][e] * bf2f((bf16_t)xr[j + 3][e]);
                *(LRU_LAS f32x4*)(T + tok * 256 + (((2 * cq) ^ (tok & 15)) << 4)) = (f32x4){o[0], o[1], o[2], o[3]};
                *(LRU_LAS f32x4*)(T + tok * 256 + (((2 * cq + 1) ^ (tok & 15)) << 4)) = (f32x4){o[4], o[5], o[6], o[7]}; }
        }
        wsync();
#pragma unroll
        for (int tb = 0; tb < 2; ++tb) {
            bf16x8 af[4];
            { const int tok = 32 * tb + r;
#pragma unroll
              for (int s = 0; s < 4; ++s) { const int c0 = 4 * s + 2 * hh;
                  const f32x4 v0 = *(const LRU_LAS f32x4*)(T + tok * 256 + ((c0 ^ (tok & 15)) << 4)), v1 = *(const LRU_LAS f32x4*)(T + tok * 256 + (((c0 + 1) ^ (tok & 15)) << 4));
                  u32x4 pk; pk.x = pk2(v0.x, v0.y); pk.y = pk2(v0.z, v0.w); pk.z = pk2(v1.x, v1.y); pk.w = pk2(v1.z, v1.w); af[s] = __builtin_bit_cast(bf16x8, pk); } }
#pragma unroll
            for (int ob = 0; ob < 2; ++ob) {
                f32x16 R = {}, I = {};
#pragma unroll
                for (int s = 0; s < 4; ++s) { R = __builtin_amdgcn_mfma_f32_32x32x16_bf16(af[s], wf[0][ob][s], R, 0, 0, 0); I = __builtin_amdgcn_mfma_f32_32x32x16_bf16(af[s], wf[1][ob][s], I, 0, 0, 0); }
                float a[16], bb[16];
#pragma unroll
                for (int i = 0; i < 16; ++i) { const int tok = 32 * tb + 8 * (i >> 2) + 4 * hh + (i & 3);
                    const float xcv = *(const LRU_LAS float*)(T + tok * 256 + (((8 * ob + (r >> 2)) ^ (tok & 15)) << 4) + (r & 3) * 4);
                    const float rg = sigm(R[i] + ba_[ob]), ig = sigm(I[i] + bx_[ob]);
                    const float la = la8_[ob] * rg, av = __builtin_amdgcn_exp2f(la);
                    a[i] = av; bb[i] = __builtin_amdgcn_sqrtf(fmaxf(1.f - av * av, 0.f)) * ig * xcv;
                    AB[((tb * 2 + ob) * 16 + i) * 64] = pk2(bb[i], la); }
#pragma unroll
                for (int G = 0; G < 4; ++G)
#pragma unroll
                    for (int j = 1; j < 4; ++j) { bb[4 * G + j] = a[4 * G + j] * bb[4 * G + j - 1] + bb[4 * G + j]; a[4 * G + j] = a[4 * G + j] * a[4 * G + j - 1]; }
#pragma unroll
                for (int G = 0; G < 4; ++G) { const float AG = a[4 * G + 3], BG = bb[4 * G + 3];
                    const float x = bc_lo(AG * hc[ob] + BG);
                    hc[ob] = bc_hi(AG * x + BG);
                    aprod[ob] *= AG; }
            }
        }
#pragma unroll
        for (int ob = 0; ob < 2; ++ob) { const float at = bc_lo(aprod[ob]) * bc_hi(aprod[ob]); const size_t idx = ((size_t)b * 64 + c) * LRUW + n * 64 + 32 * ob + r;
            if (hh == 0) { ((float*)(p.ws + WS_CA))[idx] = at; ((float*)(p.ws + WS_CB))[idx] = hc[ob]; } }
        return;
    }
    unsigned abv[2][2][16];
#pragma unroll
    for (int q = 0; q < 4; ++q)
#pragma unroll
        for (int i = 0; i < 16; ++i) abv[q >> 1][q & 1][i] = AB[(q * 16 + i) * 64];
    bf16x8 g8v[8];
#pragma unroll
    for (int j = 0; j < 8; ++j) g8v[j] = *(const bf16x8*)(ZB + ((size_t)b * SEQ + 64 * c + 8 * j + tq) * INW + LRUW + n * 64 + 8 * cq);
    const float* gain = p.in[14] + (size_t)l * LRUW + n * 64 + 8 * cq;
    const f32x4 g0 = *(const f32x4*)gain, g1 = *(const f32x4*)(gain + 4);
    {
        const float* CA = (const float*)(p.ws + WS_CA) + (size_t)b * 64 * LRUW + n * 64 + r; const float* CB = (const float*)(p.ws + WS_CB) + (size_t)b * 64 * LRUW + n * 64 + r;
        const int mid = c >> 1, lo = hh ? mid : 0, hi = hh ? c : mid;
        float fa0 = 1.f, fb0 = 0.f, fa1 = 1.f, fb1 = 0.f;
#pragma unroll 8
        for (int cc = lo; cc < hi; ++cc) { const float a0 = CA[(size_t)cc * LRUW], b0 = CB[(size_t)cc * LRUW], a1 = CA[(size_t)cc * LRUW + 32], b1 = CB[(size_t)cc * LRUW + 32];
            fb0 = a0 * fb0 + b0; fa0 *= a0; fb1 = a1 * fb1 + b1; fa1 *= a1; }
        const float* HME = (const float*)(p.ws + WS_META + M_HME) + n * 64 + r;
        hc[0] = bc_hi(fa0) * (bc_lo(fa0) * HME[0] + bc_lo(fb0)) + bc_hi(fb0);
        hc[1] = bc_hi(fa1) * (bc_lo(fa1) * HME[32] + bc_lo(fb1)) + bc_hi(fb1);
    }
#pragma unroll
    for (int tb = 0; tb < 2; ++tb) {
#pragma unroll
        for (int ob = 0; ob < 2; ++ob) {
            float a[16], bb[16];
#pragma unroll
            for (int i = 0; i < 16; ++i) { const unsigned w = abv[tb][ob][i]; a[i] = __builtin_amdgcn_exp2f(__uint_as_float(w & 0xffff0000u)); bb[i] = __uint_as_float(w << 16); }
#pragma unroll
            for (int G = 0; G < 4; ++G)
#pragma unroll
                for (int j = 1; j < 4; ++j) { bb[4 * G + j] = a[4 * G + j] * bb[4 * G + j - 1] + bb[4 * G + j]; a[4 * G + j] = a[4 * G + j] * a[4 * G + j - 1]; }
            float hin[4];
#pragma unroll
            for (int G = 0; G < 4; ++G) { const float AG = a[4 * G + 3], BG = bb[4 * G + 3];
                const float x = bc_lo(AG * hc[ob] + BG); hin[G] = hh ? x : hc[ob];
                hc[ob] = bc_hi(AG * x + BG); }
#pragma unroll
            for (int i = 0; i < 16; ++i) { const int tok = 32 * tb + 8 * (i >> 2) + 4 * hh + (i & 3);
                *(LRU_LAS float*)(T + tok * 256 + (((8 * ob + (r >> 2)) ^ (tok & 15)) << 4) + (r & 3) * 4) = bb[i] + a[i] * hin[i >> 2]; }
        }
    }
    wsync();
    LRU_LAS float* PART = (LRU_LAS float*)((LRU_LAS unsigned char*)lds_ + PART_OFF) + par * 512;
    float y[8][8];
#pragma unroll
    for (int j = 0; j < 8; ++j) { const int tok = 8 * j + tq;
        const f32x4 v0 = *(const LRU_LAS f32x4*)(T + tok * 256 + (((2 * cq) ^ (tok & 15)) << 4)), v1 = *(const LRU_LAS f32x4*)(T + tok * 256 + (((2 * cq + 1) ^ (tok & 15)) << 4));
        const bf16x8 g8 = g8v[j];
        const float hv[8] = {v0.x, v0.y, v0.z, v0.w, v1.x, v1.y, v1.z, v1.w}; float ss = 0.f;
#pragma unroll
        for (int e = 0; e < 8; ++e) { y[j][e] = hv[e] * gelu_t(bf2f((bf16_t)g8[e])); ss += y[j][e] * y[j][e]; }
        ss += shx(ss, 1, lane); ss += shx(ss, 2, lane); ss += shx(ss, 4, lane);
        if (cq == 0) PART[n * 64 + tok] = ss; }
    __syncthreads();
    bf16_t* YC = (bf16_t*)(p.ws + WS_YC);
#pragma unroll
    for (int j = 0; j < 8; ++j) { const int tok = 8 * j + tq; float tot = 0.f;
#pragma unroll
        for (int k = 0; k < 8; ++k) tot += PART[k * 64 + tok];
        const float rs = rsqrtf(tot * (1.f / LRUW) + 1e-6f);
        u32x4 o; o.x = pk2(y[j][0] * rs * g0.x, y[j][1] * rs * g0.y); o.y = pk2(y[j][2] * rs * g0.z, y[j][3] * rs * g0.w); o.z = pk2(y[j][4] * rs * g1.x, y[j][5] * rs * g1.y); o.w = pk2(y[j][6] * rs * g1.z, y[j][7] * rs * g1.w);
        *(u32x4*)(YC + ((size_t)b * SEQ + 64 * c + tok) * DM + n * 64 + 8 * cq) = o; }
}
template <int PASS>
__device__ __forceinline__ void phase(const P& p, int l, unsigned char* lds, int wv) {
    int par = 0;
    for (int u = blockIdx.x; u < NBATCH * 64; u += gridDim.x) {
        const int c = (PASS == 1 && u >= NBATCH * 32) ? 63 - (u & 63) : (u & 63); unit<PASS>(p, l, lds, u >> 6, c, par, wv); par ^= 1; }
    __syncthreads();
}
}

__device__ __forceinline__ void ph_normres(const float* Y, const float* Ym, const float* base, float* out, float* Hm, const float* Hm_base, const float* gpost, const float* gnext, bf16_t* U, bf16_t* Um, int wv) {
    const int tid = otid(wv), lane = tid & 63, wave = tid >> 6, gw = blockIdx.x * 8 + wave, ngw = gridDim.x * 8;
    for (int m = MR + gw; m < MR + NMETA; m += ngw) {
        const bool meta = m >= MR; const int r_ = meta ? m - MR : m;
        const float* y = (meta ? Ym : Y) + (size_t)r_ * DM; const float* bs = (meta ? Hm_base : base) + (size_t)r_ * DM; float* o = (meta ? Hm : out) + (size_t)r_ * DM;
        f32x4 v[4]; float s = 0.f;
#pragma unroll
        for (int j = 0; j < 4; ++j) { v[j] = *(const f32x4*)(y + 4 * lane + 256 * j); s += (v[j].x * v[j].x + v[j].y * v[j].y) + (v[j].z * v[j].z + v[j].w * v[j].w); }
        const float r = rsqrtf(wave_sum(s, lane) * (1.f / DM) + 1e-6f);
        float s2 = 0.f;
#pragma unroll
        for (int j = 0; j < 4; ++j) { const f32x4 g = *(const f32x4*)(gpost + 4 * lane + 256 * j), bb = *(const f32x4*)(bs + 4 * lane + 256 * j);
            v[j] = bb + v[j] * r * g; *(f32x4*)(o + 4 * lane + 256 * j) = v[j];
            s2 += (v[j].x * v[j].x + v[j].y * v[j].y) + (v[j].z * v[j].z + v[j].w * v[j].w); }
        if (gnext) {
            const float r2 = rsqrtf(wave_sum(s2, lane) * (1.f / DM) + 1e-6f);
            bf16_t* u = (meta ? Um : U) + (size_t)r_ * DM;
#pragma unroll
            for (int j = 0; j < 4; ++j) { const f32x4 g = *(const f32x4*)(gnext + 4 * lane + 256 * j);
                u32x2 w; w.x = pk2(v[j].x * r2 * g.x, v[j].y * r2 * g.y); w.y = pk2(v[j].z * r2 * g.z, v[j].w * r2 * g.w);
                *(u32x2*)(u + 4 * lane + 256 * j) = w; }
        }
    }
}


__device__ __forceinline__ void ph_normres2(const bf16_t* Y, bf16_t* HB, const float* gpost, float* RS, float* outf, int wv) {
    const int tid = otid(wv), lane = tid & 63, gw = blockIdx.x * 8 + (tid >> 6), ngw = gridDim.x * 8;
    const f32x4 g0 = *(const f32x4*)(gpost + 8 * lane), g1 = *(const f32x4*)(gpost + 8 * lane + 4), g2 = *(const f32x4*)(gpost + 512 + 8 * lane), g3 = *(const f32x4*)(gpost + 512 + 8 * lane + 4);
    bf16x8 ny0 = *(const bf16x8*)(Y + (size_t)gw * DM + 8 * lane), ny1 = *(const bf16x8*)(Y + (size_t)gw * DM + 512 + 8 * lane);
    bf16x8 nb0 = *(const bf16x8*)(HB + (size_t)gw * DM + 8 * lane), nb1 = *(const bf16x8*)(HB + (size_t)gw * DM + 512 + 8 * lane);
    for (int m = gw; m < MR; m += ngw) {
        const bf16x8 y0 = ny0, y1 = ny1, b0 = nb0, b1 = nb1;
        if (m + ngw < MR) { const size_t mn = (size_t)(m + ngw);
            ny0 = *(const bf16x8*)(Y + mn * DM + 8 * lane); ny1 = *(const bf16x8*)(Y + mn * DM + 512 + 8 * lane);
            nb0 = *(const bf16x8*)(HB + mn * DM + 8 * lane); nb1 = *(const bf16x8*)(HB + mn * DM + 512 + 8 * lane); }
        float v[16], hb[16];
#pragma unroll
        for (int e = 0; e < 8; ++e) { v[e] = bf2f((bf16_t)y0[e]); v[8 + e] = bf2f((bf16_t)y1[e]); hb[e] = bf2f((bf16_t)b0[e]); hb[8 + e] = bf2f((bf16_t)b1[e]); }
        float s = 0.f;
#pragma unroll
        for (int e = 0; e < 16; ++e) s += v[e] * v[e];
        const float r = rsqrtf(wave_sum(s, lane) * (1.f / DM) + 1e-6f);
        const float gg[16] = {g0.x, g0.y, g0.z, g0.w, g1.x, g1.y, g1.z, g1.w, g2.x, g2.y, g2.z, g2.w, g3.x, g3.y, g3.z, g3.w};
        float s2 = 0.f;
#pragma unroll
        for (int e = 0; e < 16; ++e) { hb[e] += v[e] * r * gg[e]; s2 += hb[e] * hb[e]; }
        if (outf) { float* o = outf + (size_t)m * DM;
            *(f32x4*)(o + 8 * lane) = (f32x4){hb[0], hb[1], hb[2], hb[3]}; *(f32x4*)(o + 8 * lane + 4) = (f32x4){hb[4], hb[5], hb[6], hb[7]};
            *(f32x4*)(o + 512 + 8 * lane) = (f32x4){hb[8], hb[9], hb[10], hb[11]}; *(f32x4*)(o + 512 + 8 * lane + 4) = (f32x4){hb[12], hb[13], hb[14], hb[15]};
        } else {
            const float r2 = rsqrtf(wave_sum(s2, lane) * (1.f / DM) + 1e-6f);
            if (lane == 0) RS[m] = r2;
            u32x4 w0, w1;
            w0.x = pk2(hb[0], hb[1]); w0.y = pk2(hb[2], hb[3]); w0.z = pk2(hb[4], hb[5]); w0.w = pk2(hb[6], hb[7]);
            w1.x = pk2(hb[8], hb[9]); w1.y = pk2(hb[10], hb[11]); w1.z = pk2(hb[12], hb[13]); w1.w = pk2(hb[14], hb[15]);
            *(u32x4*)(HB + (size_t)m * DM + 8 * lane) = w0; *(u32x4*)(HB + (size_t)m * DM + 512 + 8 * lane) = w1;
        }
    }
}

namespace pg8 {
#define PG8_LAS __attribute__((address_space(3)))
typedef unsigned short bf16_t;
typedef short bf16x8 __attribute__((ext_vector_type(8)));
typedef float f32x4 __attribute__((ext_vector_type(4)));
typedef unsigned u32x4 __attribute__((ext_vector_type(4)));
constexpr int BM = 256, BK = 64, HALF = 128, HTB = HALF * BK * 2  , STAGE_BYTES = 8 * HTB, NXCD = 8, WGM = 8;

__host__ __device__ __forceinline__ int lds_byte(int r, int c) { const int st = (r >> 4) * 2 + (c >> 5), rr = r & 15, cc = c & 31, ob = rr * 64 + cc * 2; return st * 1024 + (ob ^ (((ob >> 9) & 1) << 5)); }
__host__ __device__ __forceinline__ void stage_rc(int b, int& R, int& C) { const int st = b / 1024, sb = b % 1024, swz = sb ^ (((sb >> 9) & 1) << 5); R = (st >> 1) * 16 + swz / 64; C = (st & 1) * 32 + (swz % 64) / 2; }
__host__ __device__ __forceinline__ int perm32(int rho) { const int n = rho >> 4, i = rho & 15; return 8 * (i >> 2) + 4 * n + (i & 3); }

struct Unit { int pm, pn; };
struct Gemm { const bf16_t* A; const bf16_t* Bt; int M, N, K; };

struct StaticOrder {
    int nM, nN, nwg, G, c;
    __host__ __device__ void init(int M, int N, int G_, int c_) { nM = M / BM; nN = N / BM; nwg = nM * nN; G = G_; c = c_; }
    __host__ __device__ bool next(int i, Unit& u) const {
        const long L = (long)i * G + c; if (L >= nwg) return false;
        int wgid = (int)L; { const int q = nwg / NXCD, r = nwg % NXCD, xcd = wgid % NXCD, off = wgid / NXCD; wgid = (xcd < r ? xcd * (q + 1) : r * (q + 1) + (xcd - r) * q) + off; }
        const int nig = WGM * nN, gid = wgid / nig, fm = gid * WGM, gsz = (nM - fm) < WGM ? (nM - fm) : WGM;
        u.pm = fm + ((wgid % nig) % gsz); u.pn = (wgid % nig) / gsz; return true;
    }
    __device__ __forceinline__ void a_ready(const Unit&) const {}
    __device__ __forceinline__ void done(const Unit&) const {}
};

__device__ __forceinline__ unsigned cvt_pk_bf16(float lo, float hi) { unsigned r; asm volatile("v_cvt_pk_bf16_f32 %0, %1, %2" : "=v"(r) : "v"(lo), "v"(hi)); return r; }
typedef float f32x2 __attribute__((ext_vector_type(2)));
__device__ __forceinline__ f32x2 gelu_pk(f32x2 v) {
    const f32x2 av = __builtin_elementwise_abs(v), d = av * 0.2316418882f + 1.0f;
    f32x2 t; t.x = __builtin_amdgcn_rcpf(d.x); t.y = __builtin_amdgcn_rcpf(d.y);
    f32x2 q = t * 0.5307027145f + (-0.7265760135f); q = q * t + 0.7107068705f; q = q * t + (-0.142248368f); q = q * t + 0.127414796f; q = q * t;
    const f32x2 s = (v * v) * (-0.72134752044f);
    f32x2 e; e.x = __builtin_amdgcn_exp2f(s.x); e.y = __builtin_amdgcn_exp2f(s.y);
    const f32x2 m = v * (q * e), r = v - m;
    f32x2 o; o.x = v.x < 0.f ? m.x : r.x; o.y = v.y < 0.f ? m.y : r.y; return o;
}

template <int ACT  > struct EpiBf16 {
    static constexpr bool PERM = true, AFTER_DRAIN = false; static_assert(ACT == 0 || ACT == 1, "EpiBf16: ACT is 0 (none) or 1 (gelu_pk)");
    bf16_t* O; int ldc; const float* bias; int split_cols; size_t split_stride; float scale0;
    __device__ __forceinline__ void operator()(const f32x4 (&acc)[2][2][4][2], const Unit& u, int wr, int wc, int fr, int fq) const {
        const int row0 = u.pm * BM + wr * 64 + fr; int colt = u.pn * BM; bf16_t* base = O;
        float sc = 1.f; if (split_cols) { const int t = colt / split_cols; base += (size_t)t * split_stride; colt -= t * split_cols; if (t == 0) sc = scale0; }
        const int col0 = colt + wc * 32 + 8 * fq, bcol0 = u.pn * BM + wc * 32 + 8 * fq;
        f32x4 bv[2][2];
#pragma unroll
        for (int bj = 0; bj < 2; ++bj)
#pragma unroll
            for (int n = 0; n < 2; ++n) bv[bj][n] = bias ? *(const f32x4*)(bias + bcol0 + bj * HALF + 4 * n) : (f32x4){0.f, 0.f, 0.f, 0.f};
#pragma unroll
        for (int ai = 0; ai < 2; ++ai)
#pragma unroll
            for (int m = 0; m < 4; ++m) { bf16_t* rowp = base + (size_t)(row0 + ai * HALF + m * 16) * ldc + col0;
#pragma unroll
                for (int bj = 0; bj < 2; ++bj) { f32x4 v0 = acc[ai][bj][m][0] + bv[bj][0], v1 = acc[ai][bj][m][1] + bv[bj][1];
                    if (ACT == 1) { f32x2 a = gelu_pk((f32x2){v0[0], v0[1]}), b = gelu_pk((f32x2){v0[2], v0[3]}), c = gelu_pk((f32x2){v1[0], v1[1]}), d = gelu_pk((f32x2){v1[2], v1[3]});
                        v0 = (f32x4){a.x, a.y, b.x, b.y}; v1 = (f32x4){c.x, c.y, d.x, d.y}; }
                    v0 = v0 * sc; v1 = v1 * sc; u32x4 w; w.x = cvt_pk_bf16(v0[0], v0[1]); w.y = cvt_pk_bf16(v0[2], v0[3]); w.z = cvt_pk_bf16(v1[0], v1[1]); w.w = cvt_pk_bf16(v1[2], v1[3]);
                    *(u32x4*)(rowp + bj * HALF) = w; } }
    }
};

struct PanelStats {
    unsigned* xbuf;
    unsigned* cnt;
    unsigned* tmo;
    int ntn; float eps;
    unsigned code;
    __device__ __forceinline__ bool run(const f32x4 (&v)[2][2][4][2], const Unit& u, int wr, int wc, int fr, int fq, PG8_LAS unsigned char* lds, int wid, int lane) const {
        typedef float f32x2v __attribute__((ext_vector_type(2)));
        PG8_LAS f32x2v* P = (PG8_LAS f32x2v*)lds;
        PG8_LAS f32x2v* S = (PG8_LAS f32x2v*)(lds + 8192);
        PG8_LAS unsigned* flag = (PG8_LAS unsigned*)(lds + 8192 + 2048);
#pragma unroll
        for (int ai = 0; ai < 2; ++ai)
#pragma unroll
            for (int m = 0; m < 4; ++m) {
                float s = 0.f;
#pragma unroll
                for (int bj = 0; bj < 2; ++bj)
#pragma unroll
                    for (int n = 0; n < 2; ++n) { const f32x4 x = v[ai][bj][m][n]; s += (x[0] + x[1]) + (x[2] + x[3]); }
                s += __shfl_xor(s, 16); s += __shfl_xor(s, 32);
                const float mw = s * (1.0f / 64.0f); float q = 0.f;
#pragma unroll
                for (int bj = 0; bj < 2; ++bj)
#pragma unroll
                    for (int n = 0; n < 2; ++n) { const f32x4 d = v[ai][bj][m][n] - mw; q += (d[0] * d[0] + d[1] * d[1]) + (d[2] * d[2] + d[3] * d[3]); }
                q += __shfl_xor(q, 16); q += __shfl_xor(q, 32);
                if (fq == 0) P[(ai * HALF + wr * 64 + m * 16 + fr) * 4 + wc] = (f32x2v){mw, q};
            }
        asm volatile("s_waitcnt lgkmcnt(0)" ::: "memory"); __builtin_amdgcn_s_barrier(); asm volatile("" ::: "memory");
#if defined(BROKEN_EXCHANGE_NO_WAIT)
#warning BROKEN CONTROL BUILD: the row-statistics exchange does not wait; results are wrong by design
        if (blockIdx.x >= 64) { const long long t0_ = clock64(); while (clock64() - t0_ < 60000) __builtin_amdgcn_s_sleep(8); }
#endif
        const int row = wid * 32 + (lane & 31);
        if (lane < 32) {
            const f32x2v a = P[row * 4 + 0], b = P[row * 4 + 1], c = P[row * 4 + 2], d = P[row * 4 + 3];
            const float mt = (a.x + b.x + c.x + d.x) * 0.25f;
            const float da = a.x - mt, db = b.x - mt, dc = c.x - mt, dd = d.x - mt;
            const float m2 = (a.y + b.y) + (c.y + d.y) + 64.0f * ((da * da + db * db) + (dc * dc + dd * dd));
            unsigned long long* slot = (unsigned long long*)xbuf + ((size_t)(u.pm * BM + row) * 4 + u.pn);
            __hip_atomic_store(slot, ((unsigned long long)__float_as_uint(m2) << 32) | __float_as_uint(mt), __ATOMIC_RELAXED, __HIP_MEMORY_SCOPE_AGENT);
        }
        asm volatile("s_waitcnt vmcnt(0)" ::: "memory");
        if (lane == 0) __hip_atomic_fetch_add(cnt + 64 * u.pm, 1u, __ATOMIC_RELAXED, __HIP_MEMORY_SCOPE_AGENT);
        if (wid == 0) {
            bool dead = false; const unsigned long long t0 = __builtin_amdgcn_s_memrealtime(); const unsigned want = 8u * (unsigned)ntn;
            for (;;) {
#if defined(BROKEN_EXCHANGE_NO_WAIT)
                break;
#endif
                if ((unsigned)__builtin_amdgcn_readfirstlane(__hip_atomic_load(cnt + 64 * u.pm, __ATOMIC_RELAXED, __HIP_MEMORY_SCOPE_AGENT)) >= want) break;
                if (__builtin_amdgcn_s_memrealtime() - t0 > 2000000ull) {
                    if (lane == 0) { unsigned expect = 0u; __hip_atomic_compare_exchange_strong(tmo + 1, &expect, code | (unsigned)(u.pm & 0xff), __ATOMIC_RELAXED, __ATOMIC_RELAXED, __HIP_MEMORY_SCOPE_AGENT);
                                     __hip_atomic_store(tmo, 1u, __ATOMIC_RELAXED, __HIP_MEMORY_SCOPE_AGENT); }
                    dead = true; break; }
                __builtin_amdgcn_s_sleep(2);
            }
            __builtin_amdgcn_fence(__ATOMIC_ACQUIRE, "agent");
            if (lane == 0) flag[0] = dead ? 1u : 0u;
        }
        asm volatile("s_waitcnt vmcnt(0) lgkmcnt(0)" ::: "memory"); __builtin_amdgcn_s_barrier(); asm volatile("" ::: "memory");
        const bool bad = flag[0] != 0u;
        if (lane < 32) {
            const unsigned long long* slot = (const unsigned long long*)xbuf + (size_t)(u.pm * BM + row) * 4; float mt[4], m2[4]; float ms = 0.f;
#pragma unroll
            for (int t = 0; t < 4; ++t) { if (t < ntn) { const unsigned long long w = __hip_atomic_load(slot + t, __ATOMIC_RELAXED, __HIP_MEMORY_SCOPE_AGENT); mt[t] = __uint_as_float((unsigned)w); m2[t] = __uint_as_float((unsigned)(w >> 32)); } else { mt[t] = 0.f; m2[t] = 0.f; } ms += mt[t]; }
            const float mean = ms / (float)ntn; float q = 0.f;
#pragma unroll
            for (int t = 0; t < 4; ++t) if (t < ntn) { const float dm = mt[t] - mean; q += m2[t] + 256.0f * dm * dm; }
            S[row] = (f32x2v){mean, 1.0f / sqrtf(q / (256.0f * (float)ntn) + eps)};
        }
        asm volatile("s_waitcnt lgkmcnt(0)" ::: "memory"); __builtin_amdgcn_s_barrier(); asm volatile("" ::: "memory");
        return bad;
    }
};
struct EpiLnRes {
    static constexpr bool PERM = false, AFTER_DRAIN = true;
    const float* base; float* out; int ldc; const float* bias; PanelStats st; unsigned poison;
    __device__ __forceinline__ void fused(f32x4 (&acc)[2][2][4][2], const Unit& u, int wr, int wc, int fr, int fq, PG8_LAS unsigned char* lds, int wid, int lane) const {
        typedef float f32x2v __attribute__((ext_vector_type(2)));
        const PG8_LAS f32x2v* S = (const PG8_LAS f32x2v*)(lds + 8192);
        const int col0 = u.pn * BM + wc * 32 + 4 * fq;
#pragma unroll
        for (int bj = 0; bj < 2; ++bj)
#pragma unroll
            for (int n = 0; n < 2; ++n) { const f32x4 bv = bias ? *(const f32x4*)(bias + col0 + bj * HALF + n * 16) : (f32x4){0.f, 0.f, 0.f, 0.f};
#pragma unroll
                for (int ai = 0; ai < 2; ++ai)
#pragma unroll
                    for (int m = 0; m < 4; ++m) acc[ai][bj][m][n] += bv; }
        f32x4 pre[4][2][2];
#pragma unroll
        for (int m = 0; m < 4; ++m) { const size_t off = (size_t)(u.pm * BM + wr * 64 + m * 16 + fr) * ldc + col0;
#pragma unroll
            for (int bj = 0; bj < 2; ++bj)
#pragma unroll
                for (int n = 0; n < 2; ++n) pre[m][bj][n] = *(const f32x4*)(base + off + bj * HALF + n * 16); }
        const bool bad = st.run(acc, u, wr, wc, fr, fq, lds, wid, lane) || poison != 0u;
        const float qnan = __builtin_nanf("");
#pragma unroll
        for (int ai = 0; ai < 2; ++ai)
#pragma unroll
            for (int m = 0; m < 4; ++m) { const int r = ai * HALF + wr * 64 + m * 16 + fr; const f32x2v sr = S[r]; const size_t off = (size_t)(u.pm * BM + r) * ldc + col0;
#pragma unroll
                for (int bj = 0; bj < 2; ++bj)
#pragma unroll
                    for (int n = 0; n < 2; ++n) { const f32x4 bs = ai == 0 ? pre[m][bj][n] : *(const f32x4*)(base + off + bj * HALF + n * 16); f32x4 o = bs + (acc[ai][bj][m][n] - sr.x) * sr.y;
                        if (bad) o = (f32x4){qnan, qnan, qnan, qnan}; *(f32x4*)(out + off + bj * HALF + n * 16) = o; }
                if (m & 1) asm volatile("" ::: "memory"); }
    }
};
struct EpiLnResLn {
    static constexpr bool PERM = false, AFTER_DRAIN = true;
    const float* base; float* out; bf16_t* xn; int ldc; const float* bias; PanelStats st1, st2; unsigned poison;
    __device__ __forceinline__ void fused(f32x4 (&acc)[2][2][4][2], const Unit& u, int wr, int wc, int fr, int fq, PG8_LAS unsigned char* lds, int wid, int lane) const {
        typedef float f32x2v __attribute__((ext_vector_type(2))); typedef unsigned u32x2v __attribute__((ext_vector_type(2)));
        const PG8_LAS f32x2v* S = (const PG8_LAS f32x2v*)(lds + 8192);
        const int col0 = u.pn * BM + wc * 32 + 4 * fq;
#pragma unroll
        for (int bj = 0; bj < 2; ++bj)
#pragma unroll
            for (int n = 0; n < 2; ++n) { const f32x4 bv = bias ? *(const f32x4*)(bias + col0 + bj * HALF + n * 16) : (f32x4){0.f, 0.f, 0.f, 0.f};
#pragma unroll
                for (int ai = 0; ai < 2; ++ai)
#pragma unroll
                    for (int m = 0; m < 4; ++m) acc[ai][bj][m][n] += bv; }
        bool bad = st1.run(acc, u, wr, wc, fr, fq, lds, wid, lane) || poison != 0u;
        const float qnan = __builtin_nanf("");
#pragma unroll
        for (int ai = 0; ai < 2; ++ai)
#pragma unroll
            for (int m = 0; m < 4; ++m) { const int r = ai * HALF + wr * 64 + m * 16 + fr; const f32x2v sr = S[r]; const size_t off = (size_t)(u.pm * BM + r) * ldc + col0;
#pragma unroll
                for (int bj = 0; bj < 2; ++bj)
#pragma unroll
                    for (int n = 0; n < 2; ++n) { const f32x4 bs = *(const f32x4*)(base + off + bj * HALF + n * 16); acc[ai][bj][m][n] = bs + (acc[ai][bj][m][n] - sr.x) * sr.y; }
                asm volatile("" : "+v"(acc[ai][0][m][0]), "+v"(acc[ai][0][m][1]), "+v"(acc[ai][1][m][0]), "+v"(acc[ai][1][m][1]));
                if (m & 1) asm volatile("" ::: "memory"); }
        const bool bad1 = bad;
        bad = st2.run(acc, u, wr, wc, fr, fq, lds, wid, lane) || bad;
#pragma unroll
        for (int ai = 0; ai < 2; ++ai)
#pragma unroll
            for (int m = 0; m < 4; ++m) { const int r = ai * HALF + wr * 64 + m * 16 + fr; const f32x2v sr = S[r]; const size_t off = (size_t)(u.pm * BM + r) * ldc + col0;
#pragma unroll
                for (int bj = 0; bj < 2; ++bj)
#pragma unroll
                    for (int n = 0; n < 2; ++n) { const f32x4 x1 = acc[ai][bj][m][n]; *(f32x4*)(out + off + bj * HALF + n * 16) = bad1 ? (f32x4){qnan, qnan, qnan, qnan} : x1;
                        const f32x4 o = (x1 - sr.x) * sr.y; u32x2v w; w.x = cvt_pk_bf16(o[0], o[1]); w.y = cvt_pk_bf16(o[2], o[3]);
                        if (bad) { w.x = 0x7fc07fc0u; w.y = 0x7fc07fc0u; } *(u32x2v*)(xn + off + bj * HALF + n * 16) = w; }
                asm volatile("" ::: "memory"); }
    }
};

template <class Epi, class Sched, bool ALIGN_EPI = false, bool SP2 = false>
__device__ __forceinline__ void gemm_phase(PG8_LAS unsigned char* lds, const Gemm g, const Sched& S, const Epi& E, int wv) {
    const int tid = otid(wv), wid = __builtin_amdgcn_readfirstlane(tid >> 6), lane = tid & 63, wr = wid >> 2, wc = wid & 3, fr = lane & 15, fq = lane >> 4;
    const int K = g.K, nt = K / BK;
    unsigned voffA[2], voffB[2];
#pragma unroll
    for (int i = 0; i < 2; ++i) { int R, C; stage_rc(tid * 16 + i * 8192, R, C); const int Rb = Epi::PERM ? ((R & ~31) + perm32(R & 31)) : R;
        voffA[i] = (unsigned)(R * K + C) * 2u; voffB[i] = (unsigned)(Rb * K + C) * 2u; }
    const size_t kstep = (size_t)(BK * 2);
    const size_t hstep = (size_t)HALF * K * 2;
    const size_t tstep = 2 * hstep;
    const unsigned ldsw = (unsigned)wid * 1024u;
    const int aoff = lds_byte(wr * 64 + fr, fq * 8), boff = lds_byte(wc * 32 + fr, fq * 8);
#define PG8_SA(b, h) (((b) * 2 + (h)) * HTB)
#define PG8_SB(b, h) ((4 + (b) * 2 + (h)) * HTB)
#define PG8_STAGE(bufoff, gbase, voff) do { _Pragma("unroll") for (int _i = 0; _i < 2; ++_i) \
        __builtin_amdgcn_global_load_lds((const unsigned*)((const char*)(gbase) + (voff)[_i]), (PG8_LAS unsigned*)(lds + (bufoff) + ldsw + _i * 8192), 16, 0, 0); } while (0)
#define PG8_LDA(dst, b, h) do { _Pragma("unroll") for (int m = 0; m < 4; ++m) _Pragma("unroll") for (int k = 0; k < 2; ++k) dst[m][k] = *(const PG8_LAS bf16x8*)(lds + PG8_SA(b, h) + aoff + m * 2048 + k * 1024); } while (0)
#define PG8_LDB(dst, b, h) do { _Pragma("unroll") for (int n = 0; n < 2; ++n) _Pragma("unroll") for (int k = 0; k < 2; ++k) dst[n][k] = *(const PG8_LAS bf16x8*)(lds + PG8_SB(b, h) + boff + n * 2048 + k * 1024); } while (0)
#define PG8_MMA(ai, bj, At, Bt) do { __builtin_amdgcn_s_setprio(1); _Pragma("unroll") for (int m = 0; m < 4; ++m) _Pragma("unroll") for (int n = 0; n < 2; ++n) _Pragma("unroll") for (int k = 0; k < 2; ++k) \
        acc[ai][bj][m][n] = __builtin_amdgcn_mfma_f32_16x16x32_bf16(Bt[n][k], At[m][k], acc[ai][bj][m][n], 0, 0, 0); __builtin_amdgcn_s_setprio(0); } while (0)
#define PG8_WAIT_V(n) asm volatile("s_waitcnt vmcnt(" #n ")" ::: "memory")
#define PG8_WAIT_L(n) asm volatile("s_waitcnt lgkmcnt(" #n ")" ::: "memory")
#define PG8_BAR __builtin_amdgcn_s_barrier()
#define PG8_SCHED __builtin_amdgcn_sched_barrier(0)
    Unit cur, nxt; int ui = 0;
    if (!S.next(0, cur)) return;
    f32x4 acc[2][2][4][2];
#pragma unroll
    for (int a = 0; a < 2; ++a)
#pragma unroll
        for (int b = 0; b < 2; ++b)
#pragma unroll
            for (int m = 0; m < 4; ++m)
#pragma unroll
                for (int n = 0; n < 2; ++n) acc[a][b][m][n] = (f32x4){0.f, 0.f, 0.f, 0.f};
    bf16x8 At[4][2], B0[2][2], B1[2][2];
    const char* cA = (const char*)g.A + (size_t)cur.pm * tstep; const char* cB = (const char*)g.Bt + (size_t)cur.pn * tstep;
    S.a_ready(cur);
    if constexpr (SP2) {
        PG8_STAGE(PG8_SB(0, 0), cB, voffB); PG8_STAGE(PG8_SB(0, 1), cB + hstep, voffB); PG8_STAGE(PG8_SA(0, 0), cA, voffA); PG8_STAGE(PG8_SA(0, 1), cA + hstep, voffA);
        if (wr == 1) PG8_BAR;
        PG8_WAIT_V(2); PG8_BAR;
        PG8_STAGE(PG8_SB(1, 0), cB + kstep, voffB); PG8_STAGE(PG8_SA(1, 0), cA + kstep, voffA); PG8_STAGE(PG8_SB(1, 1), cB + hstep + kstep, voffB);
        PG8_WAIT_V(6); PG8_BAR;
    } else {
        PG8_STAGE(PG8_SB(0, 0), cB, voffB); PG8_STAGE(PG8_SA(0, 0), cA, voffA); PG8_STAGE(PG8_SB(0, 1), cB + hstep, voffB); PG8_STAGE(PG8_SA(0, 1), cA + hstep, voffA);
        if (wr == 1) PG8_BAR;
        PG8_WAIT_V(4); PG8_BAR;
        PG8_STAGE(PG8_SB(1, 0), cB + kstep, voffB); PG8_STAGE(PG8_SA(1, 0), cA + kstep, voffA); PG8_STAGE(PG8_SB(1, 1), cB + hstep + kstep, voffB);
        PG8_WAIT_V(6); PG8_BAR;
    }
    for (;;) {
        const bool has_next = S.next(ui + 1, nxt);
        const char* nA = has_next ? (const char*)g.A + (size_t)nxt.pm * tstep : cA; const char* nB = has_next ? (const char*)g.Bt + (size_t)nxt.pn * tstep : cB;
        for (int t = 0; t < nt; t += 2) {
            const bool last = (t == nt - 2);
            const char* a1 = cA + (size_t)(t + 1) * kstep;
            const char* a2 = last ? nA : cA + (size_t)(t + 2) * kstep; const char* b2 = last ? nB : cB + (size_t)(t + 2) * kstep;
            const char* a3 = a2 + kstep; const char* b3 = b2 + kstep;
            if (last && has_next) S.a_ready(nxt);
            if constexpr (SP2) {
            PG8_LDB(B0, 0, 0); PG8_LDB(B1, 0, 1); PG8_SCHED; PG8_LDA(At, 0, 0); PG8_STAGE(PG8_SA(1, 1), a1 + hstep, voffA);
            PG8_WAIT_V(8); PG8_WAIT_L(0); PG8_BAR; PG8_MMA(0, 0, At, B0); PG8_MMA(0, 1, At, B1); PG8_BAR; PG8_SCHED;
            PG8_LDA(At, 0, 1); PG8_STAGE(PG8_SB(0, 0), b2, voffB); PG8_STAGE(PG8_SB(0, 1), b2 + hstep, voffB); PG8_STAGE(PG8_SA(0, 0), a2, voffA);
            PG8_WAIT_V(8); PG8_WAIT_L(0); PG8_BAR; PG8_MMA(1, 0, At, B0); PG8_MMA(1, 1, At, B1); PG8_BAR; PG8_SCHED;
            PG8_LDB(B0, 1, 0); PG8_LDB(B1, 1, 1); PG8_SCHED; PG8_LDA(At, 1, 0); PG8_STAGE(PG8_SA(0, 1), a2 + hstep, voffA);
            PG8_WAIT_V(8); PG8_WAIT_L(0); PG8_BAR; PG8_MMA(0, 0, At, B0); PG8_MMA(0, 1, At, B1); PG8_BAR; PG8_SCHED;
            PG8_LDA(At, 1, 1); PG8_STAGE(PG8_SB(1, 0), b3, voffB); PG8_STAGE(PG8_SB(1, 1), b3 + hstep, voffB); PG8_STAGE(PG8_SA(1, 0), a3, voffA);
            PG8_WAIT_V(8); PG8_WAIT_L(0); PG8_BAR; PG8_MMA(1, 0, At, B0); PG8_MMA(1, 1, At, B1); PG8_BAR; PG8_SCHED;
            } else {
            PG8_LDB(B0, 0, 0); PG8_SCHED; PG8_LDA(At, 0, 0); PG8_STAGE(PG8_SA(1, 1), a1 + hstep, voffA);
            PG8_WAIT_L(8); PG8_BAR; PG8_WAIT_L(0); PG8_MMA(0, 0, At, B0); PG8_BAR; PG8_SCHED;
            PG8_LDB(B1, 0, 1); PG8_STAGE(PG8_SB(0, 0), b2, voffB);
            PG8_BAR; PG8_WAIT_L(0); PG8_MMA(0, 1, At, B1); PG8_BAR;
            PG8_LDA(At, 0, 1); PG8_STAGE(PG8_SA(0, 0), a2, voffA);
            PG8_BAR; PG8_WAIT_L(0); PG8_MMA(1, 0, At, B0); PG8_BAR; PG8_SCHED;
            PG8_STAGE(PG8_SB(0, 1), b2 + hstep, voffB);
            PG8_WAIT_V(6); PG8_BAR; PG8_MMA(1, 1, At, B1); PG8_BAR;
            PG8_LDB(B0, 1, 0); PG8_SCHED; PG8_LDA(At, 1, 0); PG8_STAGE(PG8_SA(0, 1), a2 + hstep, voffA);
            PG8_WAIT_L(8); PG8_BAR; PG8_WAIT_L(0); PG8_MMA(0, 0, At, B0); PG8_BAR; PG8_SCHED;
            PG8_LDB(B1, 1, 1); PG8_STAGE(PG8_SB(1, 0), b3, voffB);
            PG8_BAR; PG8_WAIT_L(0); PG8_MMA(0, 1, At, B1); PG8_BAR;
            PG8_LDA(At, 1, 1); PG8_STAGE(PG8_SA(1, 0), a3, voffA);
            PG8_BAR; PG8_WAIT_L(0); PG8_MMA(1, 0, At, B0); PG8_BAR; PG8_SCHED;
            PG8_STAGE(PG8_SB(1, 1), b3 + hstep, voffB);
            PG8_WAIT_V(6); PG8_BAR; PG8_MMA(1, 1, At, B1); PG8_BAR;
            }
        }
        if constexpr (ALIGN_EPI) { if (wr == 0) PG8_BAR; }
        if constexpr (!Epi::AFTER_DRAIN) { E(acc, cur, wr, wc, fr, fq); S.done(cur); }
        if (!has_next) break;
#pragma unroll
        for (int a = 0; a < 2; ++a)
#pragma unroll
            for (int b = 0; b < 2; ++b)
#pragma unroll
                for (int m = 0; m < 4; ++m)
#pragma unroll
                    for (int n = 0; n < 2; ++n) acc[a][b][m][n] = (f32x4){0.f, 0.f, 0.f, 0.f};
        cur = nxt; cA = nA; cB = nB; ++ui;
        if constexpr (ALIGN_EPI) { if (wr == 1) PG8_BAR; }
    }
    PG8_WAIT_V(0);
    if constexpr (!ALIGN_EPI) { if (wr == 0) PG8_BAR; }
    PG8_BAR;
    if constexpr (Epi::AFTER_DRAIN) { E.fused(acc, cur, wr, wc, fr, fq, lds, wid, lane); S.done(cur); }
#undef PG8_SA
#undef PG8_SB
#undef PG8_STAGE
#undef PG8_LDA
#undef PG8_LDB
#undef PG8_MMA
#undef PG8_WAIT_V
#undef PG8_WAIT_L
#undef PG8_BAR
#undef PG8_SCHED
}
}

namespace pg8 {
struct EpiWinPg {
    static constexpr bool PERM = false, AFTER_DRAIN = false;
    bf16_t* Z; const float* rc; const float* rs; const float* RSr;
    __device__ __forceinline__ void operator()(const f32x4 (&acc)[2][2][4][2], const Unit& u, int wr, int wc, int fr, int fq) const {
        const bool qk = u.pn >= 4 && u.pn < 8; int pn_ = u.pn; asm volatile("" : "+s"(pn_)); const float sc = pn_ < 6 ? QSCALE : 1.f;
        const int fo = 16 * (wc & 1) + 4 * fq, rowb = u.pm * BM + wr * 64 + fr;
        f32x4 cn = (f32x4){1.f, 1.f, 1.f, 1.f}, sn = (f32x4){0.f, 0.f, 0.f, 0.f}; float rn = RSr[rowb];
        if (qk) { const int t = 16 + (rowb & 4095); cn = *(const f32x4*)(rc + t * 32 + fo); sn = *(const f32x4*)(rs + t * 32 + fo); }
#pragma unroll
        for (int k = 0; k < 8; ++k) { const int ai = k >> 2, m = k & 3; const int row = rowb + ai * HALF + m * 16;
                const f32x4 c = cn, s = sn; const float rsr = rn;
                if (k + 1 < 8) { const int rown = rowb + ((k + 1) >> 2) * HALF + ((k + 1) & 3) * 16; rn = RSr[rown];
                    if (qk) { const int t = 16 + (rown & 4095); cn = *(const f32x4*)(rc + t * 32 + fo); sn = *(const f32x4*)(rs + t * 32 + fo); } }
                __builtin_amdgcn_sched_barrier(0);
                bf16_t* rowp = Z + (size_t)row * 2560 + u.pn * BM + wc * 32 + 8 * fq;
#pragma unroll
                for (int bj = 0; bj < 2; ++bj) { f32x4 v0 = acc[ai][bj][m][0] * rsr, v1 = acc[ai][bj][m][1] * rsr;
                    if (qk) { const f32x4 x1 = v0, x2 = v1; v0 = (x1 * c - x2 * s) * sc; v1 = (x2 * c + x1 * s) * sc; }
                    u32x4 w; w.x = cvt_pk_bf16(v0[0], v0[1]); w.y = cvt_pk_bf16(v0[2], v0[3]); w.z = cvt_pk_bf16(v1[0], v1[1]); w.w = cvt_pk_bf16(v1[2], v1[3]);
                    *(u32x4*)(rowp + bj * HALF) = w; } }
    }
};
template <int CTRL> __device__ __forceinline__ f32x4 dppv(f32x4 v) { f32x4 r;
#pragma unroll
    for (int i = 0; i < 4; ++i) r[i] = __builtin_bit_cast(float, __builtin_amdgcn_update_dpp(0, __builtin_bit_cast(int, v[i]), CTRL, 0xf, 0xf, true));
    return r; }
__device__ __forceinline__ float gelu_fast(float x) { return x * __builtin_amdgcn_rcpf(1.f + __builtin_amdgcn_exp2f(-2.302208198f * (x + 0.044715f * x * x * x))); }
struct EpiUpPg {
    static constexpr bool PERM = false, AFTER_DRAIN = false;
    bf16_t* HID; const float* cw; const float* cb; float* GH; float* GT; float* VH; const float* RSr;
    __device__ __forceinline__ void operator()(const f32x4 (&acc)[2][2][4][2], const Unit& u, int wr, int wc, int fr, int fq) const {
        const int hb = 128 * u.pn + 32 * wc + 8 * fq;
        f32x4 w0[2], w1[2], w2[2], bb[2];
#pragma unroll
        for (int bj = 0; bj < 2; ++bj) { w0[bj] = *(const f32x4*)(cw + hb + 4 * bj); w1[bj] = *(const f32x4*)(cw + 3072 + hb + 4 * bj); w2[bj] = *(const f32x4*)(cw + 6144 + hb + 4 * bj); bb[bj] = *(const f32x4*)(cb + hb + 4 * bj); }
        const int a1 = (fq * 16 + ((fr - 1) & 15)) << 2, a2 = (fq * 16 + ((fr - 2) & 15)) << 2;
        float rsv[2][4];
#pragma unroll
        for (int ai = 0; ai < 2; ++ai)
#pragma unroll
            for (int m = 0; m < 4; ++m) rsv[ai][m] = RSr[u.pm * BM + ai * HALF + wr * 64 + m * 16 + fr];
#pragma unroll
        for (int ai = 0; ai < 2; ++ai) { f32x4 xp[2] = {{0.f, 0.f, 0.f, 0.f}, {0.f, 0.f, 0.f, 0.f}};
#pragma unroll
            for (int m = 0; m < 4; ++m) { const int row = u.pm * BM + ai * HALF + wr * 64 + m * 16 + fr; const int blk = row >> 6; const float rsr = rsv[ai][m];
                u32x4 w;
#pragma unroll
                for (int bj = 0; bj < 2; ++bj) { const int hc = hb + 4 * bj;
                    const f32x4 x = acc[ai][bj][m][0] * rsr, v = acc[ai][bj][m][1] * rsr;
                    f32x4 p1, p2;
#pragma unroll
                    for (int i = 0; i < 4; ++i) { const float s1 = fr == 15 ? xp[bj][i] : x[i], s2 = fr >= 14 ? xp[bj][i] : x[i];
                        p1[i] = __builtin_bit_cast(float, __builtin_amdgcn_update_dpp(0, __builtin_bit_cast(int, s1), 0x121, 0xf, 0xf, false));
                        p2[i] = __builtin_bit_cast(float, __builtin_amdgcn_update_dpp(0, __builtin_bit_cast(int, s2), 0x122, 0xf, 0xf, false)); }
                    const f32x4 gc = bb[bj] + w2[bj] * x + w1[bj] * p1 + w0[bj] * p2;
                    const unsigned lo = cvt_pk_bf16(gelu_fast(gc[0]) * v[0], gelu_fast(gc[1]) * v[1]), hi = cvt_pk_bf16(gelu_fast(gc[2]) * v[2], gelu_fast(gc[3]) * v[3]);
                    if (bj == 0) { w.x = lo; w.y = hi; } else { w.z = lo; w.w = hi; }
                    if (m == 0 && fr < 2) { *(f32x4*)(GH + ((size_t)blk * 2 + fr) * 3072 + hc) = x; *(f32x4*)(VH + ((size_t)blk * 2 + fr) * 3072 + hc) = v; }
                    if (m == 3 && fr >= 14) *(f32x4*)(GT + ((size_t)blk * 2 + (fr - 14)) * 3072 + hc) = x;
                    xp[bj] = x; }
                *(u32x4*)(HID + (size_t)row * 3072 + hb) = w; } }
    }
};

struct PanelRms {
    unsigned* xbuf; unsigned* cnt; unsigned* tmo; float eps; unsigned code;
    __device__ __forceinline__ bool run(const f32x4 (&v)[2][2][4][2], int gpm, int pn, int wr, int wc, int fr, int fq, PG8_LAS unsigned char* lds, int wid, int lane) const {
        PG8_LAS float* Pp = (PG8_LAS float*)lds;
        PG8_LAS float* S = (PG8_LAS float*)(lds + 8192);
        PG8_LAS unsigned* flag = (PG8_LAS unsigned*)(lds + 8192 + 2048);
#pragma unroll
        for (int ai = 0; ai < 2; ++ai)
#pragma unroll
            for (int m = 0; m < 4; ++m) { float q = 0.f;
#pragma unroll
                for (int bj = 0; bj < 2; ++bj)
#pragma unroll
                    for (int n = 0; n < 2; ++n) { const f32x4 x = v[ai][bj][m][n]; q += (x[0] * x[0] + x[1] * x[1]) + (x[2] * x[2] + x[3] * x[3]); }
                q += __int_as_float(__builtin_amdgcn_ds_bpermute((lane ^ 16) << 2, __float_as_int(q))); q += __int_as_float(__builtin_amdgcn_ds_bpermute((lane ^ 32) << 2, __float_as_int(q)));
                if (fq == 0) Pp[(ai * HALF + wr * 64 + m * 16 + fr) * 4 + wc] = q; }
        asm volatile("s_waitcnt lgkmcnt(0)" ::: "memory"); __builtin_amdgcn_s_barrier(); asm volatile("" ::: "memory");
        const int row = wid * 32 + (lane & 31);
        if (lane < 32) { const float t = (Pp[row * 4 + 0] + Pp[row * 4 + 1]) + (Pp[row * 4 + 2] + Pp[row * 4 + 3]);
            __hip_atomic_store(xbuf + ((size_t)(gpm * BM + row) * 4 + pn), __float_as_uint(t), __ATOMIC_RELAXED, __HIP_MEMORY_SCOPE_AGENT); }
        asm volatile("s_waitcnt vmcnt(0)" ::: "memory");
        if (lane == 0) __hip_atomic_fetch_add(cnt + 64 * gpm, 1u, __ATOMIC_RELAXED, __HIP_MEMORY_SCOPE_AGENT);
        if (wid == 0) {
            bool dead = false; const unsigned long long t0 = __builtin_amdgcn_s_memrealtime();
            for (;;) {
                if ((unsigned)__builtin_amdgcn_readfirstlane(__hip_atomic_load(cnt + 64 * gpm, __ATOMIC_RELAXED, __HIP_MEMORY_SCOPE_AGENT)) >= 32u) break;
                if (__builtin_amdgcn_s_memrealtime() - t0 > 2000000ull) {
                    if (lane == 0) { unsigned expect = 0u; __hip_atomic_compare_exchange_strong(tmo + 1, &expect, code | (unsigned)(gpm & 0xff), __ATOMIC_RELAXED, __ATOMIC_RELAXED, __HIP_MEMORY_SCOPE_AGENT);
                                     __hip_atomic_store(tmo, 1u, __ATOMIC_RELAXED, __HIP_MEMORY_SCOPE_AGENT); }
                    dead = true; break; }
                __builtin_amdgcn_s_sleep(2);
            }
            __builtin_amdgcn_fence(__ATOMIC_ACQUIRE, "agent");
            if (lane == 0) flag[0] = dead ? 1u : 0u;
        }
        asm volatile("s_waitcnt vmcnt(0) lgkmcnt(0)" ::: "memory"); __builtin_amdgcn_s_barrier(); asm volatile("" ::: "memory");
        const bool bad = flag[0] != 0u;
        if (lane < 32) { const unsigned* slot = xbuf + (size_t)(gpm * BM + row) * 4; float t = 0.f;
#pragma unroll
            for (int k = 0; k < 4; ++k) t += __uint_as_float(__hip_atomic_load(slot + k, __ATOMIC_RELAXED, __HIP_MEMORY_SCOPE_AGENT));
            S[row] = 1.0f / sqrtf(t * (1.0f / 1024.0f) + eps); }
        asm volatile("s_waitcnt lgkmcnt(0)" ::: "memory"); __builtin_amdgcn_s_barrier(); asm volatile("" ::: "memory");
        return bad;
    }
};
template <bool HASNEXT> struct EpiRmsRes {
    static constexpr bool PERM = false, AFTER_DRAIN = true;
    const float* base; float* out; bf16_t* xn; const float* gpost; const float* gnext; PanelRms st1, st2; int pm_off, pad;
    __device__ __forceinline__ void fused(f32x4 (&acc)[2][2][4][2], const Unit& u, int wr, int wc, int fr, int fq, PG8_LAS unsigned char* lds, int wid, int lane) const {
        typedef unsigned u32x2v __attribute__((ext_vector_type(2)));
        const PG8_LAS float* S = (const PG8_LAS float*)(lds + 8192);
        const int gpm = u.pm + pm_off, col0 = u.pn * BM + wc * 32 + 4 * fq;
        bool bad = st1.run(acc, gpm, u.pn, wr, wc, fr, fq, lds, wid, lane);
        const float qnan = __builtin_nanf("");
#pragma unroll
        for (int ai = 0; ai < 2; ++ai)
#pragma unroll
            for (int m = 0; m < 4; ++m) { int r = ai * HALF + wr * 64 + m * 16 + fr; asm volatile("" : "+v"(r)); const float rs = S[r]; const size_t off = (size_t)(gpm * BM + r) * 1024 + col0;
#pragma unroll
                for (int bj = 0; bj < 2; ++bj)
#pragma unroll
                    for (int n = 0; n < 2; ++n) { const f32x4 bs = *(const f32x4*)(base + off + bj * HALF + n * 16), gq = *(const f32x4*)(gpost + col0 + bj * HALF + n * 16); acc[ai][bj][m][n] = bs + acc[ai][bj][m][n] * rs * gq; }
                asm volatile("" : "+v"(acc[ai][0][m][0]), "+v"(acc[ai][0][m][1]), "+v"(acc[ai][1][m][0]), "+v"(acc[ai][1][m][1]));
                asm volatile("" ::: "memory"); }
        if constexpr (!HASNEXT) {
#pragma unroll
            for (int ai = 0; ai < 2; ++ai)
#pragma unroll
                for (int m = 0; m < 4; ++m) { int r = ai * HALF + wr * 64 + m * 16 + fr; asm volatile("" : "+v"(r)); const size_t off = (size_t)(gpm * BM + r) * 1024 + col0;
#pragma unroll
                    for (int bj = 0; bj < 2; ++bj)
#pragma unroll
                        for (int n = 0; n < 2; ++n) *(f32x4*)(out + off + bj * HALF + n * 16) = bad ? (f32x4){qnan, qnan, qnan, qnan} : acc[ai][bj][m][n]; }
            return;
        }
        if constexpr (HASNEXT) {
        const bool bad1 = bad;
        bad = st2.run(acc, gpm, u.pn, wr, wc, fr, fq, lds, wid, lane) || bad;
#pragma unroll
        for (int ai = 0; ai < 2; ++ai)
#pragma unroll
            for (int m = 0; m < 4; ++m) { int r = ai * HALF + wr * 64 + m * 16 + fr; asm volatile("" : "+v"(r)); const float rs = S[r]; const size_t off = (size_t)(gpm * BM + r) * 1024 + col0;
#pragma unroll
                for (int bj = 0; bj < 2; ++bj)
#pragma unroll
                    for (int n = 0; n < 2; ++n) { const f32x4 x1 = acc[ai][bj][m][n]; *(f32x4*)(out + off + bj * HALF + n * 16) = bad1 ? (f32x4){qnan, qnan, qnan, qnan} : x1;
                        const f32x4 o = x1 * rs * *(const f32x4*)(gnext + col0 + bj * HALF + n * 16); u32x2v w; w.x = cvt_pk_bf16(o[0], o[1]); w.y = cvt_pk_bf16(o[2], o[3]);
                        if (bad) { w.x = 0x7fc07fc0u; w.y = 0x7fc07fc0u; } *(u32x2v*)(xn + off + bj * HALF + n * 16) = w; }
                asm volatile("" ::: "memory"); }
        }
    }
};
struct EpiF32Pg {
    static constexpr bool PERM = false, AFTER_DRAIN = false;
    float* C; int ldc;
    __device__ __forceinline__ void operator()(const f32x4 (&acc)[2][2][4][2], const Unit& u, int wr, int wc, int fr, int fq) const {
        const int row0 = u.pm * BM + wr * 64 + fr, col0 = u.pn * BM + wc * 32 + 4 * fq;
#pragma unroll
        for (int ai = 0; ai < 2; ++ai)
#pragma unroll
            for (int m = 0; m < 4; ++m) { float* rowp = C + (size_t)(row0 + ai * HALF + m * 16) * ldc + col0;
#pragma unroll
                for (int bj = 0; bj < 2; ++bj)
#pragma unroll
                    for (int n = 0; n < 2; ++n) *(f32x4*)(rowp + bj * HALF + n * 16) = acc[ai][bj][m][n]; }
    }
};
}


constexpr int CW_META = 8192;
template <class Epi>
__device__ __forceinline__ void meta_gemm(const bf16_t* A, const bf16_t* Bt, int N, int K, const Epi& epi, unsigned char* lds, int wv) {
    const int tile = blockIdx.x;
    if (tile >= N / 32) return;
    const int lane = otid(wv) & 63, fr = lane & 15, fq = lane >> 4;
    f32x4 acc[1][2]; acc[0][0] = (f32x4){0.f, 0.f, 0.f, 0.f}; acc[0][1] = (f32x4){0.f, 0.f, 0.f, 0.f};
    const int kw = K / 8;
    const bf16_t* Ap = A + (size_t)fr * K + fq * 8 + wv * kw;
    const bf16_t* Bp = Bt + (size_t)(tile * 32 + fr) * K + fq * 8 + wv * kw;
    if (K == 1024) {
        bf16x8 a[4], b0[4], b1[4];
#pragma unroll
        for (int i = 0; i < 4; ++i) { a[i] = *(const bf16x8*)(Ap + 32 * i); b0[i] = *(const bf16x8*)(Bp + 32 * i); b1[i] = *(const bf16x8*)(Bp + (size_t)16 * 1024 + 32 * i); }
        __builtin_amdgcn_sched_barrier(0);
#pragma unroll
        for (int i = 0; i < 4; ++i) { acc[0][0] = __builtin_amdgcn_mfma_f32_16x16x32_bf16(b0[i], a[i], acc[0][0], 0, 0, 0); acc[0][1] = __builtin_amdgcn_mfma_f32_16x16x32_bf16(b1[i], a[i], acc[0][1], 0, 0, 0); }
    } else {
        bf16x8 a[12], b0[12], b1[12];
#pragma unroll
        for (int i = 0; i < 12; ++i) { a[i] = *(const bf16x8*)(Ap + 32 * i); b0[i] = *(const bf16x8*)(Bp + 32 * i); b1[i] = *(const bf16x8*)(Bp + (size_t)16 * 3072 + 32 * i); }
        __builtin_amdgcn_sched_barrier(0);
#pragma unroll
        for (int i = 0; i < 12; ++i) { acc[0][0] = __builtin_amdgcn_mfma_f32_16x16x32_bf16(b0[i], a[i], acc[0][0], 0, 0, 0); acc[0][1] = __builtin_amdgcn_mfma_f32_16x16x32_bf16(b1[i], a[i], acc[0][1], 0, 0, 0); }
    }
    f32x4* red = (f32x4*)lds;
    red[(wv * 2 + 0) * 64 + lane] = acc[0][0]; red[(wv * 2 + 1) * 64 + lane] = acc[0][1];
    __syncthreads();
    if (wv == 0) {
#pragma unroll
        for (int w = 1; w < 8; ++w) { acc[0][0] += red[(w * 2 + 0) * 64 + lane]; acc[0][1] += red[(w * 2 + 1) * 64 + lane]; }
        epi.template run<1, 2>(acc, 0, tile * 32, fr, fq);
    }
    __syncthreads();
}
__device__ __forceinline__ void meta_norm_last(unsigned* cnt, int ntiles, const float* Ym, const float* Hm_base, float* Hm, const float* gpost, float* RSm, bf16_t* Um, unsigned char* lds, int wv) {
    if ((int)blockIdx.x >= ntiles) return;
    const int lane = otid(wv) & 63;
    volatile unsigned* flag = (volatile unsigned*)(lds + 16384);
    if (wv == 0) {
        asm volatile("s_waitcnt vmcnt(0)" ::: "memory");
        __builtin_amdgcn_fence(__ATOMIC_RELEASE, "agent");
        asm volatile("s_waitcnt vmcnt(0)" ::: "memory");
        unsigned old = 0u;
        if (lane == 0) old = __hip_atomic_fetch_add(cnt, 1u, __ATOMIC_RELAXED, __HIP_MEMORY_SCOPE_AGENT);
        old = (unsigned)__builtin_amdgcn_readfirstlane((int)old);
        const bool last = old == (unsigned)(ntiles - 1);
        if (last) { __builtin_amdgcn_fence(__ATOMIC_ACQUIRE, "agent"); asm volatile("s_waitcnt vmcnt(0)" ::: "memory"); }
        if (lane == 0) *flag = last ? 1u : 0u;
    }
    __syncthreads();
    const bool last = *flag != 0u;
    __syncthreads();
    if (!last) return;
#pragma unroll
    for (int rr = 0; rr < 2; ++rr) { const int row = 2 * wv + rr;
        const float* y = Ym + row * DM; const float* bs = Hm_base + row * DM; float* ho = Hm + row * DM;
        f32x4 v[4]; float s = 0.f;
#pragma unroll
        for (int j = 0; j < 4; ++j) { v[j] = *(const f32x4*)(y + 4 * lane + 256 * j); s += (v[j].x * v[j].x + v[j].y * v[j].y) + (v[j].z * v[j].z + v[j].w * v[j].w); }
        const float r = rsqrtf(wave_sum(s, lane) * (1.f / DM) + 1e-6f);
        float s2 = 0.f;
#pragma unroll
        for (int j = 0; j < 4; ++j) { const f32x4 g = *(const f32x4*)(gpost + 4 * lane + 256 * j), bb = *(const f32x4*)(bs + 4 * lane + 256 * j);
            v[j] = bb + v[j] * r * g; *(f32x4*)(ho + 4 * lane + 256 * j) = v[j];
            s2 += (v[j].x * v[j].x + v[j].y * v[j].y) + (v[j].z * v[j].z + v[j].w * v[j].w); }
        if (RSm) {
            const float r2 = rsqrtf(wave_sum(s2, lane) * (1.f / DM) + 1e-6f);
            if (lane == 0) RSm[row] = r2;
            bf16_t* uo = Um + row * DM;
#pragma unroll
            for (int j = 0; j < 4; ++j) { u32x2 w; w.x = pk2(v[j].x, v[j].y); w.y = pk2(v[j].z, v[j].w); *(u32x2*)(uo + 4 * lane + 256 * j) = w; }
        }
    }
}
__device__ __forceinline__ void ph_meta_norm(const float* Ym, const float* Hm_base, float* Hm, const float* gpost, float* RSm, bf16_t* Um, int wv) {
    const int row = ((int)gridDim.x - 1 - (int)blockIdx.x) * 8 + wv;
    if (row >= NMETA) return;
    const int lane = otid(wv) & 63;
    const float* y = Ym + row * DM; const float* bs = Hm_base + row * DM; float* ho = Hm + row * DM;
    f32x4 v[4], g[4], bb[4]; float s = 0.f;
#pragma unroll
    for (int j = 0; j < 4; ++j) { v[j] = *(const f32x4*)(y + 4 * lane + 256 * j); g[j] = *(const f32x4*)(gpost + 4 * lane + 256 * j); bb[j] = *(const f32x4*)(bs + 4 * lane + 256 * j); }
#pragma unroll
    for (int j = 0; j < 4; ++j) s += (v[j].x * v[j].x + v[j].y * v[j].y) + (v[j].z * v[j].z + v[j].w * v[j].w);
    const float r = rsqrtf(wave_sum(s, lane) * (1.f / DM) + 1e-6f);
    float s2 = 0.f;
#pragma unroll
    for (int j = 0; j < 4; ++j) { v[j] = bb[j] + v[j] * r * g[j]; *(f32x4*)(ho + 4 * lane + 256 * j) = v[j];
        s2 += (v[j].x * v[j].x + v[j].y * v[j].y) + (v[j].z * v[j].z + v[j].w * v[j].w); }
    if (RSm) {
        const float r2 = rsqrtf(wave_sum(s2, lane) * (1.f / DM) + 1e-6f);
        if (lane == 0) RSm[row] = r2;
        bf16_t* uo = Um + row * DM;
#pragma unroll
        for (int j = 0; j < 4; ++j) { u32x2 w; w.x = pk2(v[j].x, v[j].y); w.y = pk2(v[j].z, v[j].w); *(u32x2*)(uo + 4 * lane + 256 * j) = w; }
    }
}
struct EpiUpMeta {
    bf16_t* HIDm; float* GM; const float* cw; const float* cb; const float* RSr;
    template <int MT, int NTL> __device__ __forceinline__ void run(const f32x4 (&acc)[MT][NTL], int row0, int col0, int fr, int fq) const {
        const int s = col0 & 255, hc = 128 * (col0 >> 8) + 32 * ((s >> 5) & 3) + 8 * fq + 4 * ((s >> 7) & 1);
        const float rsr = RSr[fr]; const f32x4 x = acc[0][0] * rsr, v = acc[0][1] * rsr;
        const int a1 = (fq * 16 + ((fr - 1) & 15)) << 2, a2 = (fq * 16 + ((fr - 2) & 15)) << 2;
        f32x4 p1, p2;
#pragma unroll
        for (int i = 0; i < 4; ++i) { const float t1 = __int_as_float(__builtin_amdgcn_ds_bpermute(a1, __float_as_int(x[i]))), t2 = __int_as_float(__builtin_amdgcn_ds_bpermute(a2, __float_as_int(x[i])));
            p1[i] = fr >= 1 ? t1 : 0.f; p2[i] = fr >= 2 ? t2 : 0.f; }
        const f32x4 w0 = *(const f32x4*)(cw + hc), w1 = *(const f32x4*)(cw + DFF + hc), w2 = *(const f32x4*)(cw + 2 * DFF + hc), bb = *(const f32x4*)(cb + hc);
        const f32x4 gc = bb + w2 * x + w1 * p1 + w0 * p2;
        u32x2 w; w.x = pk2(gelu_tanh(gc[0]) * v[0], gelu_tanh(gc[1]) * v[1]); w.y = pk2(gelu_tanh(gc[2]) * v[2], gelu_tanh(gc[3]) * v[3]);
        *(u32x2*)(HIDm + (size_t)fr * DFF + hc) = w;
        if (fr >= 14) *(f32x4*)(GM + (size_t)(fr - 14) * DFF + hc) = x;
    }
};
__device__ __forceinline__ float gelu_fast(float x) { return x * __builtin_amdgcn_rcpf(1.f + __builtin_amdgcn_exp2f(-2.302208198f * (x + 0.044715f * x * x * x))); }
__device__ __forceinline__ void ph_ffnfix(const P& p, int l, int wv) {
    constexpr int Q = DFF / 4;
    const int tg = blockIdx.x * NT + otid(wv);
    if (tg >= Q * 128) return;
    const int c = (tg % Q) * 4, grp = tg / Q;
    const float* GH = (const float*)(p.ws + WS_GH); const float* GT = (const float*)(p.ws + WS_GT); const float* VH = (const float*)(p.ws + WS_VH); const float* GM = (const float*)(p.ws + WS_GVM);
    bf16_t* HID = (bf16_t*)(p.ws + WS_HID);
    const float* cw = p.in[22] + (size_t)l * 3 * DFF; const float* cb = p.in[23] + (size_t)l * DFF;
    f32x4 h0[4], h1[4], t0[4], t1[4], v0[4], v1[4];
#pragma unroll
    for (int k = 0; k < 4; ++k) { const int blk = grp * 4 + k;
        const float* tp0 = (blk & 63) == 0 ? GM + c : GT + ((size_t)(blk - 1) * 2 + 0) * DFF + c;
        const float* tp1 = (blk & 63) == 0 ? GM + DFF + c : GT + ((size_t)(blk - 1) * 2 + 1) * DFF + c;
        t0[k] = *(const f32x4*)tp0; t1[k] = *(const f32x4*)tp1;
        h0[k] = *(const f32x4*)(GH + ((size_t)blk * 2 + 0) * DFF + c); h1[k] = *(const f32x4*)(GH + ((size_t)blk * 2 + 1) * DFF + c);
        v0[k] = *(const f32x4*)(VH + ((size_t)blk * 2 + 0) * DFF + c); v1[k] = *(const f32x4*)(VH + ((size_t)blk * 2 + 1) * DFF + c); }
    const f32x4 w0 = *(const f32x4*)(cw + c), w1 = *(const f32x4*)(cw + DFF + c), w2 = *(const f32x4*)(cw + 2 * DFF + c), bb = *(const f32x4*)(cb + c);
#pragma unroll
    for (int k = 0; k < 4; ++k) { const int blk = grp * 4 + k;
        const f32x4 xa = bb + w2 * h0[k] + w1 * t1[k] + w0 * t0[k], xb = bb + w2 * h1[k] + w1 * h0[k] + w0 * t1[k];
        u32x2 wa; wa.x = pk2(gelu_fast(xa[0]) * v0[k][0], gelu_fast(xa[1]) * v0[k][1]); wa.y = pk2(gelu_fast(xa[2]) * v0[k][2], gelu_fast(xa[3]) * v0[k][3]);
        u32x2 wb; wb.x = pk2(gelu_fast(xb[0]) * v1[k][0], gelu_fast(xb[1]) * v1[k][1]); wb.y = pk2(gelu_fast(xb[2]) * v1[k][2], gelu_fast(xb[3]) * v1[k][3]);
        *(u32x2*)(HID + ((size_t)blk * 64 + 0) * DFF + c) = wa; *(u32x2*)(HID + ((size_t)blk * 64 + 1) * DFF + c) = wb; }
}

#define LAS __attribute__((address_space(3)))
#define XB_TMO      128
#define XB_XCNT(j)  (256  + 64 * (j))
#define XB_XSUB(j)  (1280 + 64 * (j))
#define XB_XGEN(j)  (2304 + 64 * (j))
#define XB_TOP      3328
#define XB_TOPGEN   3392
#define XCD_BAR_WORDS 3456
#define XB_SPIN_CAP (1u << 22)
__device__ __forceinline__ unsigned xb_ld(unsigned* p)              { return __hip_atomic_load(p, __ATOMIC_RELAXED, __HIP_MEMORY_SCOPE_AGENT); }
__device__ __forceinline__ unsigned xb_add(unsigned* p, unsigned v) { return __hip_atomic_fetch_add(p, v, __ATOMIC_RELAXED, __HIP_MEMORY_SCOPE_AGENT); }
__device__ __forceinline__ unsigned xb_xcc_id() { return (unsigned)__builtin_amdgcn_s_getreg((3 << 11) | 20) & 0xFu; }
#define XB_SPIN(cond, bar) do { unsigned _sp = 0; while (cond) { __builtin_amdgcn_s_sleep(1); \
    if ((++_sp & 255u) == 0u) { if (xb_ld(&(bar)[XB_TMO])) break; if (_sp > XB_SPIN_CAP) { atomicAdd(&(bar)[XB_TMO], 1u); break; } } } } while (0)
struct XcdBarrier { unsigned* bar; unsigned x; volatile LAS unsigned* st; };
__device__ __forceinline__ XcdBarrier xcd_barrier_post(unsigned* bar, volatile LAS unsigned* st) {
    XcdBarrier b; b.bar = bar; b.x = xb_xcc_id(); b.st = st;
    if (threadIdx.x == 0) (void)xb_add(&bar[XB_XCNT(b.x)], 1u);
    return b;
}
__device__ __forceinline__ void xcd_barrier_complete(unsigned* bar, unsigned x, unsigned& nloc, unsigned& nx) {
    const unsigned G = gridDim.x * gridDim.y * gridDim.z;
    unsigned sum, cnt, mine, sp = 0u;
    for (;;) {
        sum = 0u; cnt = 0u; mine = 0u;
#pragma unroll
        for (unsigned j = 0; j < 16; ++j) { const unsigned c = xb_ld(&bar[XB_XCNT(j)]); sum += c; cnt += (c > 0u) ? 1u : 0u; mine = (j == x) ? c : mine; }
        if (sum == G) break;
        __builtin_amdgcn_s_sleep(1);
        if ((++sp & 255u) == 0u) { if (xb_ld(&bar[XB_TMO])) break; if (sp > XB_SPIN_CAP) { atomicAdd(&bar[XB_TMO], 1u); break; } }
    }
    nloc = mine > 0u ? mine : 1u; nx = cnt > 0u ? cnt : 1u;
}
template <bool FILL>
__device__ __forceinline__ void xcd_barrier(const XcdBarrier& b, int wv, const P* pp = nullptr, unsigned char* ldsf = nullptr, int fk = -1) {
    const bool t0 = otid(wv) == 0;
    asm volatile("s_waitcnt vmcnt(0)" ::: "memory");
    __syncthreads();
    if (FILL && wv != 0) fill_item(*pp, ldsf, fk, wv);
    if (t0) {
        unsigned* bar = b.bar;
        __builtin_amdgcn_s_waitcnt(0);
        unsigned nloc = b.st[0], nx = b.st[1];
        if (nloc == 0u) { xcd_barrier_complete(bar, b.x, nloc, nx); b.st[0] = nloc; b.st[1] = nx; }
        const unsigned old = xb_add(&bar[XB_XSUB(b.x)], 1u);
        const unsigned gen = old / nloc;
        if (old + 1u == (gen + 1u) * nloc) {
            __builtin_amdgcn_fence(__ATOMIC_RELEASE, "agent");
            asm volatile("s_waitcnt vmcnt(0)" ::: "memory");
            const unsigned og = xb_add(&bar[XB_TOP], 1u);
            const unsigned tg = og / nx;
            if (og + 1u == (tg + 1u) * nx) xb_add(&bar[XB_TOPGEN], 1u);
            else XB_SPIN(xb_ld(&bar[XB_TOPGEN]) == tg, bar);
            __builtin_amdgcn_fence(__ATOMIC_ACQUIRE, "agent");
            xb_add(&bar[XB_XGEN(b.x)], 1u);
            asm volatile("s_waitcnt vmcnt(0)" ::: "memory");
        } else {
            XB_SPIN(xb_ld(&bar[XB_XGEN(b.x)]) == gen, bar);
            __builtin_amdgcn_fence(__ATOMIC_ACQUIRE, "agent");
            asm volatile("s_waitcnt vmcnt(0)" ::: "memory");
        }
    }
    __syncthreads();
}

constexpr int LDS_BYTES = 147456;
constexpr int MISC_OFF = 131072 + 320;
constexpr size_t CTL_ZERO_BYTES = 512 << 10;

__global__ void __launch_bounds__(NT, 2) mk_fwd(P p) {
    extern __shared__ __attribute__((aligned(16))) unsigned char lds[];
    volatile LAS unsigned* MISC = (volatile LAS unsigned*)((LAS unsigned char*)lds + MISC_OFF);
    const int wv = __builtin_amdgcn_readfirstlane(threadIdx.x >> 6);
    if (threadIdx.x < 32) MISC[threadIdx.x] = 0u;
    __syncthreads();
    { unsigned* bp0_ = (unsigned*)p.ws; asm volatile("" : "+s"(bp0_)); (void)xcd_barrier_post(bp0_, MISC + 8); }
#define GRID_BAR() do { XcdBarrier b_; unsigned* bp_ = (unsigned*)p.ws; asm volatile("" : "+s"(bp_)); b_.bar = bp_; b_.x = xb_xcc_id(); b_.st = MISC + 8; xcd_barrier<false>(b_, wv); } while (0)
#define GRID_BAR_FILL(k) do { XcdBarrier b_; unsigned* bp_ = (unsigned*)p.ws; asm volatile("" : "+s"(bp_)); b_.bar = bp_; b_.x = xb_xcc_id(); b_.st = MISC + 8; xcd_barrier<true>(b_, wv, &p, lds, (k)); } while (0)
    unsigned char* ws = p.ws;
    bf16_t* U = (bf16_t*)(ws + WS_U); bf16_t* Um = (bf16_t*)(ws + WS_META + M_U);
    bf16_t* YC = (bf16_t*)(ws + WS_YC); bf16_t* YCm = (bf16_t*)(ws + WS_META + M_YC);
    float* Hm = (float*)(ws + WS_META + M_H); float* Ym = (float*)(ws + WS_META + M_Y);
    const float* rc = (const float*)(ws + WS_ROPEC); const float* rs = (const float*)(ws + WS_ROPES);

    ph_prologue(p, lds, wv);
    GRID_BAR_FILL(0);
#pragma unroll 1
    for (int l = 0; l < DEPTH; ++l) {
        unsigned char* wb = ws + WS_W + l * W_LAYER;
        const bf16_t* Win = (const bf16_t*)(wb + OFF_WIN); const bf16_t* Wout = (const bf16_t*)(wb + OFF_WOUT); const bf16_t* Wup = (const bf16_t*)(wb + OFF_WUP); const bf16_t* Wdn = (const bf16_t*)(wb + OFF_WDN);
        { int wv2 = wv; asm volatile("" : "+s"(wv2)); unsigned char* wsl = ws; asm volatile("" : "+s"(wsl));
          meta_gemm(Um, Win, INW, DM, EpiWin{(bf16_t*)(wsl + WS_META + M_ZB), rc, rs, (const float*)(wsl + WS_META + M_RS), 1, 0}, lds, wv2); }
        { pg8::Gemm g{U, Win, MR, INW, DM}; pg8::StaticOrder S; S.init(MR, INW, (int)gridDim.x, (int)blockIdx.x);
          pg8::EpiWinPg E{(bf16_t*)(ws + WS_ZB), rc, rs, (const float*)(ws + WS_RS)};
          pg8::gemm_phase<pg8::EpiWinPg, pg8::StaticOrder, true, true>((PG8_LAS unsigned char*)lds, g, S, E, wv); }
        GRID_BAR_FILL(l == 0 ? 1 : -1);
        lru::phase<0>(p, l, lds, wv);
        ph_lru(p, l, lds, wv);
        GRID_BAR_FILL(l == 0 ? 2 : -1);
        att::phase(p, l, lds, wv);
        ph_attn_meta(p, l, lds, wv);
        __syncthreads();
        lru::phase<1>(p, l, lds, wv);
        ph_lrunorm(p, l, wv);
        GRID_BAR_FILL(l == 0 ? 3 : -1);
        meta_gemm(YCm, Wout, DM, DM, EpiF32{Ym, DM, 0}, lds, wv);
        { pg8::Gemm g{YC, Wout, MR, DM, DM}; pg8::StaticOrder S; S.init(MR, DM, (int)gridDim.x, (int)blockIdx.x);
          pg8::EpiBf16<0> E{(bf16_t*)(ws + WS_YB1), DM, nullptr, 0, 0, 1.f};
          pg8::gemm_phase<pg8::EpiBf16<0>, pg8::StaticOrder, true, true>((PG8_LAS unsigned char*)lds, g, S, E, wv); }
        GRID_BAR_FILL(l == 0 ? 4 : -1);
        ph_meta_norm(Ym, l == 0 ? p.in[1] : Hm, Hm, p.in[3] + l * DM, (float*)(ws + WS_META + M_RS), Um, wv);
        ph_normres2((const bf16_t*)(ws + WS_YB1), U, p.in[3] + l * DM, (float*)(ws + WS_RS), nullptr, wv);
        GRID_BAR_FILL(l == 0 ? 5 : -1);
        meta_gemm(Um, Wup, 2 * DFF, DM, EpiUpMeta{(bf16_t*)(ws + WS_META + M_HID), (float*)(ws + WS_GVM), p.in[22] + (size_t)l * 3 * DFF, p.in[23] + (size_t)l * DFF, (const float*)(ws + WS_META + M_RS)}, lds, wv);
        { pg8::Gemm g{U, Wup, MR, 2 * DFF, DM}; pg8::StaticOrder S; S.init(MR, 2 * DFF, (int)gridDim.x, (int)blockIdx.x);
          pg8::EpiUpPg E{(bf16_t*)(ws + WS_HID), p.in[22] + (size_t)l * 3 * DFF, p.in[23] + (size_t)l * DFF, (float*)(ws + WS_GH), (float*)(ws + WS_GT), (float*)(ws + WS_VH), (const float*)(ws + WS_RS)};
          pg8::gemm_phase<pg8::EpiUpPg, pg8::StaticOrder, true, true>((PG8_LAS unsigned char*)lds, g, S, E, wv); }
        GRID_BAR_FILL(l == 0 ? 6 : -1);
        ph_ffnfix(p, l, wv);
        GRID_BAR();
        meta_gemm((const bf16_t*)(ws + WS_META + M_HID), Wdn, DM, DFF, EpiF32{Ym, DM, 0}, lds, wv);
        { pg8::Gemm g{(const bf16_t*)(ws + WS_HID), Wdn, MR, DM, DFF}; pg8::StaticOrder S; S.init(MR, DM, (int)gridDim.x, (int)blockIdx.x);
          pg8::EpiBf16<0> E{(bf16_t*)(ws + WS_YB2), DM, nullptr, 0, 0, 1.f};
          pg8::gemm_phase<pg8::EpiBf16<0>, pg8::StaticOrder, true, true>((PG8_LAS unsigned char*)lds, g, S, E, wv); }
        GRID_BAR();
        if (l + 1 < DEPTH) ph_meta_norm(Ym, Hm, Hm, p.in[5] + l * DM, (float*)(ws + WS_META + M_RS), Um, wv);
        ph_normres2((const bf16_t*)(ws + WS_YB2), U, p.in[5] + l * DM, (float*)(ws + WS_RS), l + 1 < DEPTH ? nullptr : p.out, wv);
        if (l + 1 < DEPTH) GRID_BAR();
    }
}

extern "C" void kernel_launch(void* const* d_in, const int* in_sizes, int n_in, void* d_out, int out_size, void* d_ws, size_t ws_size, hipStream_t stream) {
    static int grid = 0;
    if (grid == 0) {
        if (n_in != 25 || ws_size < WS_END) { fprintf(stderr, "kernel_launch: unexpected n_in %d or ws_size %zu\n", n_in, ws_size); grid = -1; return; }
        int dev = 0, cus = 0, per_cu = 0;
        hipGetDevice(&dev);
        hipDeviceGetAttribute(&cus, hipDeviceAttributeMultiprocessorCount, dev);
        if (hipFuncSetAttribute((const void*)mk_fwd, hipFuncAttributeMaxDynamicSharedMemorySize, LDS_BYTES) != hipSuccess) { fprintf(stderr, "kernel_launch: hipFuncSetAttribute failed\n"); grid = -1; return; }
        hipOccupancyMaxActiveBlocksPerMultiprocessor(&per_cu, (const void*)mk_fwd, NT, LDS_BYTES);
        (void)hipGetLastError();
        if (per_cu < 1) { fprintf(stderr, "kernel_launch: occupancy query says %d blocks/CU\n", per_cu); per_cu = 1; }
        if (cus != 256) { fprintf(stderr, "kernel_launch: built for 256 CUs (one 256x256 unit per workgroup in the fused-norm GEMM phases), device has %d\n", cus); grid = -1; return; }
        grid = cus;
    }
    if (grid < 0) return;
    hipMemsetAsync(d_ws, 0, CTL_ZERO_BYTES, stream);
    P p{};
    for (int i = 0; i < 25; ++i) p.in[i] = (const float*)d_in[i];
    p.out = (float*)d_out; p.ws = (unsigned char*)d_ws;
    void* args[] = {&p};
    hipError_t e = hipLaunchCooperativeKernel((const void*)mk_fwd, dim3(grid), dim3(NT), args, LDS_BYTES, stream);
    if (e != hipSuccess) fprintf(stderr, "kernel_launch: cooperative launch failed: %s (grid %d)\n", hipGetErrorString(e), grid);
}
```

```cpp
#include <hip/hip_runtime.h>
#include <cstdint>
#include <cstdio>

typedef unsigned short bf16_t;
typedef short bf16x8 __attribute__((ext_vector_type(8)));
typedef float f32x4 __attribute__((ext_vector_type(4)));
typedef unsigned u32x2 __attribute__((ext_vector_type(2)));
typedef unsigned u32x4 __attribute__((ext_vector_type(4)));

constexpr int DM = 1024, NBATCH = 8, SEQ = 4096, NMETA = 16, TT = SEQ + NMETA, DEPTH = 2;
constexpr int MR = NBATCH * SEQ;
constexpr int LRUW = 512, NH = 4, DFF = 3072, INW = 2560;
constexpr int NT = 512;
constexpr float QSCALE = 0.125f * 1.4426950408889634f;

constexpr size_t MiB = 1u << 20;
constexpr size_t WS_W = 2 * MiB, W_LAYER = 25 * MiB;
constexpr size_t OFF_WIN = 0, OFF_WOUT = 5 * MiB, OFF_WUP = 7 * MiB, OFF_WDN = 19 * MiB;
constexpr size_t WS_ROPEC = 52 * MiB, WS_ROPES = 53 * MiB;
constexpr size_t WS_META = 54 * MiB;
constexpr size_t M_H = 0, M_U = 64 << 10, M_ZB = 128 << 10, M_T1 = 256 << 10, M_YC = 320 << 10, M_Y = 384 << 10, M_GV = 512 << 10, M_HID = 768 << 10;
constexpr size_t WS_WG = 55 * MiB;
constexpr size_t WS_CA = 56 * MiB, WS_CB = 58 * MiB;
constexpr size_t M_HME = 896 << 10;
constexpr size_t WS_GVM = 60 * MiB;
constexpr size_t WS_GH = 128 * MiB, WS_GT = 140 * MiB, WS_VH = 152 * MiB;
constexpr size_t WS_XA = 61 * MiB, WS_XB = 62 * MiB;
constexpr int CW_SEAM = 16384, SEAM_BANK = 128 * 64;
constexpr size_t WS_RS = 63 * MiB;
constexpr size_t M_RS = 960 << 10;
constexpr size_t WS_YB1 = 192 * MiB, WS_YB2 = 128 * MiB;
constexpr size_t WS_U = 64 * MiB, WS_YC = 128 * MiB, WS_ZB = 192 * MiB, WS_T1 = 352 * MiB, WS_Y1 = 384 * MiB;
constexpr size_t WS_GV = 128 * MiB, WS_HID = 320 * MiB, WS_Y2 = 128 * MiB, WS_END = 512 * MiB;

struct P { const float* in[25]; float* out; unsigned char* ws; };

__device__ __forceinline__ float bf2f(bf16_t v) { return __uint_as_float((unsigned)v << 16); }
__device__ __forceinline__ unsigned f2bf(float f) { unsigned u = __float_as_uint(f); return (u + 0x7fffu + ((u >> 16) & 1u)) >> 16; }
__device__ __forceinline__ unsigned pk2(float lo, float hi) { return f2bf(lo) | (f2bf(hi) << 16); }
__device__ __forceinline__ float shx(float v, int mask, int lane) { return __int_as_float(__builtin_amdgcn_ds_bpermute((lane ^ mask) << 2, __float_as_int(v))); }
__device__ __forceinline__ float wave_sum(float v, int lane) {
#pragma unroll
    for (int o = 1; o < 64; o <<= 1) v += shx(v, o, lane);
    return v;
}
__device__ __forceinline__ float wave_max(float v, int lane) {
#pragma unroll
    for (int o = 1; o < 64; o <<= 1) v = fmaxf(v, shx(v, o, lane));
    return v;
}
__device__ __forceinline__ int otid(int wv) { int l; asm volatile("v_mbcnt_lo_u32_b32 %0, -1, 0\n\tv_mbcnt_hi_u32_b32 %0, -1, %0" : "=v"(l)); return wv * 64 + l; }
__device__ __forceinline__ void wsync() { asm volatile("s_waitcnt lgkmcnt(0)" ::: "memory"); }
__device__ __forceinline__ float gelu_tanh(float x) { return 0.5f * x * (1.f + tanhf(0.7978845608028654f * (x + 0.044715f * x * x * x))); }
__device__ __forceinline__ float lambda_init_of(int l) { return l == 0 ? 0.2f : (0.8f - 0.6f * 0.7408182206817179f); }

__device__ __forceinline__ int win_col(int slot) { const int s = slot & 31, n = s >> 4, fq = (s >> 2) & 3, i = s & 3;
    if (slot >= 1024 && slot < 2048) return (slot & ~63) + 16 * ((slot >> 5) & 1) + 4 * fq + i + 32 * n;
    return (slot & ~31) + 8 * fq + 4 * n + i; }
__device__ __forceinline__ int wup_col(int slot) { const int s = slot & 255, hid = 128 * (slot >> 8) + 32 * ((s >> 5) & 3) + 8 * ((s >> 2) & 3) + 4 * ((s >> 7) & 1) + (s & 3); return ((s >> 4) & 1) ? DFF + hid : hid; }
__device__ __forceinline__ int wup_slot(int hid) { return 256 * (hid >> 7) + 128 * ((hid >> 2) & 1) + 32 * ((hid >> 5) & 3) + 4 * ((hid >> 3) & 3) + (hid & 3); }
template <int PERMQK, bool DEEP = false>
__device__ __forceinline__ void transpose_item(const float* W, int K, int N, bf16_t* WT, float* scr, int item, int lane, const float* gk = nullptr) {
    const int nblk = N / 32, kb = item / nblk, nb = item % nblk, k0 = 64 * kb, n0 = 32 * nb;
    if (DEEP) {
        float v[32];
#pragma unroll
        for (int i = 0; i < 32; ++i) { const int kk = 2 * i + (lane >> 5); v[i] = W[(size_t)(k0 + kk) * N + (PERMQK == 1 ? win_col(n0 + (lane & 31)) : PERMQK == 2 ? wup_col(n0 + (lane & 31)) : n0 + (lane & 31))]; }
        if (gk) {
#pragma unroll
            for (int i = 0; i < 32; ++i) v[i] *= gk[k0 + 2 * i + (lane >> 5)];
        }
#pragma unroll
        for (int i = 0; i < 32; ++i) scr[(2 * i + (lane >> 5)) * 33 + (lane & 31)] = v[i];
    } else
#pragma unroll 8
    for (int i = 0; i < 32; ++i) { const int kk = 2 * i + (lane >> 5); scr[kk * 33 + (lane & 31)] = W[(size_t)(k0 + kk) * N + (PERMQK == 1 ? win_col(n0 + (lane & 31)) : PERMQK == 2 ? wup_col(n0 + (lane & 31)) : n0 + (lane & 31))] * (gk ? gk[k0 + kk] : 1.f); }
    wsync();
    const int c = lane & 7;
#pragma unroll
    for (int j = 0; j < 4; ++j) { const int n = (lane >> 3) + 8 * j; const float* s = scr + (8 * c) * 33 + n;
        u32x4 o; o.x = pk2(s[0 * 33], s[1 * 33]); o.y = pk2(s[2 * 33], s[3 * 33]); o.z = pk2(s[4 * 33], s[5 * 33]); o.w = pk2(s[6 * 33], s[7 * 33]);
        *(u32x4*)(WT + (size_t)(n0 + n) * K + k0 + 8 * c) = o; }
    wsync();
}
__device__ __forceinline__ void row_to_bf16_rs(const float* xrow, bf16_t* orow, float* rs, int lane) {
    f32x4 v[4]; float s = 0.f;
#pragma unroll
    for (int j = 0; j < 4; ++j) { v[j] = *(const f32x4*)(xrow + 4 * lane + 256 * j); s += (v[j].x * v[j].x + v[j].y * v[j].y) + (v[j].z * v[j].z + v[j].w * v[j].w); }
    const float r = rsqrtf(wave_sum(s, lane) * (1.f / DM) + 1e-6f);
    if (lane == 0) *rs = r;
#pragma unroll
    for (int j = 0; j < 4; ++j) { u32x2 o; o.x = pk2(v[j].x, v[j].y); o.y = pk2(v[j].z, v[j].w); *(u32x2*)(orow + 4 * lane + 256 * j) = o; }
}
__device__ __forceinline__ void rms_row_to_bf16(const float* xrow, const float* gain, bf16_t* orow, int lane) {
    f32x4 v[4]; float s = 0.f;
#pragma unroll
    for (int j = 0; j < 4; ++j) { v[j] = *(const f32x4*)(xrow + 4 * lane + 256 * j); s += (v[j].x * v[j].x + v[j].y * v[j].y) + (v[j].z * v[j].z + v[j].w * v[j].w); }
    const float r = rsqrtf(wave_sum(s, lane) * (1.f / DM) + 1e-6f);
#pragma unroll
    for (int j = 0; j < 4; ++j) { const f32x4 g = *(const f32x4*)(gain + 4 * lane + 256 * j);
        u32x2 o; o.x = pk2(v[j].x * r * g.x, v[j].y * r * g.y); o.y = pk2(v[j].z * r * g.z, v[j].w * r * g.w);
        *(u32x2*)(orow + 4 * lane + 256 * j) = o; }
}
__device__ __forceinline__ void ph_prologue(const P& p, unsigned char* lds, int wv) {
    float* scr_all = (float*)lds;
    const int tid = otid(wv), lane = tid & 63, wave = tid >> 6;
    const int gw = blockIdx.x * 8 + wave, ngw = gridDim.x * 8;
    float* scr = scr_all + wave * 64 * 33;
    if (gw < NMETA) { const int m = gw; const float* src = p.in[1] + (size_t)m * DM;
        float* Hm = (float*)(p.ws + WS_META + M_H); bf16_t* Um = (bf16_t*)(p.ws + WS_META + M_U);
        f32x4 v[4]; float sq = 0.f;
#pragma unroll
        for (int j = 0; j < 4; ++j) v[j] = *(const f32x4*)(src + 4 * lane + 256 * j);
#pragma unroll
        for (int j = 0; j < 4; ++j) sq += (v[j].x * v[j].x + v[j].y * v[j].y) + (v[j].z * v[j].z + v[j].w * v[j].w);
        const float r = rsqrtf(wave_sum(sq, lane) * (1.f / DM) + 1e-6f);
        if (lane == 0) ((float*)(p.ws + WS_META + M_RS))[m] = r;
#pragma unroll
        for (int j = 0; j < 4; ++j) { *(f32x4*)(Hm + (size_t)m * DM + 4 * lane + 256 * j) = v[j];
            u32x2 o; o.x = pk2(v[j].x, v[j].y); o.y = pk2(v[j].z, v[j].w); *(u32x2*)(Um + (size_t)m * DM + 4 * lane + 256 * j) = o; }
    }
    constexpr int I_IN = 16 * 80, I_OUT = 16 * 32, I_UP = 16 * 192, I_DN = 48 * 32, I_L = I_IN + I_OUT + I_UP + I_DN;
    for (int it = gw; it < I_IN; it += ngw) transpose_item<1>(p.in[6], DM, INW, (bf16_t*)(p.ws + WS_W + OFF_WIN), scr, it, lane, p.in[2]);
    { bf16_t* WG = (bf16_t*)(p.ws + WS_WG);
      for (int i = blockIdx.x * NT + tid; i < DEPTH * 2 * 8 * 4096; i += gridDim.x * NT) {
          const int in_ = i & 63, out_ = (i >> 6) & 63, n = (i >> 12) & 7, g = (i >> 15) & 1, l = i >> 16;
          WG[i] = (bf16_t)f2bf(p.in[g ? 11 : 9][((size_t)(l * 8 + n) * 64 + in_) * 64 + out_]); } }
    float* rc = (float*)(p.ws + WS_ROPEC); float* rs = (float*)(p.ws + WS_ROPES);
    for (int i = blockIdx.x * NT + tid; i < TT * 32; i += gridDim.x * NT) {
        const int t = i >> 5, f = i & 31;
        const double inv = exp(-(double)f / 32.0 * log(10000.0));
        const double ang = (double)t * inv;
        rc[i] = (float)cos(ang); rs[i] = (float)sin(ang);
    }
    bf16_t* U = (bf16_t*)(p.ws + WS_U);
    float* RS = (float*)(p.ws + WS_RS);
    for (int m = gw; m < MR; m += 2 * ngw) {
        const float* x0 = p.in[0] + (size_t)m * DM; const float* x1 = p.in[0] + (size_t)(m + ngw) * DM;
        f32x4 v0[4], v1[4]; float s0 = 0.f, s1 = 0.f;
#pragma unroll
        for (int j = 0; j < 4; ++j) { v0[j] = *(const f32x4*)(x0 + 4 * lane + 256 * j); v1[j] = *(const f32x4*)(x1 + 4 * lane + 256 * j); }
#pragma unroll
        for (int j = 0; j < 4; ++j) { s0 += (v0[j].x * v0[j].x + v0[j].y * v0[j].y) + (v0[j].z * v0[j].z + v0[j].w * v0[j].w); s1 += (v1[j].x * v1[j].x + v1[j].y * v1[j].y) + (v1[j].z * v1[j].z + v1[j].w * v1[j].w); }
        const float r0 = rsqrtf(wave_sum(s0, lane) * (1.f / DM) + 1e-6f), r1 = rsqrtf(wave_sum(s1, lane) * (1.f / DM) + 1e-6f);
        if (lane == 0) { RS[m] = r0; RS[m + ngw] = r1; }
#pragma unroll
        for (int j = 0; j < 4; ++j) { u32x2 o; o.x = pk2(v0[j].x, v0[j].y); o.y = pk2(v0[j].z, v0[j].w); *(u32x2*)(U + (size_t)m * DM + 4 * lane + 256 * j) = o;
            u32x2 q; q.x = pk2(v1[j].x, v1[j].y); q.y = pk2(v1[j].z, v1[j].w); *(u32x2*)(U + (size_t)(m + ngw) * DM + 4 * lane + 256 * j) = q; }
    }
}

constexpr int FILL_PER_BAR = 256 * 7, FILL_ITEMS = 2 * (16 * 32 + 16 * 192 + 48 * 32) + 16 * 80;
__device__ __forceinline__ void fill_item(const P& p, unsigned char* lds, int k, int wv) {
    int it = k * FILL_PER_BAR + (int)blockIdx.x * 7 + (wv - 1);
    if (k < 0 || it >= FILL_ITEMS) return;
    const int lane = otid(wv) & 63;
    float* scr = (float*)lds + wv * 64 * 33;
    constexpr int I_IN = 16 * 80, I_OUT = 16 * 32, I_UP = 16 * 192, I_DN = 48 * 32;
    int l = 0;
    if (it >= I_OUT + I_UP + I_DN) { it -= I_OUT + I_UP + I_DN; l = 1;
        if (it < I_IN) { transpose_item<1, true>(p.in[6] + (size_t)DM * INW, DM, INW, (bf16_t*)(p.ws + WS_W + W_LAYER + OFF_WIN), scr, it, lane, p.in[2] + DM); return; }
        it -= I_IN; }
    unsigned char* wb = p.ws + WS_W + l * W_LAYER;
    if (it < I_OUT) { transpose_item<0, true>(p.in[20] + (size_t)l * DM * DM, DM, DM, (bf16_t*)(wb + OFF_WOUT), scr, it, lane); return; } it -= I_OUT;
    if (it < I_UP) { transpose_item<2, true>(p.in[21] + (size_t)l * DM * 2 * DFF, DM, 2 * DFF, (bf16_t*)(wb + OFF_WUP), scr, it, lane, p.in[4] + l * DM); return; } it -= I_UP;
    transpose_item<0, true>(p.in[24] + (size_t)l * DFF * DM, DFF, DM, (bf16_t*)(wb + OFF_WDN), scr, it, lane);
}

template <int MT, int NTL, class Epi>
__device__ __forceinline__ void gemm_naive(const bf16_t* A, const bf16_t* Bt, int M, int N, int K, const Epi& epi, int gw, int ngw, int lane) {
    const int fr = lane & 15, fq = lane >> 4;
    const int tilesM = M / (16 * MT), tilesN = N / (16 * NTL);
    for (int tile = gw; tile < tilesM * tilesN; tile += ngw) {
        const int tm = tile / tilesN, tn = tile % tilesN;
        f32x4 acc[MT][NTL];
#pragma unroll
        for (int m = 0; m < MT; ++m)
#pragma unroll
            for (int n = 0; n < NTL; ++n) acc[m][n] = (f32x4){0.f, 0.f, 0.f, 0.f};
        const bf16_t* Ap = A + (size_t)(tm * 16 * MT + fr) * K + fq * 8;
        const bf16_t* Bp = Bt + (size_t)(tn * 16 * NTL + fr) * K + fq * 8;
#pragma unroll 8
        for (int k = 0; k < K; k += 32) {
            bf16x8 a[MT], b[NTL];
#pragma unroll
            for (int m = 0; m < MT; ++m) a[m] = *(const bf16x8*)(Ap + (size_t)m * 16 * K + k);
#pragma unroll
            for (int n = 0; n < NTL; ++n) b[n] = *(const bf16x8*)(Bp + (size_t)n * 16 * K + k);
#pragma unroll
            for (int m = 0; m < MT; ++m)
#pragma unroll
                for (int n = 0; n < NTL; ++n) acc[m][n] = __builtin_amdgcn_mfma_f32_16x16x32_bf16(b[n], a[m], acc[m][n], 0, 0, 0);
        }
        epi.template run<MT, NTL>(acc, tm * 16 * MT, tn * 16 * NTL, fr, fq);
    }
}
struct EpiF32 {
    float* C; int ldc, pad;
    template <int MT, int NTL> __device__ __forceinline__ void run(const f32x4 (&acc)[MT][NTL], int row0, int col0, int fr, int fq) const {
#pragma unroll
        for (int m = 0; m < MT; ++m)
#pragma unroll
            for (int n = 0; n < NTL; ++n) *(f32x4*)(C + (size_t)(row0 + 16 * m + fr) * ldc + col0 + 16 * n + 4 * fq) = acc[m][n];
    }
};
struct EpiBf16 {
    bf16_t* C; int ldc, pad;
    template <int MT, int NTL> __device__ __forceinline__ void run(const f32x4 (&acc)[MT][NTL], int row0, int col0, int fr, int fq) const {
#pragma unroll
        for (int m = 0; m < MT; ++m)
#pragma unroll
            for (int n = 0; n < NTL; ++n) { u32x2 o; o.x = pk2(acc[m][n][0], acc[m][n][1]); o.y = pk2(acc[m][n][2], acc[m][n][3]);
                *(u32x2*)(C + (size_t)(row0 + 16 * m + fr) * ldc + col0 + 16 * n + 4 * fq) = o; }
    }
};
struct EpiWin {
    bf16_t* Z; const float* rc; const float* rs; const float* RSr; int meta, pad;
    template <int MT, int NTL> __device__ __forceinline__ void run(const f32x4 (&acc)[MT][NTL], int row0, int col0, int fr, int fq) const {
        static_assert(NTL == 2, "EpiWin: 32-slot tiles");
        int c0_ = col0; asm volatile("" : "+s"(c0_));
        const bool qk = col0 >= 1024 && col0 < 2048; const float sc = (c0_ < 1536) ? QSCALE : 1.f;
        const int fo = 16 * ((col0 >> 5) & 1) + 4 * fq;
#pragma unroll
        for (int m = 0; m < MT; ++m) {
            const int row = row0 + 16 * m + fr; const int t = meta ? row : 16 + (row & (SEQ - 1));
            const float rsr = RSr[row]; f32x4 v0 = acc[m][0] * rsr, v1 = acc[m][1] * rsr;
            if (qk) { const f32x4 c = *(const f32x4*)(rc + t * 32 + fo), s = *(const f32x4*)(rs + t * 32 + fo);
                const f32x4 x1 = v0, x2 = v1; v0 = (x1 * c - x2 * s) * sc; v1 = (x2 * c + x1 * s) * sc; }
            u32x4 o; o.x = pk2(v0[0], v0[1]); o.y = pk2(v0[2], v0[3]); o.z = pk2(v1[0], v1[1]); o.w = pk2(v1[2], v1[3]);
            *(u32x4*)(Z + (size_t)row * INW + col0 + 8 * fq) = o;
        }
    }
};
template <int MT, int NTL, class Epi>
__device__ __forceinline__ void ph_gemm(const bf16_t* A, const bf16_t* Bt, int M, int N, int K, Epi epi, int wv) {
    const int tid = otid(wv), lane = tid & 63, wave = tid >> 6;
    gemm_naive<MT, NTL, Epi>(A, Bt, M, N, K, epi, blockIdx.x * 8 + wave, gridDim.x * 8, lane);
}

__device__ __forceinline__ void ph_lru(const P& p, int l, unsigned char* lds, int wv) {
    if (blockIdx.x >= 8) return;
    const int lane = otid(wv) & 63, w = wv, n = blockIdx.x, ch = n * 64 + lane, t0 = 2 * w;
    float* xsT = (float*)lds;
    float* PG = (float*)lds + 1024;
    float* AB = (float*)lds + 1024 + 16384;
    float* HS = AB + 2048;
    const bf16_t* ZBm = (const bf16_t*)(p.ws + WS_META + M_ZB);
    float* T1m = (float*)(p.ws + WS_META + M_T1);
    const float cw0 = p.in[7][(l * 4 + 0) * LRUW + ch], cw1 = p.in[7][(l * 4 + 1) * LRUW + ch], cw2 = p.in[7][(l * 4 + 2) * LRUW + ch], cw3 = p.in[7][(l * 4 + 3) * LRUW + ch];
    const float cb = p.in[8][l * LRUW + ch];
    float xr[5];
#pragma unroll
    for (int k = 0; k < 5; ++k) { const int row = t0 - 3 + k; const float xv = bf2f(ZBm[(size_t)(row >= 0 ? row : 0) * INW + ch]); xr[k] = row >= 0 ? xv : 0.f; }
    const float g0 = bf2f(ZBm[(size_t)t0 * INW + LRUW + ch]), g1 = bf2f(ZBm[(size_t)(t0 + 1) * INW + LRUW + ch]);
    const float* wa = p.in[9] + (size_t)(l * 8 + n) * 4096 + lane; const float* wx = p.in[11] + (size_t)(l * 8 + n) * 4096 + lane;
    float wav[8], wxv[8];
#pragma unroll
    for (int ii = 0; ii < 8; ++ii) { wav[ii] = wa[(8 * w + ii) * 64]; wxv[ii] = wx[(8 * w + ii) * 64]; }
    const float ba = p.in[10][(l * 8 + n) * 64 + lane], bx = p.in[12][(l * 8 + n) * 64 + lane];
    constexpr float L2E_ = 1.4426950408889634f;
    const float la8 = -8.f * log1pf(expf(-p.in[13][l * LRUW + ch])) * L2E_;
    const float xc0 = cb + cw0 * xr[0] + cw1 * xr[1] + cw2 * xr[2] + cw3 * xr[3], xc1 = cb + cw0 * xr[1] + cw1 * xr[2] + cw2 * xr[3] + cw3 * xr[4];
    xsT[lane * 16 + t0] = xc0; xsT[lane * 16 + t0 + 1] = xc1;
    __syncthreads();
    float rp[16], ip[16];
#pragma unroll
    for (int t = 0; t < 16; ++t) { rp[t] = 0.f; ip[t] = 0.f; }
#pragma unroll
    for (int ii = 0; ii < 8; ++ii) {
#pragma unroll
        for (int q = 0; q < 4; ++q) { const f32x4 xv = *(const f32x4*)(xsT + (8 * w + ii) * 16 + 4 * q);
            rp[4 * q] += xv.x * wav[ii]; rp[4 * q + 1] += xv.y * wav[ii]; rp[4 * q + 2] += xv.z * wav[ii]; rp[4 * q + 3] += xv.w * wav[ii];
            ip[4 * q] += xv.x * wxv[ii]; ip[4 * q + 1] += xv.y * wxv[ii]; ip[4 * q + 2] += xv.z * wxv[ii]; ip[4 * q + 3] += xv.w * wxv[ii]; } }
#pragma unroll
    for (int t = 0; t < 16; ++t) { PG[((w * 2 + 0) * 16 + t) * 64 + lane] = rp[t]; PG[((w * 2 + 1) * 16 + t) * 64 + lane] = ip[t]; }
    __syncthreads();
    float r0 = ba, r1 = ba, i0 = bx, i1 = bx;
#pragma unroll
    for (int k = 0; k < 8; ++k) { r0 += PG[((k * 2 + 0) * 16 + t0) * 64 + lane]; r1 += PG[((k * 2 + 0) * 16 + t0 + 1) * 64 + lane]; i0 += PG[((k * 2 + 1) * 16 + t0) * 64 + lane]; i1 += PG[((k * 2 + 1) * 16 + t0 + 1) * 64 + lane]; }
    { const float r = __builtin_amdgcn_rcpf(1.f + __builtin_amdgcn_exp2f(-L2E_ * r0)), ig = __builtin_amdgcn_rcpf(1.f + __builtin_amdgcn_exp2f(-L2E_ * i0));
      const float a = __builtin_amdgcn_exp2f(la8 * r), mult = __builtin_amdgcn_sqrtf(fmaxf(1.f - a * a, 0.f));
      AB[t0 * 64 + lane] = a; AB[1024 + t0 * 64 + lane] = mult * (ig * xc0); }
    { const float r = __builtin_amdgcn_rcpf(1.f + __builtin_amdgcn_exp2f(-L2E_ * r1)), ig = __builtin_amdgcn_rcpf(1.f + __builtin_amdgcn_exp2f(-L2E_ * i1));
      const float a = __builtin_amdgcn_exp2f(la8 * r), mult = __builtin_amdgcn_sqrtf(fmaxf(1.f - a * a, 0.f));
      AB[(t0 + 1) * 64 + lane] = a; AB[1024 + (t0 + 1) * 64 + lane] = mult * (ig * xc1); }
    __syncthreads();
    if (w == 0) { float h = 0.f;
#pragma unroll
        for (int t = 0; t < 16; ++t) { h = AB[t * 64 + lane] * h + AB[1024 + t * 64 + lane]; HS[t * 64 + lane] = h; }
        ((float*)(p.ws + WS_META + M_HME))[ch] = h; }
    __syncthreads();
    T1m[t0 * LRUW + ch] = HS[t0 * 64 + lane] * g0 * __builtin_amdgcn_rcpf(1.f + __builtin_amdgcn_exp2f(-2.302208198f * (g0 + 0.044715f * g0 * g0 * g0)));
    T1m[(t0 + 1) * LRUW + ch] = HS[(t0 + 1) * 64 + lane] * g1 * __builtin_amdgcn_rcpf(1.f + __builtin_amdgcn_exp2f(-2.302208198f * (g1 + 0.044715f * g1 * g1 * g1)));
}
__device__ __forceinline__ void ph_lrunorm(const P& p, int l, int wv) {
    if (blockIdx.x < 8 || blockIdx.x >= 10) return;
    const int tid = otid(wv), lane = tid & 63, wave = tid >> 6, gw = ((int)blockIdx.x - 8) * 8 + wave, ngw = gridDim.x * 8;
    const float* g = p.in[14] + l * LRUW;
    for (int m = MR + gw; m < MR + NMETA; m += ngw) {
        const float* src = m < MR ? (const float*)(p.ws + WS_T1) + (size_t)m * LRUW : (const float*)(p.ws + WS_META + M_T1) + (size_t)(m - MR) * LRUW;
        bf16_t* dst = m < MR ? (bf16_t*)(p.ws + WS_YC) + (size_t)m * DM : (bf16_t*)(p.ws + WS_META + M_YC) + (size_t)(m - MR) * DM;
        f32x4 v[2]; float s = 0.f;
#pragma unroll
        for (int j = 0; j < 2; ++j) { v[j] = *(const f32x4*)(src + 4 * lane + 256 * j); s += (v[j].x * v[j].x + v[j].y * v[j].y) + (v[j].z * v[j].z + v[j].w * v[j].w); }
        const float r = rsqrtf(wave_sum(s, lane) * (1.f / LRUW) + 1e-6f);
#pragma unroll
        for (int j = 0; j < 2; ++j) { const f32x4 gg = *(const f32x4*)(g + 4 * lane + 256 * j);
            u32x2 o; o.x = pk2(v[j].x * r * gg.x, v[j].y * r * gg.y); o.y = pk2(v[j].z * r * gg.z, v[j].w * r * gg.w);
            *(u32x2*)(dst + 4 * lane + 256 * j) = o; }
    }
}

__device__ __forceinline__ void score2(const bf16_t* krow, const float* sm, float& s1, float& s2) {
    float a = 0.f, b = 0.f;
#pragma unroll
    for (int d = 0; d < 64; d += 8) {
        const bf16x8 k1 = *(const bf16x8*)(krow + d), k2 = *(const bf16x8*)(krow + 64 + d);
        const f32x4 qa = *(const f32x4*)(sm + d), qb = *(const f32x4*)(sm + d + 4), qc = *(const f32x4*)(sm + 64 + d), qd = *(const f32x4*)(sm + 64 + d + 4);
        a += qa.x * bf2f((bf16_t)k1[0]) + qa.y * bf2f((bf16_t)k1[1]) + qa.z * bf2f((bf16_t)k1[2]) + qa.w * bf2f((bf16_t)k1[3])
           + qb.x * bf2f((bf16_t)k1[4]) + qb.y * bf2f((bf16_t)k1[5]) + qb.z * bf2f((bf16_t)k1[6]) + qb.w * bf2f((bf16_t)k1[7]);
        b += qc.x * bf2f((bf16_t)k2[0]) + qc.y * bf2f((bf16_t)k2[1]) + qc.z * bf2f((bf16_t)k2[2]) + qc.w * bf2f((bf16_t)k2[3])
           + qd.x * bf2f((bf16_t)k2[4]) + qd.y * bf2f((bf16_t)k2[5]) + qd.z * bf2f((bf16_t)k2[6]) + qd.w * bf2f((bf16_t)k2[7]);
    }
    s1 = a; s2 = b;
}
__device__ __forceinline__ void ph_attn(const P& p, int l, unsigned char* lds, bool meta_only, int wv) {
    float* sm_all = (float*)(lds + 4096);
    const int tid = otid(wv), lane = tid & 63, wave = tid >> 6, gw = blockIdx.x * 8 + wave, ngw = gridDim.x * 8;
    float* sm = sm_all + wave * 192;
    const bf16_t* ZB = (const bf16_t*)(p.ws + WS_ZB); const bf16_t* ZBm = (const bf16_t*)(p.ws + WS_META + M_ZB);
    bf16_t* YC = (bf16_t*)(p.ws + WS_YC); bf16_t* YCm = (bf16_t*)(p.ws + WS_META + M_YC);
    const float li = lambda_init_of(l);
    const float lam = expf(wave_sum(p.in[15][l * 64 + lane] * p.in[16][l * 64 + lane], lane)) - expf(wave_sum(p.in[17][l * 64 + lane] * p.in[18][l * 64 + lane], lane)) + li;
    const float g0 = p.in[19][l * 128 + lane] * (1.f - li), g1 = p.in[19][l * 128 + 64 + lane] * (1.f - li);
    constexpr int NQR = NBATCH * NH * SEQ, NQ = NQR + NH * NMETA;
    for (int qi = (meta_only ? NQR : 0) + gw; qi < NQ; qi += ngw) {
        int b, h, t;
        if (qi < NQR) { b = qi / (NH * SEQ); h = (qi / SEQ) % NH; t = NMETA + qi % SEQ; } else { const int m = qi - NQR; b = 0; h = m / NMETA; t = m % NMETA; }
        const bf16_t* qrow = (t < NMETA ? ZBm + (size_t)t * INW : ZB + ((size_t)b * SEQ + (t - NMETA)) * INW) + 1024 + h * 128;
        sm[lane] = bf2f(qrow[lane]); sm[64 + lane] = bf2f(qrow[64 + lane]);
        wsync();
        const int nch = t < NMETA ? 0 : (t - NMETA) / 64 + 1;
        const bf16_t* kmeta = ZBm + 1536 + h * 128; const bf16_t* kreal = ZB + (size_t)b * SEQ * INW + 1536 + h * 128;
        float m1 = -1e30f, l1 = 0.f, m2 = -1e30f, l2 = 0.f;
        for (int c = -1; c < nch; ++c) {
            const bool valid = c >= 0 || lane < NMETA;
            if (valid) {
                const bf16_t* krow = c < 0 ? kmeta + (size_t)lane * INW : kreal + (size_t)(c * 64 + lane) * INW;
                float s1, s2; score2(krow, sm, s1, s2);
                float mn = fmaxf(m1, s1); l1 = l1 * exp2f(m1 - mn) + exp2f(s1 - mn); m1 = mn;
                mn = fmaxf(m2, s2); l2 = l2 * exp2f(m2 - mn) + exp2f(s2 - mn); m2 = mn;
            }
        }
        const float M1 = wave_max(m1, lane), M2 = wave_max(m2, lane);
        const float L1 = wave_sum(l1 * exp2f(m1 - M1), lane), L2 = wave_sum(l2 * exp2f(m2 - M2), lane);
        const float i1 = 1.f / L1, i2 = lam / L2;
        float acc0 = 0.f, acc1 = 0.f;
        for (int c = -1; c < nch; ++c) {
            const bool valid = c >= 0 || lane < NMETA;
            float w = 0.f;
            if (valid) {
                const bf16_t* krow = c < 0 ? kmeta + (size_t)lane * INW : kreal + (size_t)(c * 64 + lane) * INW;
                float s1, s2; score2(krow, sm, s1, s2);
                w = exp2f(s1 - M1) * i1 - exp2f(s2 - M2) * i2;
            }
            sm[128 + lane] = w; wsync();
            const int nk = c < 0 ? NMETA : 64;
            const bf16_t* vbase = (c < 0 ? kmeta : kreal + (size_t)(c * 64) * INW) + 512;
            for (int j = 0; j < nk; ++j) { const float wj = sm[128 + j]; const bf16_t* vr = vbase + (size_t)j * INW;
                acc0 += wj * bf2f(vr[lane]); acc1 += wj * bf2f(vr[64 + lane]); }
            wsync();
        }
        const float ss = wave_sum(acc0 * acc0 + acc1 * acc1, lane);
        const float r = rsqrtf(ss * (1.f / 128.f) + 1e-5f);
        bf16_t* orow = (t < NMETA ? YCm + (size_t)t * DM : YC + ((size_t)b * SEQ + (t - NMETA)) * DM) + 512 + h * 128;
        orow[lane] = (bf16_t)f2bf(acc0 * r * g0); orow[64 + lane] = (bf16_t)f2bf(acc1 * r * g1);
        wsync();
    }
}


__device__ __forceinline__ void ph_attn_meta(const P& p, int l, unsigned char* lds, int wv) {
    if (blockIdx.x >= 8) return;
    __syncthreads();
    const int lane = otid(wv) & 63, m = blockIdx.x * 8 + wv, h = m / NMETA, t = m % NMETA;
    float* sm = (float*)(lds + 4096) + wv * 192;
    unsigned char* wsl = p.ws; asm volatile("" : "+s"(wsl));
    const bf16_t* ZBm = (const bf16_t*)(wsl + WS_META + M_ZB); bf16_t* YCm = (bf16_t*)(wsl + WS_META + M_YC);
    const bf16_t* qrow = ZBm + (size_t)t * INW + 1024 + h * 128; const bf16_t* kmeta = ZBm + 1536 + h * 128;
    float v0[NMETA], v1[NMETA];
#pragma unroll
    for (int j = 0; j < NMETA; ++j) { v0[j] = bf2f(kmeta[(size_t)j * INW + 512 + lane]); v1[j] = bf2f(kmeta[(size_t)j * INW + 512 + 64 + lane]); }
    sm[lane] = bf2f(qrow[lane]); sm[64 + lane] = bf2f(qrow[64 + lane]);
    const float li = lambda_init_of(l);
    const float lam = expf(wave_sum(p.in[15][l * 64 + lane] * p.in[16][l * 64 + lane], lane)) - expf(wave_sum(p.in[17][l * 64 + lane] * p.in[18][l * 64 + lane], lane)) + li;
    const float g0 = p.in[19][l * 128 + lane] * (1.f - li), g1 = p.in[19][l * 128 + 64 + lane] * (1.f - li);
    wsync();
    float s1 = -1e30f, s2 = -1e30f;
    if (lane < NMETA) score2(kmeta + (size_t)lane * INW, sm, s1, s2);
    const float M1 = wave_max(s1, lane), M2 = wave_max(s2, lane);
    const float e1 = lane < NMETA ? exp2f(s1 - M1) : 0.f, e2 = lane < NMETA ? exp2f(s2 - M2) : 0.f;
    const float L1 = wave_sum(e1, lane), L2 = wave_sum(e2, lane);
    const float w = e1 * (1.f / L1) - e2 * (lam / L2);
    float acc0 = 0.f, acc1 = 0.f;
#pragma unroll
    for (int j = 0; j < NMETA; ++j) { const float wj = __int_as_float(__builtin_amdgcn_readlane(__float_as_int(w), j)); acc0 += wj * v0[j]; acc1 += wj * v1[j]; }
    const float ss = wave_sum(acc0 * acc0 + acc1 * acc1, lane);
    const float r = rsqrtf(ss * (1.f / 128.f) + 1e-5f);
    bf16_t* orow = YCm + (size_t)t * DM + 512 + h * 128;
    orow[lane] = (bf16_t)f2bf(acc0 * r * g0); orow[64 + lane] = (bf16_t)f2bf(acc1 * r * g1);
}


namespace att {
typedef float f32x16 __attribute__((ext_vector_type(16)));
typedef short s16x4 __attribute__((ext_vector_type(4)));
#define ATT_LAS __attribute__((address_space(3)))
constexpr float THR = 5.f;
__device__ __forceinline__ s16x4 vtr(const ATT_LAS unsigned char* p) { return __builtin_bit_cast(s16x4, __builtin_amdgcn_ds_read_tr16_b64_v4i16((ATT_LAS s16x4*)p)); }
__device__ __forceinline__ unsigned cvtpk(float lo, float hi) { typedef float f2 __attribute__((ext_vector_type(2))); typedef __bf16 b2 __attribute__((ext_vector_type(2))); f2 v = {lo, hi}; b2 b = __builtin_convertvector(v, b2); return __builtin_bit_cast(unsigned, b); }

template <bool META>
__device__ __forceinline__ void tile(const ATT_LAS unsigned char* Kb, const ATT_LAS unsigned char* Vb, const bf16x8 (&qf)[4], f32x16 (&o)[4], float& m, float& lsum, float (&prs)[16], int map, int lane) {
    const int r = lane & 31, hh = lane >> 5;
    f32x16 S0, S1;
#pragma unroll
    for (int i = 0; i < 16; ++i) { S0[i] = META ? 0.f : -m; S1[i] = META ? 0.f : -m; }
    {
        bf16x8 ka[4], kb[4];
#pragma unroll
        for (int s4 = 0; s4 < 4; ++s4) { const int chunk = map * 8 + 2 * s4 + hh;
            ka[s4] = *(const ATT_LAS bf16x8*)(Kb + r * 256 + ((chunk ^ (r & 15)) << 4));
            if (!META) kb[s4] = *(const ATT_LAS bf16x8*)(Kb + (32 + r) * 256 + ((chunk ^ (r & 15)) << 4)); }
        if (!META) {
            const float a0 = (prs[0] + prs[1]) + (prs[2] + prs[3]), a1 = (prs[4] + prs[5]) + (prs[6] + prs[7]), a2 = (prs[8] + prs[9]) + (prs[10] + prs[11]), a3 = (prs[12] + prs[13]) + (prs[14] + prs[15]);
            lsum += (a0 + a1) + (a2 + a3); }
#pragma unroll
        for (int s4 = 0; s4 < 4; ++s4) { S0 = __builtin_amdgcn_mfma_f32_32x32x16_bf16(ka[s4], qf[s4], S0, 0, 0, 0);
            if (!META) S1 = __builtin_amdgcn_mfma_f32_32x32x16_bf16(kb[s4], qf[s4], S1, 0, 0, 0); }
    }
    float mt = -1e30f;
    if (META) {
#pragma unroll
        for (int i = 0; i < 8; ++i) mt = fmaxf(mt, S0[i]);
    } else {
        {
            float q0 = fmaxf(fmaxf(S0[0], S0[1]), S1[0]), q1 = fmaxf(fmaxf(S0[2], S0[3]), S1[1]), q2 = fmaxf(fmaxf(S0[4], S0[5]), S1[2]), q3 = fmaxf(fmaxf(S0[6], S0[7]), S1[3]);
            q0 = fmaxf(fmaxf(q0, S0[8]), S0[9]); q1 = fmaxf(fmaxf(q1, S0[10]), S0[11]); q2 = fmaxf(fmaxf(q2, S0[12]), S0[13]); q3 = fmaxf(fmaxf(q3, S0[14]), S0[15]);
            q0 = fmaxf(fmaxf(q0, S1[4]), S1[5]); q1 = fmaxf(fmaxf(q1, S1[6]), S1[7]); q2 = fmaxf(fmaxf(q2, S1[8]), S1[9]); q3 = fmaxf(fmaxf(q3, S1[10]), S1[11]);
            q0 = fmaxf(fmaxf(q0, S1[12]), S1[13]); q1 = fmaxf(fmaxf(q1, S1[14]), S1[15]);
            mt = fmaxf(fmaxf(q0, q1), fmaxf(q2, q3)); }
    }
    { auto rr = __builtin_amdgcn_permlane32_swap(__float_as_uint(mt), __float_as_uint(mt), false, false); mt = fmaxf(__uint_as_float(rr[0]), __uint_as_float(rr[1])); }
    if (META) {
        if (__any(mt > m + THR)) {
            const float mn = fmaxf(m, mt), alpha = __builtin_amdgcn_exp2f(m - mn);
            lsum *= alpha; m = mn;
#pragma unroll
            for (int e = 0; e < 4; ++e) o[e] = o[e] * alpha;
        }
#pragma unroll
        for (int i = 0; i < 8; ++i) S0[i] -= m;
    } else if (__any(mt > THR)) {
        const float d = fmaxf(mt, 0.f), alpha = __builtin_amdgcn_exp2f(-d);
        lsum *= alpha; m += d;
#pragma unroll
        for (int e = 0; e < 4; ++e) o[e] = o[e] * alpha;
#pragma unroll
        for (int i = 0; i < 16; ++i) { S0[i] -= d; S1[i] -= d; }
    }
    unsigned pw[4][4];
#pragma unroll
    for (int i = 0; i < 16; i += 2) {
        if (META && i >= 8) { prs[i >> 1] = 0.f; continue; }
        const float p0 = __builtin_amdgcn_exp2f(S0[i]), p1 = __builtin_amdgcn_exp2f(S0[i + 1]); prs[i >> 1] = p0 + p1; pw[i >> 3][(i >> 1) & 3] = cvtpk(p0, p1); }
#pragma unroll
    for (int i = 0; i < 16; i += 2) {
        if (META) { prs[8 + (i >> 1)] = 0.f; continue; }
        const float p0 = __builtin_amdgcn_exp2f(S1[i]), p1 = __builtin_amdgcn_exp2f(S1[i + 1]); prs[8 + (i >> 1)] = p0 + p1; pw[2 + (i >> 3)][(i >> 1) & 3] = cvtpk(p0, p1); }
    const int g = (lane >> 4) & 1, q = (lane & 15) >> 2, pp = lane & 3;
    const ATT_LAS unsigned char* vbase = Vb + (4 * hh + q) * 256 + (pp & 1) * 8;
    int cho[4];
#pragma unroll
    for (int eb = 0; eb < 4; ++eb) cho[eb] = ((4 * eb + 2 * g + (pp >> 1)) ^ (q << 2)) << 4;
    constexpr int NKS = META ? 1 : 4;
    s16x4 lo[2][4], hi[2][4];
#pragma unroll
    for (int eb = 0; eb < 4; ++eb) { lo[0][eb] = vtr(vbase + cho[eb]); hi[0][eb] = vtr(vbase + cho[eb] + 8 * 256); }
#pragma unroll
    for (int ks = 0; ks < NKS; ++ks) {
        if (ks + 1 < NKS) {
#pragma unroll
            for (int eb = 0; eb < 4; ++eb) { lo[(ks + 1) & 1][eb] = vtr(vbase + (ks + 1) * 16 * 256 + cho[eb]); hi[(ks + 1) & 1][eb] = vtr(vbase + (ks + 1) * 16 * 256 + cho[eb] + 8 * 256); }
        }
        const u32x4 pu = {pw[ks][0], pw[ks][1], pw[ks][2], pw[ks][3]};
        const bf16x8 pf = __builtin_bit_cast(bf16x8, pu);
#pragma unroll
        for (int eb = 0; eb < 4; ++eb) { const s16x4 a = lo[ks & 1][eb], c = hi[ks & 1][eb];
            const bf16x8 vf = {a[0], a[1], a[2], a[3], c[0], c[1], c[2], c[3]};
            o[eb] = __builtin_amdgcn_mfma_f32_32x32x16_bf16(vf, pf, o[eb], 0, 0, 0); }
    }
}

__device__ __forceinline__ void unit(const P& p, int l, unsigned char* lds_, int b, int h, int qb, float lam, float li, int wv) {
    const ATT_LAS unsigned char* lds = (const ATT_LAS unsigned char*)lds_;
    ATT_LAS unsigned char* ldsw = (ATT_LAS unsigned char*)lds_;
    const int tid = otid(wv), lane = tid & 63, wid = __builtin_amdgcn_readfirstlane(tid >> 6), r = lane & 31, hh = lane >> 5;
    const int map = wid >> 2, qs = wid & 3;
    const bf16_t* ZB = (const bf16_t*)(p.ws + WS_ZB); const bf16_t* ZBm = (const bf16_t*)(p.ws + WS_META + M_ZB);
    const size_t rowbase = (size_t)b * SEQ;
    const int q0 = qb * 128 + qs * 32;
    const int nt_unit = 2 * qb + 2, nt_wave = 2 * qb + 1 + (qs >> 1);
    bf16x8 qf[4];
    { const bf16_t* qp = ZB + (rowbase + q0 + r) * INW + 1024 + h * 128 + map * 64 + hh * 8;
#pragma unroll
      for (int s4 = 0; s4 < 4; ++s4) qf[s4] = *(const bf16x8*)(qp + 16 * s4); }
    f32x16 o[4] = {}; float m = -1e30f, lsum = 0.f;
    float prs[16];
#pragma unroll
    for (int i = 0; i < 16; ++i) prs[i] = 0.f;
#define ATT_DMA(tt, img) do { _Pragma("unroll") for (int j_ = 0; j_ < 2; ++j_) { const int q_ = 2 * wid + j_, row_ = 4 * q_ + (lane >> 4), slot_ = lane & 15; \
        const bf16_t* rp_ = (tt) == 0 ? ZBm + (size_t)(row_ & 15) * INW : ZB + (rowbase + 64 * ((tt) - 1) + row_) * INW; \
        __builtin_amdgcn_global_load_lds((const unsigned*)(rp_ + 1536 + h * 128 + (slot_ ^ (row_ & 15)) * 8), (ATT_LAS unsigned*)(ldsw + (img) * 32768 + q_ * 1024), 16, 0, 0); \
        __builtin_amdgcn_global_load_lds((const unsigned*)(rp_ + 2048 + h * 128 + (slot_ ^ ((row_ & 3) << 2)) * 8), (ATT_LAS unsigned*)(ldsw + (img) * 32768 + 16384 + q_ * 1024), 16, 0, 0); } } while (0)
    ATT_DMA(0, 0);
    asm volatile("s_waitcnt vmcnt(0)" ::: "memory");
    __syncthreads();
    for (int tt = 0; tt <= nt_unit; ++tt) {
        const int buf = tt & 1;
        if (tt < nt_unit) ATT_DMA(tt + 1, buf ^ 1);
        if (tt <= nt_wave) {
            if (tt == 0) tile<true>(lds + buf * 32768, lds + buf * 32768 + 16384, qf, o, m, lsum, prs, map, lane);
            else tile<false>(lds + buf * 32768, lds + buf * 32768 + 16384, qf, o, m, lsum, prs, map, lane);
        }
        asm volatile("s_waitcnt vmcnt(0)" ::: "memory");
        __syncthreads();
    }
#undef ATT_DMA
    lsum += ((prs[0] + prs[1]) + (prs[2] + prs[3])) + ((prs[4] + prs[5]) + (prs[6] + prs[7])) + (((prs[8] + prs[9]) + (prs[10] + prs[11])) + ((prs[12] + prs[13]) + (prs[14] + prs[15])));
    { auto rr = __builtin_amdgcn_permlane32_swap(__float_as_uint(lsum), __float_as_uint(lsum), false, false); lsum = __uint_as_float(rr[0]) + __uint_as_float(rr[1]); }
    const float inv = 1.f / lsum;
    ATT_LAS float* X = (ATT_LAS float*)ldsw;
    if (map == 1) {
        const float f = inv * lam;
#pragma unroll
        for (int eb = 0; eb < 4; ++eb)
#pragma unroll
            for (int i = 0; i < 16; ++i) X[(eb * 16 + i) * 256 + qs * 64 + lane] = o[eb][i] * f;
    }
    __syncthreads();
    if (map == 0) {
        float ss = 0.f;
#pragma unroll
        for (int eb = 0; eb < 4; ++eb)
#pragma unroll
            for (int i = 0; i < 16; ++i) { const float v = o[eb][i] * inv - X[(eb * 16 + i) * 256 + qs * 64 + lane]; o[eb][i] = v; ss += v * v; }
        { auto rr = __builtin_amdgcn_permlane32_swap(__float_as_uint(ss), __float_as_uint(ss), false, false); ss = __uint_as_float(rr[0]) + __uint_as_float(rr[1]); }
        const float rs = rsqrtf(ss * (1.f / 128.f) + 1e-5f) * (1.f - li);
        const float* gsub = p.in[19] + l * 128;
        bf16_t* orow = (bf16_t*)(p.ws + WS_YC) + (rowbase + q0 + r) * DM + 512 + h * 128;
#pragma unroll
        for (int eb = 0; eb < 4; ++eb)
#pragma unroll
            for (int i4 = 0; i4 < 4; ++i4) { const int e0 = 32 * eb + 8 * i4 + 4 * hh; const f32x4 g = *(const f32x4*)(gsub + e0);
                u32x2 w; w.x = cvtpk(o[eb][4 * i4] * rs * g.x, o[eb][4 * i4 + 1] * rs * g.y); w.y = cvtpk(o[eb][4 * i4 + 2] * rs * g.z, o[eb][4 * i4 + 3] * rs * g.w);
                *(u32x2*)(orow + e0) = w; }
    }
    __syncthreads();
}

__device__ __forceinline__ void phase(const P& p, int l, unsigned char* lds, int wv) {
    const int lane = otid(wv) & 63;
    const float li = lambda_init_of(l);
    const float lam = expf(wave_sum(p.in[15][l * 64 + lane] * p.in[16][l * 64 + lane], lane)) - expf(wave_sum(p.in[17][l * 64 + lane] * p.in[18][l * 64 + lane], lane)) + li;
    const int G = gridDim.x, bx = blockIdx.x;
    const int vcu = (G % 8 == 0) ? (bx % 8) * (G / 8) + bx / 8 : bx;
    if (G == 256) {
        const int x = vcu >> 5, c = vcu & 31;
#pragma unroll 1
        for (int j = 0; j < 4; ++j) { const int bh = 4 * x + j; unit(p, l, lds, bh >> 2, bh & 3, (j & 1) ? 31 - c : c, lam, li, wv); }
    } else {
        for (int it = vcu; it < 32 * 32; it += G) unit(p, l, lds, (it >> 5) >> 2, (it >> 5) & 3, it & 31, lam, li, wv);
    }
}
}


namespace lru {
#define LRU_LAS __attribute__((address_space(3)))
typedef float f32x16 __attribute__((ext_vector_type(16)));
constexpr float L2E = 1.4426950408889634f;
__device__ __forceinline__ float sigm(float x) { return __builtin_amdgcn_rcpf(1.f + __builtin_amdgcn_exp2f(-L2E * x)); }
__device__ __forceinline__ float gelu_t(float x) { return x * sigm(1.5957691216057308f * (x + 0.044715f * x * x * x)); }
__device__ __forceinline__ float bc_lo(float v) { auto rr = __builtin_amdgcn_permlane32_swap(__float_as_uint(v), __float_as_uint(v), false, false); return __uint_as_float(rr[0]); }
__device__ __forceinline__ float bc_hi(float v) { auto rr = __builtin_amdgcn_permlane32_swap(__float_as_uint(v), __float_as_uint(v), false, false); return __uint_as_float(rr[1]); }
constexpr int PART_OFF = 131072 + 1024;

constexpr size_t WS_AB = 416 * MiB;
template <int PASS>
__device__ __forceinline__ void unit(const P& p, int l, unsigned char* lds_, int b, int c, int par, int wv) {
    const int tid = otid(wv), lane = tid & 63, n = __builtin_amdgcn_readfirstlane(tid >> 6), r = lane & 31, hh = lane >> 5, tq = lane >> 3, cq = lane & 7;
    LRU_LAS unsigned char* T = (LRU_LAS unsigned char*)lds_ + n * 16384;
    const bf16_t* ZB = (const bf16_t*)(p.ws + WS_ZB); const bf16_t* ZBm = (const bf16_t*)(p.ws + WS_META + M_ZB);
    unsigned* AB = (unsigned*)(p.ws + WS_AB) + ((size_t)((b * 64 + c) * 8 + n)) * 4096 + lane;
    float hc[2] = {0.f, 0.f}, aprod[2] = {1.f, 1.f};
    if (PASS == 0) {
        bf16x8 wf[2][2][4];
        { const bf16_t* WG = (const bf16_t*)(p.ws + WS_WG);
#pragma unroll
          for (int g = 0; g < 2; ++g)
#pragma unroll
            for (int ob = 0; ob < 2; ++ob)
#pragma unroll
                for (int s = 0; s < 4; ++s) wf[g][ob][s] = *(const bf16x8*)(WG + ((size_t)((l * 2 + g) * 8 + n)) * 4096 + (32 * ob + r) * 64 + 16 * s + 8 * hh); }
        float ba_[2], bx_[2], la8_[2];
#pragma unroll
        for (int ob = 0; ob < 2; ++ob) { const int ch = n * 64 + 32 * ob + r;
            ba_[ob] = p.in[10][l * LRUW + ch]; bx_[ob] = p.in[12][l * LRUW + ch];
            la8_[ob] = -8.f * log1pf(expf(-p.in[13][l * LRUW + ch])) * L2E; }
        {
            const float* cw = p.in[7] + (size_t)l * 4 * LRUW + n * 64 + 8 * cq; const float* cb = p.in[8] + (size_t)l * LRUW + n * 64 + 8 * cq;
            bf16x8 xr[11];
#pragma unroll
            for (int k = 0; k < 11; ++k) { const int grow = 64 * c + 8 * tq - 3 + k;
                const bf16_t* ptr = grow >= 0 ? ZB + ((size_t)b * SEQ + grow) * INW : ZBm + (size_t)(NMETA + grow) * INW;
                xr[k] = *(const bf16x8*)(ptr + n * 64 + 8 * cq); }
            float w[4][8], bia[8];
#pragma unroll
            for (int k = 0; k < 4; ++k) { const f32x4 a = *(const f32x4*)(cw + k * LRUW), bq = *(const f32x4*)(cw + k * LRUW + 4);
                w[k][0] = a.x; w[k][1] = a.y; w[k][2] = a.z; w[k][3] = a.w; w[k][4] = bq.x; w[k][5] = bq.y; w[k][6] = bq.z; w[k][7] = bq.w; }
            { const f32x4 a = *(const f32x4*)cb, bq = *(const f32x4*)(cb + 4); bia[0] = a.x; bia[1] = a.y; bia[2] = a.z; bia[3] = a.w; bia[4] = bq.x; bia[5] = bq.y; bia[6] = bq.z; bia[7] = bq.w; }
#pragma unroll
            for (int j = 0; j < 8; ++j) { const int tok = 8 * tq + j; float o[8];
#pragma unroll
                for (int e = 0; e < 8; ++e) o[e] = bia[e] + w[0][e] * bf2f((bf16_t)xr[j][e]) + w[1][e] * bf2f((bf16_t)xr[j + 1][e]) + w[2][e] * bf2f((bf16_t)xr[j + 2][e]) + w[3][e] * bf2f((bf16_t)xr[j + 3][e]);
                *(LRU_LAS f32x4*)(T + tok * 256 + (((2 * cq) ^ (tok & 15)) << 4)) = (f32x4){o[0], o[1], o[2], o[3]};
                *(LRU_LAS f32x4*)(T + tok * 256 + (((2 * cq + 1) ^ (tok & 15)) << 4)) = (f32x4){o[4], o[5], o[6], o[7]}; }
        }
        wsync();
#pragma unroll
        for (int tb = 0; tb < 2; ++tb) {
            bf16x8 af[4];
            { const int tok = 32 * tb + r;
#pragma unroll
              for (int s = 0; s < 4; ++s) { const int c0 = 4 * s + 2 * hh;
                  const f32x4 v0 = *(const LRU_LAS f32x4*)(T + tok * 256 + ((c0 ^ (tok & 15)) << 4)), v1 = *(const LRU_LAS f32x4*)(T + tok * 256 + (((c0 + 1) ^ (tok & 15)) << 4));
                  u32x4 pk; pk.x = pk2(v0.x, v0.y); pk.y = pk2(v0.z, v0.w); pk.z = pk2(v1.x, v1.y); pk.w = pk2(v1.z, v1.w); af[s] = __builtin_bit_cast(bf16x8, pk); } }
#pragma unroll
            for (int ob = 0; ob < 2; ++ob) {
                f32x16 R = {}, I = {};
#pragma unroll
                for (int s = 0; s < 4; ++s) { R = __builtin_amdgcn_mfma_f32_32x32x16_bf16(af[s], wf[0][ob][s], R, 0, 0, 0); I = __builtin_amdgcn_mfma_f32_32x32x16_bf16(af[s], wf[1][ob][s], I, 0, 0, 0); }
                float a[16], bb[16];
#pragma unroll
                for (int i = 0; i < 16; ++i) { const int tok = 32 * tb + 8 * (i >> 2) + 4 * hh + (i & 3);
                    const float xcv = *(const LRU_LAS float*)(T + tok * 256 + (((8 * ob + (r >> 2)) ^ (tok & 15)) << 4) + (r & 3) * 4);
                    const float rg = sigm(R[i] + ba_[ob]), ig = sigm(I[i] + bx_[ob]);
                    const float la = la8_[ob] * rg, av = __builtin_amdgcn_exp2f(la);
                    a[i] = av; bb[i] = __builtin_amdgcn_sqrtf(fmaxf(1.f - av * av, 0.f)) * ig * xcv;
                    AB[((tb * 2 + ob) * 16 + i) * 64] = pk2(bb[i], la); }
#pragma unroll
                for (int G = 0; G < 4; ++G)
#pragma unroll
                    for (int j = 1; j < 4; ++j) { bb[4 * G + j] = a[4 * G + j] * bb[4 * G + j - 1] + bb[4 * G + j]; a[4 * G + j] = a[4 * G + j] * a[4 * G + j - 1]; }
#pragma unroll
                for (int G = 0; G < 4; ++G) { const float AG = a[4 * G + 3], BG = bb[4 * G + 3];
                    const float x = bc_lo(AG * hc[ob] + BG);
                    hc[ob] = bc_hi(AG * x + BG);
                    aprod[ob] *= AG; }
            }
        }
#pragma unroll
        for (int ob = 0; ob < 2; ++ob) { const float at = bc_lo(aprod[ob]) * bc_hi(aprod[ob]); const size_t idx = ((size_t)b * 64 + c) * LRUW + n * 64 + 32 * ob + r;
            if (hh == 0) { ((float*)(p.ws + WS_CA))[idx] = at; ((float*)(p.ws + WS_CB))[idx] = hc[ob]; } }
        return;
    }
    unsigned abv[2][2][16];
#pragma unroll
    for (int q = 0; q < 4; ++q)
#pragma unroll
        for (int i = 0; i < 16; ++i) abv[q >> 1][q & 1][i] = AB[(q * 16 + i) * 64];
    bf16x8 g8v[8];
#pragma unroll
    for (int j = 0; j < 8; ++j) g8v[j] = *(const bf16x8*)(ZB + ((size_t)b * SEQ + 64 * c + 8 * j + tq) * INW + LRUW + n * 64 + 8 * cq);
    const float* gain = p.in[14] + (size_t)l * LRUW + n * 64 + 8 * cq;
    const f32x4 g0 = *(const f32x4*)gain, g1 = *(const f32x4*)(gain + 4);
    {
        const float* CA = (const float*)(p.ws + WS_CA) + (size_t)b * 64 * LRUW + n * 64 + r; const float* CB = (const float*)(p.ws + WS_CB) + (size_t)b * 64 * LRUW + n * 64 + r;
        const int mid = c >> 1, lo = hh ? mid : 0, hi = hh ? c : mid;
        float fa0 = 1.f, fb0 = 0.f, fa1 = 1.f, fb1 = 0.f;
#pragma unroll 8
        for (int cc = lo; cc < hi; ++cc) { const float a0 = CA[(size_t)cc * LRUW], b0 = CB[(size_t)cc * LRUW], a1 = CA[(size_t)cc * LRUW + 32], b1 = CB[(size_t)cc * LRUW + 32];
            fb0 = a0 * fb0 + b0; fa0 *= a0; fb1 = a1 * fb1 + b1; fa1 *= a1; }
        const float* HME = (const float*)(p.ws + WS_META + M_HME) + n * 64 + r;
        hc[0] = bc_hi(fa0) * (bc_lo(fa0) * HME[0] + bc_lo(fb0)) + bc_hi(fb0);
        hc[1] = bc_hi(fa1) * (bc_lo(fa1) * HME[32] + bc_lo(fb1)) + bc_hi(fb1);
    }
#pragma unroll
    for (int tb = 0; tb < 2; ++tb) {
#pragma unroll
        for (int ob = 0; ob < 2; ++ob) {
            float a[16], bb[16];
#pragma unroll
            for (int i = 0; i < 16; ++i) { const unsigned w = abv[tb][ob][i]; a[i] = __builtin_amdgcn_exp2f(__uint_as_float(w & 0xffff0000u)); bb[i] = __uint_as_float(w << 16); }
#pragma unroll
            for (int G = 0; G < 4; ++G)
#pragma unroll
                for (int j = 1; j < 4; ++j) { bb[4 * G + j] = a[4 * G + j] * bb[4 * G + j - 1] + bb[4 * G + j]; a[4 * G + j] = a[4 * G + j] * a[4 * G + j - 1]; }
            float hin[4];
#pragma unroll
            for (int G = 0; G < 4; ++G) { const float AG = a[4 * G + 3], BG = bb[4 * G + 3];
                const float x = bc_lo(AG * hc[ob] + BG); hin[G] = hh ? x : hc[ob];
                hc[ob] = bc_hi(AG * x + BG); }
#pragma unroll
            for (int i = 0; i < 16; ++i) { const int tok = 32 * tb + 8 * (i >> 2) + 4 * hh + (i & 3);
                *(LRU_LAS float*)(T + tok * 256 + (((8 * ob + (r >> 2)) ^ (tok & 15)) << 4) + (r & 3) * 4) = bb[i] + a[i] * hin[i >> 2]; }
        }
    }
    wsync();
    LRU_LAS float* PART = (LRU_LAS float*)((LRU_LAS unsigned char*)lds_ + PART_OFF) + par * 512;
    float y[8][8];
#pragma unroll
    for (int j = 0; j < 8; ++j) { const int tok = 8 * j + tq;
        const f32x4 v0 = *(const LRU_LAS f32x4*)(T + tok * 256 + (((2 * cq) ^ (tok & 15)) << 4)), v1 = *(const LRU_LAS f32x4*)(T + tok * 256 + (((2 * cq + 1) ^ (tok & 15)) << 4));
        const bf16x8 g8 = g8v[j];
        const float hv[8] = {v0.x, v0.y, v0.z, v0.w, v1.x, v1.y, v1.z, v1.w}; float ss = 0.f;
#pragma unroll
        for (int e = 0; e < 8; ++e) { y[j][e] = hv[e] * gelu_t(bf2f((bf16_t)g8[e])); ss += y[j][e] * y[j][e]; }
        ss += shx(ss, 1, lane); ss += shx(ss, 2, lane); ss += shx(ss, 4, lane);
        if (cq == 0) PART[n * 64 + tok] = ss; }
    __syncthreads();
    bf16_t* YC = (bf16_t*)(p.ws + WS_YC);
#pragma unroll
    for (int j = 0; j < 8; ++j) { const int tok = 8 * j + tq; float tot = 0.f;
#pragma unroll
        for (int k = 0; k < 8; ++k) tot += PART[k * 64 + tok];
        const float rs = rsqrtf(tot * (1.f / LRUW) + 1e-6f);
        u32x4 o; o.x = pk2(y[j][0] * rs * g0.x, y[j][1] * rs * g0.y); o.y = pk2(y[j][2] * rs * g0.z, y[j][3] * rs * g0.w); o.z = pk2(y[j][4] * rs * g1.x, y[j][5] * rs * g1.y); o.w = pk2(y[j][6] * rs * g1.z, y[j][7] * rs * g1.w);
        *(u32x4*)(YC + ((size_t)b * SEQ + 64 * c + tok) * DM + n * 64 + 8 * cq) = o; }
}
template <int PASS>
__device__ __forceinline__ void phase(const P& p, int l, unsigned char* lds, int wv) {
    int par = 0;
    for (int u = blockIdx.x; u < NBATCH * 64; u += gridDim.x) {
        const int c = (PASS == 1 && u >= NBATCH * 32) ? 63 - (u & 63) : (u & 63); unit<PASS>(p, l, lds, u >> 6, c, par, wv); par ^= 1; }
    __syncthreads();
}
}

__device__ __forceinline__ void ph_normres(const float* Y, const float* Ym, const float* base, float* out, float* Hm, const float* Hm_base, const float* gpost, const float* gnext, bf16_t* U, bf16_t* Um, int wv) {
    const int tid = otid(wv), lane = tid & 63, wave = tid >> 6, gw = blockIdx.x * 8 + wave, ngw = gridDim.x * 8;
    for (int m = MR + gw; m < MR + NMETA; m += ngw) {
        const bool meta = m >= MR; const int r_ = meta ? m - MR : m;
        const float* y = (meta ? Ym : Y) + (size_t)r_ * DM; const float* bs = (meta ? Hm_base : base) + (size_t)r_ * DM; float* o = (meta ? Hm : out) + (size_t)r_ * DM;
        f32x4 v[4]; float s = 0.f;
#pragma unroll
        for (int j = 0; j < 4; ++j) { v[j] = *(const f32x4*)(y + 4 * lane + 256 * j); s += (v[j].x * v[j].x + v[j].y * v[j].y) + (v[j].z * v[j].z + v[j].w * v[j].w); }
        const float r = rsqrtf(wave_sum(s, lane) * (1.f / DM) + 1e-6f);
        float s2 = 0.f;
#pragma unroll
        for (int j = 0; j < 4; ++j) { const f32x4 g = *(const f32x4*)(gpost + 4 * lane + 256 * j), bb = *(const f32x4*)(bs + 4 * lane + 256 * j);
            v[j] = bb + v[j] * r * g; *(f32x4*)(o + 4 * lane + 256 * j) = v[j];
            s2 += (v[j].x * v[j].x + v[j].y * v[j].y) + (v[j].z * v[j].z + v[j].w * v[j].w); }
        if (gnext) {
            const float r2 = rsqrtf(wave_sum(s2, lane) * (1.f / DM) + 1e-6f);
            bf16_t* u = (meta ? Um : U) + (size_t)r_ * DM;
#pragma unroll
            for (int j = 0; j < 4; ++j) { const f32x4 g = *(const f32x4*)(gnext + 4 * lane + 256 * j);
                u32x2 w; w.x = pk2(v[j].x * r2 * g.x, v[j].y * r2 * g.y); w.y = pk2(v[j].z * r2 * g.z, v[j].w * r2 * g.w);
                *(u32x2*)(u + 4 * lane + 256 * j) = w; }
        }
    }
}


__device__ __forceinline__ void ph_normres2(const bf16_t* Y, bf16_t* HB, const float* gpost, float* RS, float* outf, int wv) {
    const int tid = otid(wv), lane = tid & 63, gw = blockIdx.x * 8 + (tid >> 6), ngw = gridDim.x * 8;
    const f32x4 g0 = *(const f32x4*)(gpost + 8 * lane), g1 = *(const f32x4*)(gpost + 8 * lane + 4), g2 = *(const f32x4*)(gpost + 512 + 8 * lane), g3 = *(const f32x4*)(gpost + 512 + 8 * lane + 4);
    bf16x8 ny0 = *(const bf16x8*)(Y + (size_t)gw * DM + 8 * lane), ny1 = *(const bf16x8*)(Y + (size_t)gw * DM + 512 + 8 * lane);
    bf16x8 nb0 = *(const bf16x8*)(HB + (size_t)gw * DM + 8 * lane), nb1 = *(const bf16x8*)(HB + (size_t)gw * DM + 512 + 8 * lane);
    for (int m = gw; m < MR; m += ngw) {
        const bf16x8 y0 = ny0, y1 = ny1, b0 = nb0, b1 = nb1;
        if (m + ngw < MR) { const size_t mn = (size_t)(m + ngw);
            ny0 = *(const bf16x8*)(Y + mn * DM + 8 * lane); ny1 = *(const bf16x8*)(Y + mn * DM + 512 + 8 * lane);
            nb0 = *(const bf16x8*)(HB + mn * DM + 8 * lane); nb1 = *(const bf16x8*)(HB + mn * DM + 512 + 8 * lane); }
        float v[16], hb[16];
#pragma unroll
        for (int e = 0; e < 8; ++e) { v[e] = bf2f((bf16_t)y0[e]); v[8 + e] = bf2f((bf16_t)y1[e]); hb[e] = bf2f((bf16_t)b0[e]); hb[8 + e] = bf2f((bf16_t)b1[e]); }
        float s = 0.f;
#pragma unroll
        for (int e = 0; e < 16; ++e) s += v[e] * v[e];
        const float r = rsqrtf(wave_sum(s, lane) * (1.f / DM) + 1e-6f);
        const float gg[16] = {g0.x, g0.y, g0.z, g0.w, g1.x, g1.y, g1.z, g1.w, g2.x, g2.y, g2.z, g2.w, g3.x, g3.y, g3.z, g3.w};
        float s2 = 0.f;
#pragma unroll
        for (int e = 0; e < 16; ++e) { hb[e] += v[e] * r * gg[e]; s2 += hb[e] * hb[e]; }
        if (outf) { float* o = outf + (size_t)m * DM;
            *(f32x4*)(o + 8 * lane) = (f32x4){hb[0], hb[1], hb[2], hb[3]}; *(f32x4*)(o + 8 * lane + 4) = (f32x4){hb[4], hb[5], hb[6], hb[7]};
            *(f32x4*)(o + 512 + 8 * lane) = (f32x4){hb[8], hb[9], hb[10], hb[11]}; *(f32x4*)(o + 512 + 8 * lane + 4) = (f32x4){hb[12], hb[13], hb[14], hb[15]};
        } else {
            const float r2 = rsqrtf(wave_sum(s2, lane) * (1.f / DM) + 1e-6f);
            if (lane == 0) RS[m] = r2;
            u32x4 w0, w1;
            w0.x = pk2(hb[0], hb[1]); w0.y = pk2(hb[2], hb[3]); w0.z = pk2(hb[4], hb[5]); w0.w = pk2(hb[6], hb[7]);
            w1.x = pk2(hb[8], hb[9]); w1.y = pk2(hb[10], hb[11]); w1.z = pk2(hb[12], hb[13]); w1.w = pk2(hb[14], hb[15]);
            *(u32x4*)(HB + (size_t)m * DM + 8 * lane) = w0; *(u32x4*)(HB + (size_t)m * DM + 512 + 8 * lane) = w1;
        }
    }
}

namespace pg8 {
#define PG8_LAS __attribute__((address_space(3)))
typedef unsigned short bf16_t;
typedef short bf16x8 __attribute__((ext_vector_type(8)));
typedef float f32x4 __attribute__((ext_vector_type(4)));
typedef unsigned u32x4 __attribute__((ext_vector_type(4)));
constexpr int BM = 256, BK = 64, HALF = 128, HTB = HALF * BK * 2  , STAGE_BYTES = 8 * HTB, NXCD = 8, WGM = 8;

__host__ __device__ __forceinline__ int lds_byte(int r, int c) { const int st = (r >> 4) * 2 + (c >> 5), rr = r & 15, cc = c & 31, ob = rr * 64 + cc * 2; return st * 1024 + (ob ^ (((ob >> 9) & 1) << 5)); }
__host__ __device__ __forceinline__ void stage_rc(int b, int& R, int& C) { const int st = b / 1024, sb = b % 1024, swz = sb ^ (((sb >> 9) & 1) << 5); R = (st >> 1) * 16 + swz / 64; C = (st & 1) * 32 + (swz % 64) / 2; }
__host__ __device__ __forceinline__ int perm32(int rho) { const int n = rho >> 4, i = rho & 15; return 8 * (i >> 2) + 4 * n + (i & 3); }

struct Unit { int pm, pn; };
struct Gemm { const bf16_t* A; const bf16_t* Bt; int M, N, K; };

struct StaticOrder {
    int nM, nN, nwg, G, c;
    __host__ __device__ void init(int M, int N, int G_, int c_) { nM = M / BM; nN = N / BM; nwg = nM * nN; G = G_; c = c_; }
    __host__ __device__ bool next(int i, Unit& u) const {
        const long L = (long)i * G + c; if (L >= nwg) return false;
        int wgid = (int)L; { const int q = nwg / NXCD, r = nwg % NXCD, xcd = wgid % NXCD, off = wgid / NXCD; wgid = (xcd < r ? xcd * (q + 1) : r * (q + 1) + (xcd - r) * q) + off; }
        const int nig = WGM * nN, gid = wgid / nig, fm = gid * WGM, gsz = (nM - fm) < WGM ? (nM - fm) : WGM;
        u.pm = fm + ((wgid % nig) % gsz); u.pn = (wgid % nig) / gsz; return true;
    }
    __device__ __forceinline__ void a_ready(const Unit&) const {}
    __device__ __forceinline__ void done(const Unit&) const {}
};

__device__ __forceinline__ unsigned cvt_pk_bf16(float lo, float hi) { unsigned r; asm volatile("v_cvt_pk_bf16_f32 %0, %1, %2" : "=v"(r) : "v"(lo), "v"(hi)); return r; }
typedef float f32x2 __attribute__((ext_vector_type(2)));
__device__ __forceinline__ f32x2 gelu_pk(f32x2 v) {
    const f32x2 av = __builtin_elementwise_abs(v), d = av * 0.2316418882f + 1.0f;
    f32x2 t; t.x = __builtin_amdgcn_rcpf(d.x); t.y = __builtin_amdgcn_rcpf(d.y);
    f32x2 q = t * 0.5307027145f + (-0.7265760135f); q = q * t + 0.7107068705f; q = q * t + (-0.142248368f); q = q * t + 0.127414796f; q = q * t;
    const f32x2 s = (v * v) * (-0.72134752044f);
    f32x2 e; e.x = __builtin_amdgcn_exp2f(s.x); e.y = __builtin_amdgcn_exp2f(s.y);
    const f32x2 m = v * (q * e), r = v - m;
    f32x2 o; o.x = v.x < 0.f ? m.x : r.x; o.y = v.y < 0.f ? m.y : r.y; return o;
}

template <int ACT  > struct EpiBf16 {
    static constexpr bool PERM = true, AFTER_DRAIN = false; static_assert(ACT == 0 || ACT == 1, "EpiBf16: ACT is 0 (none) or 1 (gelu_pk)");
    bf16_t* O; int ldc; const float* bias; int split_cols; size_t split_stride; float scale0;
    __device__ __forceinline__ void operator()(const f32x4 (&acc)[2][2][4][2], const Unit& u, int wr, int wc, int fr, int fq) const {
        const int row0 = u.pm * BM + wr * 64 + fr; int colt = u.pn * BM; bf16_t* base = O;
        float sc = 1.f; if (split_cols) { const int t = colt / split_cols; base += (size_t)t * split_stride; colt -= t * split_cols; if (t == 0) sc = scale0; }
        const int col0 = colt + wc * 32 + 8 * fq, bcol0 = u.pn * BM + wc * 32 + 8 * fq;
        f32x4 bv[2][2];
#pragma unroll
        for (int bj = 0; bj < 2; ++bj)
#pragma unroll
            for (int n = 0; n < 2; ++n) bv[bj][n] = bias ? *(const f32x4*)(bias + bcol0 + bj * HALF + 4 * n) : (f32x4){0.f, 0.f, 0.f, 0.f};
#pragma unroll
        for (int ai = 0; ai < 2; ++ai)
#pragma unroll
            for (int m = 0; m < 4; ++m) { bf16_t* rowp = base + (size_t)(row0 + ai * HALF + m * 16) * ldc + col0;
#pragma unroll
                for (int bj = 0; bj < 2; ++bj) { f32x4 v0 = acc[ai][bj][m][0] + bv[bj][0], v1 = acc[ai][bj][m][1] + bv[bj][1];
                    if (ACT == 1) { f32x2 a = gelu_pk((f32x2){v0[0], v0[1]}), b = gelu_pk((f32x2){v0[2], v0[3]}), c = gelu_pk((f32x2){v1[0], v1[1]}), d = gelu_pk((f32x2){v1[2], v1[3]});
                        v0 = (f32x4){a.x, a.y, b.x, b.y}; v1 = (f32x4){c.x, c.y, d.x, d.y}; }
                    v0 = v0 * sc; v1 = v1 * sc; u32x4 w; w.x = cvt_pk_bf16(v0[0], v0[1]); w.y = cvt_pk_bf16(v0[2], v0[3]); w.z = cvt_pk_bf16(v1[0], v1[1]); w.w = cvt_pk_bf16(v1[2], v1[3]);
                    *(u32x4*)(rowp + bj * HALF) = w; } }
    }
};

struct PanelStats {
    unsigned* xbuf;
    unsigned* cnt;
    unsigned* tmo;
    int ntn; float eps;
    unsigned code;
    __device__ __forceinline__ bool run(const f32x4 (&v)[2][2][4][2], const Unit& u, int wr, int wc, int fr, int fq, PG8_LAS unsigned char* lds, int wid, int lane) const {
        typedef float f32x2v __attribute__((ext_vector_type(2)));
        PG8_LAS f32x2v* P = (PG8_LAS f32x2v*)lds;
        PG8_LAS f32x2v* S = (PG8_LAS f32x2v*)(lds + 8192);
        PG8_LAS unsigned* flag = (PG8_LAS unsigned*)(lds + 8192 + 2048);
#pragma unroll
        for (int ai = 0; ai < 2; ++ai)
#pragma unroll
            for (int m = 0; m < 4; ++m) {
                float s = 0.f;
#pragma unroll
                for (int bj = 0; bj < 2; ++bj)
#pragma unroll
                    for (int n = 0; n < 2; ++n) { const f32x4 x = v[ai][bj][m][n]; s += (x[0] + x[1]) + (x[2] + x[3]); }
                s += __shfl_xor(s, 16); s += __shfl_xor(s, 32);
                const float mw = s * (1.0f / 64.0f); float q = 0.f;
#pragma unroll
                for (int bj = 0; bj < 2; ++bj)
#pragma unroll
                    for (int n = 0; n < 2; ++n) { const f32x4 d = v[ai][bj][m][n] - mw; q += (d[0] * d[0] + d[1] * d[1]) + (d[2] * d[2] + d[3] * d[3]); }
                q += __shfl_xor(q, 16); q += __shfl_xor(q, 32);
                if (fq == 0) P[(ai * HALF + wr * 64 + m * 16 + fr) * 4 + wc] = (f32x2v){mw, q};
            }
        asm volatile("s_waitcnt lgkmcnt(0)" ::: "memory"); __builtin_amdgcn_s_barrier(); asm volatile("" ::: "memory");
#if defined(BROKEN_EXCHANGE_NO_WAIT)
#warning BROKEN CONTROL BUILD: the row-statistics exchange does not wait; results are wrong by design
        if (blockIdx.x >= 64) { const long long t0_ = clock64(); while (clock64() - t0_ < 60000) __builtin_amdgcn_s_sleep(8); }
#endif
        const int row = wid * 32 + (lane & 31);
        if (lane < 32) {
            const f32x2v a = P[row * 4 + 0], b = P[row * 4 + 1], c = P[row * 4 + 2], d = P[row * 4 + 3];
            const float mt = (a.x + b.x + c.x + d.x) * 0.25f;
            const float da = a.x - mt, db = b.x - mt, dc = c.x - mt, dd = d.x - mt;
            const float m2 = (a.y + b.y) + (c.y + d.y) + 64.0f * ((da * da + db * db) + (dc * dc + dd * dd));
            unsigned long long* slot = (unsigned long long*)xbuf + ((size_t)(u.pm * BM + row) * 4 + u.pn);
            __hip_atomic_store(slot, ((unsigned long long)__float_as_uint(m2) << 32) | __float_as_uint(mt), __ATOMIC_RELAXED, __HIP_MEMORY_SCOPE_AGENT);
        }
        asm volatile("s_waitcnt vmcnt(0)" ::: "memory");
        if (lane == 0) __hip_atomic_fetch_add(cnt + 64 * u.pm, 1u, __ATOMIC_RELAXED, __HIP_MEMORY_SCOPE_AGENT);
        if (wid == 0) {
            bool dead = false; const unsigned long long t0 = __builtin_amdgcn_s_memrealtime(); const unsigned want = 8u * (unsigned)ntn;
            for (;;) {
#if defined(BROKEN_EXCHANGE_NO_WAIT)
                break;
#endif
                if ((unsigned)__builtin_amdgcn_readfirstlane(__hip_atomic_load(cnt + 64 * u.pm, __ATOMIC_RELAXED, __HIP_MEMORY_SCOPE_AGENT)) >= want) break;
                if (__builtin_amdgcn_s_memrealtime() - t0 > 2000000ull) {
                    if (lane == 0) { unsigned expect = 0u; __hip_atomic_compare_exchange_strong(tmo + 1, &expect, code | (unsigned)(u.pm & 0xff), __ATOMIC_RELAXED, __ATOMIC_RELAXED, __HIP_MEMORY_SCOPE_AGENT);
                                     __hip_atomic_store(tmo, 1u, __ATOMIC_RELAXED, __HIP_MEMORY_SCOPE_AGENT); }
                    dead = true; break; }
                __builtin_amdgcn_s_sleep(2);
            }
            __builtin_amdgcn_fence(__ATOMIC_ACQUIRE, "agent");
            if (lane == 0) flag[0] = dead ? 1u : 0u;
        }
        asm volatile("s_waitcnt vmcnt(0) lgkmcnt(0)" ::: "memory"); __builtin_amdgcn_s_barrier(); asm volatile("" ::: "memory");
        const bool bad = flag[0] != 0u;
        if (lane < 32) {
            const unsigned long long* slot = (const unsigned long long*)xbuf + (size_t)(u.pm * BM + row) * 4; float mt[4], m2[4]; float ms = 0.f;
#pragma unroll
            for (int t = 0; t < 4; ++t) { if (t < ntn) { const unsigned long long w = __hip_atomic_load(slot + t, __ATOMIC_RELAXED, __HIP_MEMORY_SCOPE_AGENT); mt[t] = __uint_as_float((unsigned)w); m2[t] = __uint_as_float((unsigned)(w >> 32)); } else { mt[t] = 0.f; m2[t] = 0.f; } ms += mt[t]; }
            const float mean = ms / (float)ntn; float q = 0.f;
#pragma unroll
            for (int t = 0; t < 4; ++t) if (t < ntn) { const float dm = mt[t] - mean; q += m2[t] + 256.0f * dm * dm; }
            S[row] = (f32x2v){mean, 1.0f / sqrtf(q / (256.0f * (float)ntn) + eps)};
        }
        asm volatile("s_waitcnt lgkmcnt(0)" ::: "memory"); __builtin_amdgcn_s_barrier(); asm volatile("" ::: "memory");
        return bad;
    }
};
struct EpiLnRes {
    static constexpr bool PERM = false, AFTER_DRAIN = true;
    const float* base; float* out; int ldc; const float* bias; PanelStats st; unsigned poison;
    __device__ __forceinline__ void fused(f32x4 (&acc)[2][2][4][2], const Unit& u, int wr, int wc, int fr, int fq, PG8_LAS unsigned char* lds, int wid, int lane) const {
        typedef float f32x2v __attribute__((ext_vector_type(2)));
        const PG8_LAS f32x2v* S = (const PG8_LAS f32x2v*)(lds + 8192);
        const int col0 = u.pn * BM + wc * 32 + 4 * fq;
#pragma unroll
        for (int bj = 0; bj < 2; ++bj)
#pragma unroll
            for (int n = 0; n < 2; ++n) { const f32x4 bv = bias ? *(const f32x4*)(bias + col0 + bj * HALF + n * 16) : (f32x4){0.f, 0.f, 0.f, 0.f};
#pragma unroll
                for (int ai = 0; ai < 2; ++ai)
#pragma unroll
                    for (int m = 0; m < 4; ++m) acc[ai][bj][m][n] += bv; }
        f32x4 pre[4][2][2];
#pragma unroll
        for (int m = 0; m < 4; ++m) { const size_t off = (size_t)(u.pm * BM + wr * 64 + m * 16 + fr) * ldc + col0;
#pragma unroll
            for (int bj = 0; bj < 2; ++bj)
#pragma unroll
                for (int n = 0; n < 2; ++n) pre[m][bj][n] = *(const f32x4*)(base + off + bj * HALF + n * 16); }
        const bool bad = st.run(acc, u, wr, wc, fr, fq, lds, wid, lane) || poison != 0u;
        const float qnan = __builtin_nanf("");
#pragma unroll
        for (int ai = 0; ai < 2; ++ai)
#pragma unroll
            for (int m = 0; m < 4; ++m) { const int r = ai * HALF + wr * 64 + m * 16 + fr; const f32x2v sr = S[r]; const size_t off = (size_t)(u.pm * BM + r) * ldc + col0;
#pragma unroll
                for (int bj = 0; bj < 2; ++bj)
#pragma unroll
                    for (int n = 0; n < 2; ++n) { const f32x4 bs = ai == 0 ? pre[m][bj][n] : *(const f32x4*)(base + off + bj * HALF + n * 16); f32x4 o = bs + (acc[ai][bj][m][n] - sr.x) * sr.y;
                        if (bad) o = (f32x4){qnan, qnan, qnan, qnan}; *(f32x4*)(out + off + bj * HALF + n * 16) = o; }
                if (m & 1) asm volatile("" ::: "memory"); }
    }
};
struct EpiLnResLn {
    static constexpr bool PERM = false, AFTER_DRAIN = true;
    const float* base; float* out; bf16_t* xn; int ldc; const float* bias; PanelStats st1, st2; unsigned poison;
    __device__ __forceinline__ void fused(f32x4 (&acc)[2][2][4][2], const Unit& u, int wr, int wc, int fr, int fq, PG8_LAS unsigned char* lds, int wid, int lane) const {
        typedef float f32x2v __attribute__((ext_vector_type(2))); typedef unsigned u32x2v __attribute__((ext_vector_type(2)));
        const PG8_LAS f32x2v* S = (const PG8_LAS f32x2v*)(lds + 8192);
        const int col0 = u.pn * BM + wc * 32 + 4 * fq;
#pragma unroll
        for (int bj = 0; bj < 2; ++bj)
#pragma unroll
            for (int n = 0; n < 2; ++n) { const f32x4 bv = bias ? *(const f32x4*)(bias + col0 + bj * HALF + n * 16) : (f32x4){0.f, 0.f, 0.f, 0.f};
#pragma unroll
                for (int ai = 0; ai < 2; ++ai)
#pragma unroll
                    for (int m = 0; m < 4; ++m) acc[ai][bj][m][n] += bv; }
        bool bad = st1.run(acc, u, wr, wc, fr, fq, lds, wid, lane) || poison != 0u;
        const float qnan = __builtin_nanf("");
#pragma unroll
        for (int ai = 0; ai < 2; ++ai)
#pragma unroll
            for (int m = 0; m < 4; ++m) { const int r = ai * HALF + wr * 64 + m * 16 + fr; const f32x2v sr = S[r]; const size_t off = (size_t)(u.pm * BM + r) * ldc + col0;
#pragma unroll
                for (int bj = 0; bj < 2; ++bj)
#pragma unroll
                    for (int n = 0; n < 2; ++n) { const f32x4 bs = *(const f32x4*)(base + off + bj * HALF + n * 16); acc[ai][bj][m][n] = bs + (acc[ai][bj][m][n] - sr.x) * sr.y; }
                asm volatile("" : "+v"(acc[ai][0][m][0]), "+v"(acc[ai][0][m][1]), "+v"(acc[ai][1][m][0]), "+v"(acc[ai][1][m][1]));
                if (m & 1) asm volatile("" ::: "memory"); }
        const bool bad1 = bad;
        bad = st2.run(acc, u, wr, wc, fr, fq, lds, wid, lane) || bad;
#pragma unroll
        for (int ai = 0; ai < 2; ++ai)
#pragma unroll
            for (int m = 0; m < 4; ++m) { const int r = ai * HALF + wr * 64 + m * 16 + fr; const f32x2v sr = S[r]; const size_t off = (size_t)(u.pm * BM + r) * ldc + col0;
#pragma unroll
                for (int bj = 0; bj < 2; ++bj)
#pragma unroll
                    for (int n = 0; n < 2; ++n) { const f32x4 x1 = acc[ai][bj][m][n]; *(f32x4*)(out + off + bj * HALF + n * 16) = bad1 ? (f32x4){qnan, qnan, qnan, qnan} : x1;
                        const f32x4 o = (x1 - sr.x) * sr.y; u32x2v w; w.x = cvt_pk_bf16(o[0], o[1]); w.y = cvt_pk_bf16(o[2], o[3]);
                        if (bad) { w.x = 0x7fc07fc0u; w.y = 0x7fc07fc0u; } *(u32x2v*)(xn + off + bj * HALF + n * 16) = w; }
                asm volatile("" ::: "memory"); }
    }
};

template <class Epi, class Sched, bool ALIGN_EPI = false, bool SP2 = false>
__device__ __forceinline__ void gemm_phase(PG8_LAS unsigned char* lds, const Gemm g, const Sched& S, const Epi& E, int wv) {
    const int tid = otid(wv), wid = __builtin_amdgcn_readfirstlane(tid >> 6), lane = tid & 63, wr = wid >> 2, wc = wid & 3, fr = lane & 15, fq = lane >> 4;
    const int K = g.K, nt = K / BK;
    unsigned voffA[2], voffB[2];
#pragma unroll
    for (int i = 0; i < 2; ++i) { int R, C; stage_rc(tid * 16 + i * 8192, R, C); const int Rb = Epi::PERM ? ((R & ~31) + perm32(R & 31)) : R;
        voffA[i] = (unsigned)(R * K + C) * 2u; voffB[i] = (unsigned)(Rb * K + C) * 2u; }
    const size_t kstep = (size_t)(BK * 2);
    const size_t hstep = (size_t)HALF * K * 2;
    const size_t tstep = 2 * hstep;
    const unsigned ldsw = (unsigned)wid * 1024u;
    const int aoff = lds_byte(wr * 64 + fr, fq * 8), boff = lds_byte(wc * 32 + fr, fq * 8);
#define PG8_SA(b, h) (((b) * 2 + (h)) * HTB)
#define PG8_SB(b, h) ((4 + (b) * 2 + (h)) * HTB)
#define PG8_STAGE(bufoff, gbase, voff) do { _Pragma("unroll") for (int _i = 0; _i < 2; ++_i) \
        __builtin_amdgcn_global_load_lds((const unsigned*)((const char*)(gbase) + (voff)[_i]), (PG8_LAS unsigned*)(lds + (bufoff) + ldsw + _i * 8192), 16, 0, 0); } while (0)
#define PG8_LDA(dst, b, h) do { _Pragma("unroll") for (int m = 0; m < 4; ++m) _Pragma("unroll") for (int k = 0; k < 2; ++k) dst[m][k] = *(const PG8_LAS bf16x8*)(lds + PG8_SA(b, h) + aoff + m * 2048 + k * 1024); } while (0)
#define PG8_LDB(dst, b, h) do { _Pragma("unroll") for (int n = 0; n < 2; ++n) _Pragma("unroll") for (int k = 0; k < 2; ++k) dst[n][k] = *(const PG8_LAS bf16x8*)(lds + PG8_SB(b, h) + boff + n * 2048 + k * 1024); } while (0)
#define PG8_MMA(ai, bj, At, Bt) do { __builtin_amdgcn_s_setprio(1); _Pragma("unroll") for (int m = 0; m < 4; ++m) _Pragma("unroll") for (int n = 0; n < 2; ++n) _Pragma("unroll") for (int k = 0; k < 2; ++k) \
        acc[ai][bj][m][n] = __builtin_amdgcn_mfma_f32_16x16x32_bf16(Bt[n][k], At[m][k], acc[ai][bj][m][n], 0, 0, 0); __builtin_amdgcn_s_setprio(0); } while (0)
#define PG8_WAIT_V(n) asm volatile("s_waitcnt vmcnt(" #n ")" ::: "memory")
#define PG8_WAIT_L(n) asm volatile("s_waitcnt lgkmcnt(" #n ")" ::: "memory")
#define PG8_BAR __builtin_amdgcn_s_barrier()
#define PG8_SCHED __builtin_amdgcn_sched_barrier(0)
    Unit cur, nxt; int ui = 0;
    if (!S.next(0, cur)) return;
    f32x4 acc[2][2][4][2];
#pragma unroll
    for (int a = 0; a < 2; ++a)
#pragma unroll
        for (int b = 0; b < 2; ++b)
#pragma unroll
            for (int m = 0; m < 4; ++m)
#pragma unroll
                for (int n = 0; n < 2; ++n) acc[a][b][m][n] = (f32x4){0.f, 0.f, 0.f, 0.f};
    bf16x8 At[4][2], B0[2][2], B1[2][2];
    const char* cA = (const char*)g.A + (size_t)cur.pm * tstep; const char* cB = (const char*)g.Bt + (size_t)cur.pn * tstep;
    S.a_ready(cur);
    if constexpr (SP2) {
        PG8_STAGE(PG8_SB(0, 0), cB, voffB); PG8_STAGE(PG8_SB(0, 1), cB + hstep, voffB); PG8_STAGE(PG8_SA(0, 0), cA, voffA); PG8_STAGE(PG8_SA(0, 1), cA + hstep, voffA);
        if (wr == 1) PG8_BAR;
        PG8_WAIT_V(2); PG8_BAR;
        PG8_STAGE(PG8_SB(1, 0), cB + kstep, voffB); PG8_STAGE(PG8_SA(1, 0), cA + kstep, voffA); PG8_STAGE(PG8_SB(1, 1), cB + hstep + kstep, voffB);
        PG8_WAIT_V(6); PG8_BAR;
    } else {
        PG8_STAGE(PG8_SB(0, 0), cB, voffB); PG8_STAGE(PG8_SA(0, 0), cA, voffA); PG8_STAGE(PG8_SB(0, 1), cB + hstep, voffB); PG8_STAGE(PG8_SA(0, 1), cA + hstep, voffA);
        if (wr == 1) PG8_BAR;
        PG8_WAIT_V(4); PG8_BAR;
        PG8_STAGE(PG8_SB(1, 0), cB + kstep, voffB); PG8_STAGE(PG8_SA(1, 0), cA + kstep, voffA); PG8_STAGE(PG8_SB(1, 1), cB + hstep + kstep, voffB);
        PG8_WAIT_V(6); PG8_BAR;
    }
    for (;;) {
        const bool has_next = S.next(ui + 1, nxt);
        const char* nA = has_next ? (const char*)g.A + (size_t)nxt.pm * tstep : cA; const char* nB = has_next ? (const char*)g.Bt + (size_t)nxt.pn * tstep : cB;
        for (int t = 0; t < nt; t += 2) {
            const bool last = (t == nt - 2);
            const char* a1 = cA + (size_t)(t + 1) * kstep;
            const char* a2 = last ? nA : cA + (size_t)(t + 2) * kstep; const char* b2 = last ? nB : cB + (size_t)(t + 2) * kstep;
            const char* a3 = a2 + kstep; const char* b3 = b2 + kstep;
            if (last && has_next) S.a_ready(nxt);
            if constexpr (SP2) {
            PG8_LDB(B0, 0, 0); PG8_LDB(B1, 0, 1); PG8_SCHED; PG8_LDA(At, 0, 0); PG8_STAGE(PG8_SA(1, 1), a1 + hstep, voffA);
            PG8_WAIT_V(8); PG8_WAIT_L(0); PG8_BAR; PG8_MMA(0, 0, At, B0); PG8_MMA(0, 1, At, B1); PG8_BAR; PG8_SCHED;
            PG8_LDA(At, 0, 1); PG8_STAGE(PG8_SB(0, 0), b2, voffB); PG8_STAGE(PG8_SB(0, 1), b2 + hstep, voffB); PG8_STAGE(PG8_SA(0, 0), a2, voffA);
            PG8_WAIT_V(8); PG8_WAIT_L(0); PG8_BAR; PG8_MMA(1, 0, At, B0); PG8_MMA(1, 1, At, B1); PG8_BAR; PG8_SCHED;
            PG8_LDB(B0, 1, 0); PG8_LDB(B1, 1, 1); PG8_SCHED; PG8_LDA(At, 1, 0); PG8_STAGE(PG8_SA(0, 1), a2 + hstep, voffA);
            PG8_WAIT_V(8); PG8_WAIT_L(0); PG8_BAR; PG8_MMA(0, 0, At, B0); PG8_MMA(0, 1, At, B1); PG8_BAR; PG8_SCHED;
            PG8_LDA(At, 1, 1); PG8_STAGE(PG8_SB(1, 0), b3, voffB); PG8_STAGE(PG8_SB(1, 1), b3 + hstep, voffB); PG8_STAGE(PG8_SA(1, 0), a3, voffA);
            PG8_WAIT_V(8); PG8_WAIT_L(0); PG8_BAR; PG8_MMA(1, 0, At, B0); PG8_MMA(1, 1, At, B1); PG8_BAR; PG8_SCHED;
            } else {
            PG8_LDB(B0, 0, 0); PG8_SCHED; PG8_LDA(At, 0, 0); PG8_STAGE(PG8_SA(1, 1), a1 + hstep, voffA);
            PG8_WAIT_L(8); PG8_BAR; PG8_WAIT_L(0); PG8_MMA(0, 0, At, B0); PG8_BAR; PG8_SCHED;
            PG8_LDB(B1, 0, 1); PG8_STAGE(PG8_SB(0, 0), b2, voffB);
            PG8_BAR; PG8_WAIT_L(0); PG8_MMA(0, 1, At, B1); PG8_BAR;
            PG8_LDA(At, 0, 1); PG8_STAGE(PG8_SA(0, 0), a2, voffA);
            PG8_BAR; PG8_WAIT_L(0); PG8_MMA(1, 0, At, B0); PG8_BAR; PG8_SCHED;
            PG8_STAGE(PG8_SB(0, 1), b2 + hstep, voffB);
            PG8_WAIT_V(6); PG8_BAR; PG8_MMA(1, 1, At, B1); PG8_BAR;
            PG8_LDB(B0, 1, 0); PG8_SCHED; PG8_LDA(At, 1, 0); PG8_STAGE(PG8_SA(0, 1), a2 + hstep, voffA);
            PG8_WAIT_L(8); PG8_BAR; PG8_WAIT_L(0); PG8_MMA(0, 0, At, B0); PG8_BAR; PG8_SCHED;
            PG8_LDB(B1, 1, 1); PG8_STAGE(PG8_SB(1, 0), b3, voffB);
            PG8_BAR; PG8_WAIT_L(0); PG8_MMA(0, 1, At, B1); PG8_BAR;
            PG8_LDA(At, 1, 1); PG8_STAGE(PG8_SA(1, 0), a3, voffA);
            PG8_BAR; PG8_WAIT_L(0); PG8_MMA(1, 0, At, B0); PG8_BAR; PG8_SCHED;
            PG8_STAGE(PG8_SB(1, 1), b3 + hstep, voffB);
            PG8_WAIT_V(6); PG8_BAR; PG8_MMA(1, 1, At, B1); PG8_BAR;
            }
        }
        if constexpr (ALIGN_EPI) { if (wr == 0) PG8_BAR; }
        if constexpr (!Epi::AFTER_DRAIN) { E(acc, cur, wr, wc, fr, fq); S.done(cur); }
        if (!has_next) break;
#pragma unroll
        for (int a = 0; a < 2; ++a)
#pragma unroll
            for (int b = 0; b < 2; ++b)
#pragma unroll
                for (int m = 0; m < 4; ++m)
#pragma unroll
                    for (int n = 0; n < 2; ++n) acc[a][b][m][n] = (f32x4){0.f, 0.f, 0.f, 0.f};
        cur = nxt; cA = nA; cB = nB; ++ui;
        if constexpr (ALIGN_EPI) { if (wr == 1) PG8_BAR; }
    }
    PG8_WAIT_V(0);
    if constexpr (!ALIGN_EPI) { if (wr == 0) PG8_BAR; }
    PG8_BAR;
    if constexpr (Epi::AFTER_DRAIN) { E.fused(acc, cur, wr, wc, fr, fq, lds, wid, lane); S.done(cur); }
#undef PG8_SA
#undef PG8_SB
#undef PG8_STAGE
#undef PG8_LDA
#undef PG8_LDB
#undef PG8_MMA
#undef PG8_WAIT_V
#undef PG8_WAIT_L
#undef PG8_BAR
#undef PG8_SCHED
}
}

namespace pg8 {
struct EpiWinPg {
    static constexpr bool PERM = false, AFTER_DRAIN = false;
    bf16_t* Z; const float* rc; const float* rs; const float* RSr;
    __device__ __forceinline__ void operator()(const f32x4 (&acc)[2][2][4][2], const Unit& u, int wr, int wc, int fr, int fq) const {
        const bool qk = u.pn >= 4 && u.pn < 8; int pn_ = u.pn; asm volatile("" : "+s"(pn_)); const float sc = pn_ < 6 ? QSCALE : 1.f;
        const int fo = 16 * (wc & 1) + 4 * fq, rowb = u.pm * BM + wr * 64 + fr;
        f32x4 cn = (f32x4){1.f, 1.f, 1.f, 1.f}, sn = (f32x4){0.f, 0.f, 0.f, 0.f}; float rn = RSr[rowb];
        if (qk) { const int t = 16 + (rowb & 4095); cn = *(const f32x4*)(rc + t * 32 + fo); sn = *(const f32x4*)(rs + t * 32 + fo); }
#pragma unroll
        for (int k = 0; k < 8; ++k) { const int ai = k >> 2, m = k & 3; const int row = rowb + ai * HALF + m * 16;
                const f32x4 c = cn, s = sn; const float rsr = rn;
                if (k + 1 < 8) { const int rown = rowb + ((k + 1) >> 2) * HALF + ((k + 1) & 3) * 16; rn = RSr[rown];
                    if (qk) { const int t = 16 + (rown & 4095); cn = *(const f32x4*)(rc + t * 32 + fo); sn = *(const f32x4*)(rs + t * 32 + fo); } }
                __builtin_amdgcn_sched_barrier(0);
                bf16_t* rowp = Z + (size_t)row * 2560 + u.pn * BM + wc * 32 + 8 * fq;
#pragma unroll
                for (int bj = 0; bj < 2; ++bj) { f32x4 v0 = acc[ai][bj][m][0] * rsr, v1 = acc[ai][bj][m][1] * rsr;
                    if (qk) { const f32x4 x1 = v0, x2 = v1; v0 = (x1 * c - x2 * s) * sc; v1 = (x2 * c + x1 * s) * sc; }
                    u32x4 w; w.x = cvt_pk_bf16(v0[0], v0[1]); w.y = cvt_pk_bf16(v0[2], v0[3]); w.z = cvt_pk_bf16(v1[0], v1[1]); w.w = cvt_pk_bf16(v1[2], v1[3]);
                    *(u32x4*)(rowp + bj * HALF) = w; } }
    }
};
template <int CTRL> __device__ __forceinline__ f32x4 dppv(f32x4 v) { f32x4 r;
#pragma unroll
    for (int i = 0; i < 4; ++i) r[i] = __builtin_bit_cast(float, __builtin_amdgcn_update_dpp(0, __builtin_bit_cast(int, v[i]), CTRL, 0xf, 0xf, true));
    return r; }
__device__ __forceinline__ float gelu_fast(float x) { return x * __builtin_amdgcn_rcpf(1.f + __builtin_amdgcn_exp2f(-2.302208198f * (x + 0.044715f * x * x * x))); }
struct EpiUpPg {
    static constexpr bool PERM = false, AFTER_DRAIN = false;
    bf16_t* HID; const float* cw; const float* cb; float* GH; float* GT; float* VH; const float* RSr;
    __device__ __forceinline__ void operator()(const f32x4 (&acc)[2][2][4][2], const Unit& u, int wr, int wc, int fr, int fq) const {
        const int hb = 128 * u.pn + 32 * wc + 8 * fq;
        f32x4 w0[2], w1[2], w2[2], bb[2];
#pragma unroll
        for (int bj = 0; bj < 2; ++bj) { w0[bj] = *(const f32x4*)(cw + hb + 4 * bj); w1[bj] = *(const f32x4*)(cw + 3072 + hb + 4 * bj); w2[bj] = *(const f32x4*)(cw + 6144 + hb + 4 * bj); bb[bj] = *(const f32x4*)(cb + hb + 4 * bj); }
        const int a1 = (fq * 16 + ((fr - 1) & 15)) << 2, a2 = (fq * 16 + ((fr - 2) & 15)) << 2;
        float rsv[2][4];
#pragma unroll
        for (int ai = 0; ai < 2; ++ai)
#pragma unroll
            for (int m = 0; m < 4; ++m) rsv[ai][m] = RSr[u.pm * BM + ai * HALF + wr * 64 + m * 16 + fr];
#pragma unroll
        for (int ai = 0; ai < 2; ++ai) { f32x4 xp[2] = {{0.f, 0.f, 0.f, 0.f}, {0.f, 0.f, 0.f, 0.f}};
#pragma unroll
            for (int m = 0; m < 4; ++m) { const int row = u.pm * BM + ai * HALF + wr * 64 + m * 16 + fr; const int blk = row >> 6; const float rsr = rsv[ai][m];
                u32x4 w;
#pragma unroll
                for (int bj = 0; bj < 2; ++bj) { const int hc = hb + 4 * bj;
                    const f32x4 x = acc[ai][bj][m][0] * rsr, v = acc[ai][bj][m][1] * rsr;
                    f32x4 p1, p2;
#pragma unroll
                    for (int i = 0; i < 4; ++i) { const float s1 = fr == 15 ? xp[bj][i] : x[i], s2 = fr >= 14 ? xp[bj][i] : x[i];
                        p1[i] = __builtin_bit_cast(float, __builtin_amdgcn_update_dpp(0, __builtin_bit_cast(int, s1), 0x121, 0xf, 0xf, false));
                        p2[i] = __builtin_bit_cast(float, __builtin_amdgcn_update_dpp(0, __builtin_bit_cast(int, s2), 0x122, 0xf, 0xf, false)); }
                    const f32x4 gc = bb[bj] + w2[bj] * x + w1[bj] * p1 + w0[bj] * p2;
                    const unsigned lo = cvt_pk_bf16(gelu_fast(gc[0]) * v[0], gelu_fast(gc[1]) * v[1]), hi = cvt_pk_bf16(gelu_fast(gc[2]) * v[2], gelu_fast(gc[3]) * v[3]);
                    if (bj == 0) { w.x = lo; w.y = hi; } else { w.z = lo; w.w = hi; }
                    if (m == 0 && fr < 2) { *(f32x4*)(GH + ((size_t)blk * 2 + fr) * 3072 + hc) = x; *(f32x4*)(VH + ((size_t)blk * 2 + fr) * 3072 + hc) = v; }
                    if (m == 3 && fr >= 14) *(f32x4*)(GT + ((size_t)blk * 2 + (fr - 14)) * 3072 + hc) = x;
                    xp[bj] = x; }
                *(u32x4*)(HID + (size_t)row * 3072 + hb) = w; } }
    }
};

struct PanelRms {
    unsigned* xbuf; unsigned* cnt; unsigned* tmo; float eps; unsigned code;
    __device__ __forceinline__ bool run(const f32x4 (&v)[2][2][4][2], int gpm, int pn, int wr, int wc, int fr, int fq, PG8_LAS unsigned char* lds, int wid, int lane) const {
        PG8_LAS float* Pp = (PG8_LAS float*)lds;
        PG8_LAS float* S = (PG8_LAS float*)(lds + 8192);
        PG8_LAS unsigned* flag = (PG8_LAS unsigned*)(lds + 8192 + 2048);
#pragma unroll
        for (int ai = 0; ai < 2; ++ai)
#pragma unroll
            for (int m = 0; m < 4; ++m) { float q = 0.f;
#pragma unroll
                for (int bj = 0; bj < 2; ++bj)
#pragma unroll
                    for (int n = 0; n < 2; ++n) { const f32x4 x = v[ai][bj][m][n]; q += (x[0] * x[0] + x[1] * x[1]) + (x[2] * x[2] + x[3] * x[3]); }
                q += __int_as_float(__builtin_amdgcn_ds_bpermute((lane ^ 16) << 2, __float_as_int(q))); q += __int_as_float(__builtin_amdgcn_ds_bpermute((lane ^ 32) << 2, __float_as_int(q)));
                if (fq == 0) Pp[(ai * HALF + wr * 64 + m * 16 + fr) * 4 + wc] = q; }
        asm volatile("s_waitcnt lgkmcnt(0)" ::: "memory"); __builtin_amdgcn_s_barrier(); asm volatile("" ::: "memory");
        const int row = wid * 32 + (lane & 31);
        if (lane < 32) { const float t = (Pp[row * 4 + 0] + Pp[row * 4 + 1]) + (Pp[row * 4 + 2] + Pp[row * 4 + 3]);
            __hip_atomic_store(xbuf + ((size_t)(gpm * BM + row) * 4 + pn), __float_as_uint(t), __ATOMIC_RELAXED, __HIP_MEMORY_SCOPE_AGENT); }
        asm volatile("s_waitcnt vmcnt(0)" ::: "memory");
        if (lane == 0) __hip_atomic_fetch_add(cnt + 64 * gpm, 1u, __ATOMIC_RELAXED, __HIP_MEMORY_SCOPE_AGENT);
        if (wid == 0) {
            bool dead = false; const unsigned long long t0 = __builtin_amdgcn_s_memrealtime();
            for (;;) {
                if ((unsigned)__builtin_amdgcn_readfirstlane(__hip_atomic_load(cnt + 64 * gpm, __ATOMIC_RELAXED, __HIP_MEMORY_SCOPE_AGENT)) >= 32u) break;
                if (__builtin_amdgcn_s_memrealtime() - t0 > 2000000ull) {
                    if (lane == 0) { unsigned expect = 0u; __hip_atomic_compare_exchange_strong(tmo + 1, &expect, code | (unsigned)(gpm & 0xff), __ATOMIC_RELAXED, __ATOMIC_RELAXED, __HIP_MEMORY_SCOPE_AGENT);
                                     __hip_atomic_store(tmo, 1u, __ATOMIC_RELAXED, __HIP_MEMORY_SCOPE_AGENT); }
                    dead = true; break; }
                __builtin_amdgcn_s_sleep(2);
            }
            __builtin_amdgcn_fence(__ATOMIC_ACQUIRE, "agent");
            if (lane == 0) flag[0] = dead ? 1u : 0u;
        }
        asm volatile("s_waitcnt vmcnt(0) lgkmcnt(0)" ::: "memory"); __builtin_amdgcn_s_barrier(); asm volatile("" ::: "memory");
        const bool bad = flag[0] != 0u;
        if (lane < 32) { const unsigned* slot = xbuf + (size_t)(gpm * BM + row) * 4; float t = 0.f;
#pragma unroll
            for (int k = 0; k < 4; ++k) t += __uint_as_float(__hip_atomic_load(slot + k, __ATOMIC_RELAXED, __HIP_MEMORY_SCOPE_AGENT));
            S[row] = 1.0f / sqrtf(t * (1.0f / 1024.0f) + eps); }
        asm volatile("s_waitcnt lgkmcnt(0)" ::: "memory"); __builtin_amdgcn_s_barrier(); asm volatile("" ::: "memory");
        return bad;
    }
};
template <bool HASNEXT> struct EpiRmsRes {
    static constexpr bool PERM = false, AFTER_DRAIN = true;
    const float* base; float* out; bf16_t* xn; const float* gpost; const float* gnext; PanelRms st1, st2; int pm_off, pad;
    __device__ __forceinline__ void fused(f32x4 (&acc)[2][2][4][2], const Unit& u, int wr, int wc, int fr, int fq, PG8_LAS unsigned char* lds, int wid, int lane) const {
        typedef unsigned u32x2v __attribute__((ext_vector_type(2)));
        const PG8_LAS float* S = (const PG8_LAS float*)(lds + 8192);
        const int gpm = u.pm + pm_off, col0 = u.pn * BM + wc * 32 + 4 * fq;
        bool bad = st1.run(acc, gpm, u.pn, wr, wc, fr, fq, lds, wid, lane);
        const float qnan = __builtin_nanf("");
#pragma unroll
        for (int ai = 0; ai < 2; ++ai)
#pragma unroll
            for (int m = 0; m < 4; ++m) { int r = ai * HALF + wr * 64 + m * 16 + fr; asm volatile("" : "+v"(r)); const float rs = S[r]; const size_t off = (size_t)(gpm * BM + r) * 1024 + col0;
#pragma unroll
                for (int bj = 0; bj < 2; ++bj)
#pragma unroll
                    for (int n = 0; n < 2; ++n) { const f32x4 bs = *(const f32x4*)(base + off + bj * HALF + n * 16), gq = *(const f32x4*)(gpost + col0 + bj * HALF + n * 16); acc[ai][bj][m][n] = bs + acc[ai][bj][m][n] * rs * gq; }
                asm volatile("" : "+v"(acc[ai][0][m][0]), "+v"(acc[ai][0][m][1]), "+v"(acc[ai][1][m][0]), "+v"(acc[ai][1][m][1]));
                asm volatile("" ::: "memory"); }
        if constexpr (!HASNEXT) {
#pragma unroll
            for (int ai = 0; ai < 2; ++ai)
#pragma unroll
                for (int m = 0; m < 4; ++m) { int r = ai * HALF + wr * 64 + m * 16 + fr; asm volatile("" : "+v"(r)); const size_t off = (size_t)(gpm * BM + r) * 1024 + col0;
#pragma unroll
                    for (int bj = 0; bj < 2; ++bj)
#pragma unroll
                        for (int n = 0; n < 2; ++n) *(f32x4*)(out + off + bj * HALF + n * 16) = bad ? (f32x4){qnan, qnan, qnan, qnan} : acc[ai][bj][m][n]; }
            return;
        }
        if constexpr (HASNEXT) {
        const bool bad1 = bad;
        bad = st2.run(acc, gpm, u.pn, wr, wc, fr, fq, lds, wid, lane) || bad;
#pragma unroll
        for (int ai = 0; ai < 2; ++ai)
#pragma unroll
            for (int m = 0; m < 4; ++m) { int r = ai * HALF + wr * 64 + m * 16 + fr; asm volatile("" : "+v"(r)); const float rs = S[r]; const size_t off = (size_t)(gpm * BM + r) * 1024 + col0;
#pragma unroll
                for (int bj = 0; bj < 2; ++bj)
#pragma unroll
                    for (int n = 0; n < 2; ++n) { const f32x4 x1 = acc[ai][bj][m][n]; *(f32x4*)(out + off + bj * HALF + n * 16) = bad1 ? (f32x4){qnan, qnan, qnan, qnan} : x1;
                        const f32x4 o = x1 * rs * *(const f32x4*)(gnext + col0 + bj * HALF + n * 16); u32x2v w; w.x = cvt_pk_bf16(o[0], o[1]); w.y = cvt_pk_bf16(o[2], o[3]);
                        if (bad) { w.x = 0x7fc07fc0u; w.y = 0x7fc07fc0u; } *(u32x2v*)(xn + off + bj * HALF + n * 16) = w; }
                asm volatile("" ::: "memory"); }
        }
    }
};
struct EpiF32Pg {
    static constexpr bool PERM = false, AFTER_DRAIN = false;
    float* C; int ldc;
    __device__ __forceinline__ void operator()(const f32x4 (&acc)[2][2][4][2], const Unit& u, int wr, int wc, int fr, int fq) const {
        const int row0 = u.pm * BM + wr * 64 + fr, col0 = u.pn * BM + wc * 32 + 4 * fq;
#pragma unroll
        for (int ai = 0; ai < 2; ++ai)
#pragma unroll
            for (int m = 0; m < 4; ++m) { float* rowp = C + (size_t)(row0 + ai * HALF + m * 16) * ldc + col0;
#pragma unroll
                for (int bj = 0; bj < 2; ++bj)
#pragma unroll
                    for (int n = 0; n < 2; ++n) *(f32x4*)(rowp + bj * HALF + n * 16) = acc[ai][bj][m][n]; }
    }
};
}


constexpr int CW_META = 8192;
template <class Epi>
__device__ __forceinline__ void meta_gemm(const bf16_t* A, const bf16_t* Bt, int N, int K, const Epi& epi, unsigned char* lds, int wv) {
    const int tile = blockIdx.x;
    if (tile >= N / 32) return;
    const int lane = otid(wv) & 63, fr = lane & 15, fq = lane >> 4;
    f32x4 acc[1][2]; acc[0][0] = (f32x4){0.f, 0.f, 0.f, 0.f}; acc[0][1] = (f32x4){0.f, 0.f, 0.f, 0.f};
    const int kw = K / 8;
    const bf16_t* Ap = A + (size_t)fr * K + fq * 8 + wv * kw;
    const bf16_t* Bp = Bt + (size_t)(tile * 32 + fr) * K + fq * 8 + wv * kw;
    if (K == 1024) {
        bf16x8 a[4], b0[4], b1[4];
#pragma unroll
        for (int i = 0; i < 4; ++i) { a[i] = *(const bf16x8*)(Ap + 32 * i); b0[i] = *(const bf16x8*)(Bp + 32 * i); b1[i] = *(const bf16x8*)(Bp + (size_t)16 * 1024 + 32 * i); }
        __builtin_amdgcn_sched_barrier(0);
#pragma unroll
        for (int i = 0; i < 4; ++i) { acc[0][0] = __builtin_amdgcn_mfma_f32_16x16x32_bf16(b0[i], a[i], acc[0][0], 0, 0, 0); acc[0][1] = __builtin_amdgcn_mfma_f32_16x16x32_bf16(b1[i], a[i], acc[0][1], 0, 0, 0); }
    } else {
        bf16x8 a[12], b0[12], b1[12];
#pragma unroll
        for (int i = 0; i < 12; ++i) { a[i] = *(const bf16x8*)(Ap + 32 * i); b0[i] = *(const bf16x8*)(Bp + 32 * i); b1[i] = *(const bf16x8*)(Bp + (size_t)16 * 3072 + 32 * i); }
        __builtin_amdgcn_sched_barrier(0);
#pragma unroll
        for (int i = 0; i < 12; ++i) { acc[0][0] = __builtin_amdgcn_mfma_f32_16x16x32_bf16(b0[i], a[i], acc[0][0], 0, 0, 0); acc[0][1] = __builtin_amdgcn_mfma_f32_16x16x32_bf16(b1[i], a[i], acc[0][1], 0, 0, 0); }
    }
    f32x4* red = (f32x4*)lds;
    red[(wv * 2 + 0) * 64 + lane] = acc[0][0]; red[(wv * 2 + 1) * 64 + lane] = acc[0][1];
    __syncthreads();
    if (wv == 0) {
#pragma unroll
        for (int w = 1; w < 8; ++w) { acc[0][0] += red[(w * 2 + 0) * 64 + lane]; acc[0][1] += red[(w * 2 + 1) * 64 + lane]; }
        epi.template run<1, 2>(acc, 0, tile * 32, fr, fq);
    }
    __syncthreads();
}
__device__ __forceinline__ void meta_norm_last(unsigned* cnt, int ntiles, const float* Ym, const float* Hm_base, float* Hm, const float* gpost, float* RSm, bf16_t* Um, unsigned char* lds, int wv) {
    if ((int)blockIdx.x >= ntiles) return;
    const int lane = otid(wv) & 63;
    volatile unsigned* flag = (volatile unsigned*)(lds + 16384);
    if (wv == 0) {
        asm volatile("s_waitcnt vmcnt(0)" ::: "memory");
        __builtin_amdgcn_fence(__ATOMIC_RELEASE, "agent");
        asm volatile("s_waitcnt vmcnt(0)" ::: "memory");
        unsigned old = 0u;
        if (lane == 0) old = __hip_atomic_fetch_add(cnt, 1u, __ATOMIC_RELAXED, __HIP_MEMORY_SCOPE_AGENT);
        old = (unsigned)__builtin_amdgcn_readfirstlane((int)old);
        const bool last = old == (unsigned)(ntiles - 1);
        if (last) { __builtin_amdgcn_fence(__ATOMIC_ACQUIRE, "agent"); asm volatile("s_waitcnt vmcnt(0)" ::: "memory"); }
        if (lane == 0) *flag = last ? 1u : 0u;
    }
    __syncthreads();
    const bool last = *flag != 0u;
    __syncthreads();
    if (!last) return;
#pragma unroll
    for (int rr = 0; rr < 2; ++rr) { const int row = 2 * wv + rr;
        const float* y = Ym + row * DM; const float* bs = Hm_base + row * DM; float* ho = Hm + row * DM;
        f32x4 v[4]; float s = 0.f;
#pragma unroll
        for (int j = 0; j < 4; ++j) { v[j] = *(const f32x4*)(y + 4 * lane + 256 * j); s += (v[j].x * v[j].x + v[j].y * v[j].y) + (v[j].z * v[j].z + v[j].w * v[j].w); }
        const float r = rsqrtf(wave_sum(s, lane) * (1.f / DM) + 1e-6f);
        float s2 = 0.f;
#pragma unroll
        for (int j = 0; j < 4; ++j) { const f32x4 g = *(const f32x4*)(gpost + 4 * lane + 256 * j), bb = *(const f32x4*)(bs + 4 * lane + 256 * j);
            v[j] = bb + v[j] * r * g; *(f32x4*)(ho + 4 * lane + 256 * j) = v[j];
            s2 += (v[j].x * v[j].x + v[j].y * v[j].y) + (v[j].z * v[j].z + v[j].w * v[j].w); }
        if (RSm) {
            const float r2 = rsqrtf(wave_sum(s2, lane) * (1.f / DM) + 1e-6f);
            if (lane == 0) RSm[row] = r2;
            bf16_t* uo = Um + row * DM;
#pragma unroll
            for (int j = 0; j < 4; ++j) { u32x2 w; w.x = pk2(v[j].x, v[j].y); w.y = pk2(v[j].z, v[j].w); *(u32x2*)(uo + 4 * lane + 256 * j) = w; }
        }
    }
}
__device__ __forceinline__ void ph_meta_norm(const float* Ym, const float* Hm_base, float* Hm, const float* gpost, float* RSm, bf16_t* Um, int wv) {
    const int row = ((int)gridDim.x - 1 - (int)blockIdx.x) * 8 + wv;
    if (row >= NMETA) return;
    const int lane = otid(wv) & 63;
    const float* y = Ym + row * DM; const float* bs = Hm_base + row * DM; float* ho = Hm + row * DM;
    f32x4 v[4], g[4], bb[4]; float s = 0.f;
#pragma unroll
    for (int j = 0; j < 4; ++j) { v[j] = *(const f32x4*)(y + 4 * lane + 256 * j); g[j] = *(const f32x4*)(gpost + 4 * lane + 256 * j); bb[j] = *(const f32x4*)(bs + 4 * lane + 256 * j); }
#pragma unroll
    for (int j = 0; j < 4; ++j) s += (v[j].x * v[j].x + v[j].y * v[j].y) + (v[j].z * v[j].z + v[j].w * v[j].w);
    const float r = rsqrtf(wave_sum(s, lane) * (1.f / DM) + 1e-6f);
    float s2 = 0.f;
#pragma unroll
    for (int j = 0; j < 4; ++j) { v[j] = bb[j] + v[j] * r * g[j]; *(f32x4*)(ho + 4 * lane + 256 * j) = v[j];
        s2 += (v[j].x * v[j].x + v[j].y * v[j].y) + (v[j].z * v[j].z + v[j].w * v[j].w); }
    if (RSm) {
        const float r2 = rsqrtf(wave_sum(s2, lane) * (1.f / DM) + 1e-6f);
        if (lane == 0) RSm[row] = r2;
        bf16_t* uo = Um + row * DM;
#pragma unroll
        for (int j = 0; j < 4; ++j) { u32x2 w; w.x = pk2(v[j].x, v[j].y); w.y = pk2(v[j].z, v[j].w); *(u32x2*)(uo + 4 * lane + 256 * j) = w; }
    }
}
struct EpiUpMeta {
    bf16_t* HIDm; float* GM; const float* cw; const float* cb; const float* RSr;
    template <int MT, int NTL> __device__ __forceinline__ void run(const f32x4 (&acc)[MT][NTL], int row0, int col0, int fr, int fq) const {
        const int s = col0 & 255, hc = 128 * (col0 >> 8) + 32 * ((s >> 5) & 3) + 8 * fq + 4 * ((s >> 7) & 1);
        const float rsr = RSr[fr]; const f32x4 x = acc[0][0] * rsr, v = acc[0][1] * rsr;
        const int a1 = (fq * 16 + ((fr - 1) & 15)) << 2, a2 = (fq * 16 + ((fr - 2) & 15)) << 2;
        f32x4 p1, p2;
#pragma unroll
        for (int i = 0; i < 4; ++i) { const float t1 = __int_as_float(__builtin_amdgcn_ds_bpermute(a1, __float_as_int(x[i]))), t2 = __int_as_float(__builtin_amdgcn_ds_bpermute(a2, __float_as_int(x[i])));
            p1[i] = fr >= 1 ? t1 : 0.f; p2[i] = fr >= 2 ? t2 : 0.f; }
        const f32x4 w0 = *(const f32x4*)(cw + hc), w1 = *(const f32x4*)(cw + DFF + hc), w2 = *(const f32x4*)(cw + 2 * DFF + hc), bb = *(const f32x4*)(cb + hc);
        const f32x4 gc = bb + w2 * x + w1 * p1 + w0 * p2;
        u32x2 w; w.x = pk2(gelu_tanh(gc[0]) * v[0], gelu_tanh(gc[1]) * v[1]); w.y = pk2(gelu_tanh(gc[2]) * v[2], gelu_tanh(gc[3]) * v[3]);
        *(u32x2*)(HIDm + (size_t)fr * DFF + hc) = w;
        if (fr >= 14) *(f32x4*)(GM + (size_t)(fr - 14) * DFF + hc) = x;
    }
};
__device__ __forceinline__ float gelu_fast(float x) { return x * __builtin_amdgcn_rcpf(1.f + __builtin_amdgcn_exp2f(-2.302208198f * (x + 0.044715f * x * x * x))); }
__device__ __forceinline__ void ph_ffnfix(const P& p, int l, int wv) {
    constexpr int Q = DFF / 4;
    const int tg = blockIdx.x * NT + otid(wv);
    if (tg >= Q * 128) return;
    const int c = (tg % Q) * 4, grp = tg / Q;
    const float* GH = (const float*)(p.ws + WS_GH); const float* GT = (const float*)(p.ws + WS_GT); const float* VH = (const float*)(p.ws + WS_VH); const float* GM = (const float*)(p.ws + WS_GVM);
    bf16_t* HID = (bf16_t*)(p.ws + WS_HID);
    const float* cw = p.in[22] + (size_t)l * 3 * DFF; const float* cb = p.in[23] + (size_t)l * DFF;
    f32x4 h0[4], h1[4], t0[4], t1[4], v0[4], v1[4];
#pragma unroll
    for (int k = 0; k < 4; ++k) { const int blk = grp * 4 + k;
        const float* tp0 = (blk & 63) == 0 ? GM + c : GT + ((size_t)(blk - 1) * 2 + 0) * DFF + c;
        const float* tp1 = (blk & 63) == 0 ? GM + DFF + c : GT + ((size_t)(blk - 1) * 2 + 1) * DFF + c;
        t0[k] = *(const f32x4*)tp0; t1[k] = *(const f32x4*)tp1;
        h0[k] = *(const f32x4*)(GH + ((size_t)blk * 2 + 0) * DFF + c); h1[k] = *(const f32x4*)(GH + ((size_t)blk * 2 + 1) * DFF + c);
        v0[k] = *(const f32x4*)(VH + ((size_t)blk * 2 + 0) * DFF + c); v1[k] = *(const f32x4*)(VH + ((size_t)blk * 2 + 1) * DFF + c); }
    const f32x4 w0 = *(const f32x4*)(cw + c), w1 = *(const f32x4*)(cw + DFF + c), w2 = *(const f32x4*)(cw + 2 * DFF + c), bb = *(const f32x4*)(cb + c);
#pragma unroll
    for (int k = 0; k < 4; ++k) { const int blk = grp * 4 + k;
        const f32x4 xa = bb + w2 * h0[k] + w1 * t1[k] + w0 * t0[k], xb = bb + w2 * h1[k] + w1 * h0[k] + w0 * t1[k];
        u32x2 wa; wa.x = pk2(gelu_fast(xa[0]) * v0[k][0], gelu_fast(xa[1]) * v0[k][1]); wa.y = pk2(gelu_fast(xa[2]) * v0[k][2], gelu_fast(xa[3]) * v0[k][3]);
        u32x2 wb; wb.x = pk2(gelu_fast(xb[0]) * v1[k][0], gelu_fast(xb[1]) * v1[k][1]); wb.y = pk2(gelu_fast(xb[2]) * v1[k][2], gelu_fast(xb[3]) * v1[k][3]);
        *(u32x2*)(HID + ((size_t)blk * 64 + 0) * DFF + c) = wa; *(u32x2*)(HID + ((size_t)blk * 64 + 1) * DFF + c) = wb; }
}

#define LAS __attribute__((address_space(3)))
#define XB_TMO      128
#define XB_XCNT(j)  (256  + 64 * (j))
#define XB_XSUB(j)  (1280 + 64 * (j))
#define XB_XGEN(j)  (2304 + 64 * (j))
#define XB_TOP      3328
#define XB_TOPGEN   3392
#define XCD_BAR_WORDS 3456
#define XB_SPIN_CAP (1u << 22)
__device__ __forceinline__ unsigned xb_ld(unsigned* p)              { return __hip_atomic_load(p, __ATOMIC_RELAXED, __HIP_MEMORY_SCOPE_AGENT); }
__device__ __forceinline__ unsigned xb_add(unsigned* p, unsigned v) { return __hip_atomic_fetch_add(p, v, __ATOMIC_RELAXED, __HIP_MEMORY_SCOPE_AGENT); }
__device__ __forceinline__ unsigned xb_xcc_id() { return (unsigned)__builtin_amdgcn_s_getreg((3 << 11) | 20) & 0xFu; }
#define XB_SPIN(cond, bar) do { unsigned _sp = 0; while (cond) { __builtin_amdgcn_s_sleep(1); \
    if ((++_sp & 255u) == 0u) { if (xb_ld(&(bar)[XB_TMO])) break; if (_sp > XB_SPIN_CAP) { atomicAdd(&(bar)[XB_TMO], 1u); break; } } } } while (0)
struct XcdBarrier { unsigned* bar; unsigned x; volatile LAS unsigned* st; };
__device__ __forceinline__ XcdBarrier xcd_barrier_post(unsigned* bar, volatile LAS unsigned* st) {
    XcdBarrier b; b.bar = bar; b.x = xb_xcc_id(); b.st = st;
    if (threadIdx.x == 0) (void)xb_add(&bar[XB_XCNT(b.x)], 1u);
    return b;
}
__device__ __forceinline__ void xcd_barrier_complete(unsigned* bar, unsigned x, unsigned& nloc, unsigned& nx) {
    const unsigned G = gridDim.x * gridDim.y * gridDim.z;
    unsigned sum, cnt, mine, sp = 0u;
    for (;;) {
        sum = 0u; cnt = 0u; mine = 0u;
#pragma unroll
        for (unsigned j = 0; j < 16; ++j) { const unsigned c = xb_ld(&bar[XB_XCNT(j)]); sum += c; cnt += (c > 0u) ? 1u : 0u; mine = (j == x) ? c : mine; }
        if (sum == G) break;
        __builtin_amdgcn_s_sleep(1);
        if ((++sp & 255u) == 0u) { if (xb_ld(&bar[XB_TMO])) break; if (sp > XB_SPIN_CAP) { atomicAdd(&bar[XB_TMO], 1u); break; } }
    }
    nloc = mine > 0u ? mine : 1u; nx = cnt > 0u ? cnt : 1u;
}
template <bool FILL>
__device__ __forceinline__ void xcd_barrier(const XcdBarrier& b, int wv, const P* pp = nullptr, unsigned char* ldsf = nullptr, int fk = -1) {
    const bool t0 = otid(wv) == 0;
    asm volatile("s_waitcnt vmcnt(0)" ::: "memory");
    __syncthreads();
    if (FILL && wv != 0) fill_item(*pp, ldsf, fk, wv);
    if (t0) {
        unsigned* bar = b.bar;
        __builtin_amdgcn_s_waitcnt(0);
        unsigned nloc = b.st[0], nx = b.st[1];
        if (nloc == 0u) { xcd_barrier_complete(bar, b.x, nloc, nx); b.st[0] = nloc; b.st[1] = nx; }
        const unsigned old = xb_add(&bar[XB_XSUB(b.x)], 1u);
        const unsigned gen = old / nloc;
        if (old + 1u == (gen + 1u) * nloc) {
            __builtin_amdgcn_fence(__ATOMIC_RELEASE, "agent");
            asm volatile("s_waitcnt vmcnt(0)" ::: "memory");
            const unsigned og = xb_add(&bar[XB_TOP], 1u);
            const unsigned tg = og / nx;
            if (og + 1u == (tg + 1u) * nx) xb_add(&bar[XB_TOPGEN], 1u);
            else XB_SPIN(xb_ld(&bar[XB_TOPGEN]) == tg, bar);
            __builtin_amdgcn_fence(__ATOMIC_ACQUIRE, "agent");
            xb_add(&bar[XB_XGEN(b.x)], 1u);
            asm volatile("s_waitcnt vmcnt(0)" ::: "memory");
        } else {
            XB_SPIN(xb_ld(&bar[XB_XGEN(b.x)]) == gen, bar);
            __builtin_amdgcn_fence(__ATOMIC_ACQUIRE, "agent");
            asm volatile("s_waitcnt vmcnt(0)" ::: "memory");
        }
    }
    __syncthreads();
}

constexpr int LDS_BYTES = 147456;
constexpr int MISC_OFF = 131072 + 320;
constexpr size_t CTL_ZERO_BYTES = 512 << 10;

__global__ void __launch_bounds__(NT, 2) mk_fwd(P p) {
    extern __shared__ __attribute__((aligned(16))) unsigned char lds[];
    volatile LAS unsigned* MISC = (volatile LAS unsigned*)((LAS unsigned char*)lds + MISC_OFF);
    const int wv = __builtin_amdgcn_readfirstlane(threadIdx.x >> 6);
    if (threadIdx.x < 32) MISC[threadIdx.x] = 0u;
    __syncthreads();
    { unsigned* bp0_ = (unsigned*)p.ws; asm volatile("" : "+s"(bp0_)); (void)xcd_barrier_post(bp0_, MISC + 8); }
#define GRID_BAR() do { XcdBarrier b_; unsigned* bp_ = (unsigned*)p.ws; asm volatile("" : "+s"(bp_)); b_.bar = bp_; b_.x = xb_xcc_id(); b_.st = MISC + 8; xcd_barrier<false>(b_, wv); } while (0)
#define GRID_BAR_FILL(k) do { XcdBarrier b_; unsigned* bp_ = (unsigned*)p.ws; asm volatile("" : "+s"(bp_)); b_.bar = bp_; b_.x = xb_xcc_id(); b_.st = MISC + 8; xcd_barrier<true>(b_, wv, &p, lds, (k)); } while (0)
    unsigned char* ws = p.ws;
    bf16_t* U = (bf16_t*)(ws + WS_U); bf16_t* Um = (bf16_t*)(ws + WS_META + M_U);
    bf16_t* YC = (bf16_t*)(ws + WS_YC); bf16_t* YCm = (bf16_t*)(ws + WS_META + M_YC);
    float* Hm = (float*)(ws + WS_META + M_H); float* Ym = (float*)(ws + WS_META + M_Y);
    const float* rc = (const float*)(ws + WS_ROPEC); const float* rs = (const float*)(ws + WS_ROPES);

    ph_prologue(p, lds, wv);
    GRID_BAR_FILL(0);
#pragma unroll 1
    for (int l = 0; l < DEPTH; ++l) {
        unsigned char* wb = ws + WS_W + l * W_LAYER;
        const bf16_t* Win = (const bf16_t*)(wb + OFF_WIN); const bf16_t* Wout = (const bf16_t*)(wb + OFF_WOUT); const bf16_t* Wup = (const bf16_t*)(wb + OFF_WUP); const bf16_t* Wdn = (const bf16_t*)(wb + OFF_WDN);
        { int wv2 = wv; asm volatile("" : "+s"(wv2)); unsigned char* wsl = ws; asm volatile("" : "+s"(wsl));
          meta_gemm(Um, Win, INW, DM, EpiWin{(bf16_t*)(wsl + WS_META + M_ZB), rc, rs, (const float*)(wsl + WS_META + M_RS), 1, 0}, lds, wv2); }
        { pg8::Gemm g{U, Win, MR, INW, DM}; pg8::StaticOrder S; S.init(MR, INW, (int)gridDim.x, (int)blockIdx.x);
          pg8::EpiWinPg E{(bf16_t*)(ws + WS_ZB), rc, rs, (const float*)(ws + WS_RS)};
          pg8::gemm_phase<pg8::EpiWinPg, pg8::StaticOrder, true, true>((PG8_LAS unsigned char*)lds, g, S, E, wv); }
        GRID_BAR_FILL(l == 0 ? 1 : -1);
        lru::phase<0>(p, l, lds, wv);
        ph_lru(p, l, lds, wv);
        GRID_BAR_FILL(l == 0 ? 2 : -1);
        att::phase(p, l, lds, wv);
        ph_attn_meta(p, l, lds, wv);
        __syncthreads();
        lru::phase<1>(p, l, lds, wv);
        ph_lrunorm(p, l, wv);
        GRID_BAR_FILL(l == 0 ? 3 : -1);
        meta_gemm(YCm, Wout, DM, DM, EpiF32{Ym, DM, 0}, lds, wv);
        { pg8::Gemm g{YC, Wout, MR, DM, DM}; pg8::StaticOrder S; S.init(MR, DM, (int)gridDim.x, (int)blockIdx.x);
          pg8::EpiBf16<0> E{(bf16_t*)(ws + WS_YB1), DM, nullptr, 0, 0, 1.f};
          pg8::gemm_phase<pg8::EpiBf16<0>, pg8::StaticOrder, true, true>((PG8_LAS unsigned char*)lds, g, S, E, wv); }
        GRID_BAR_FILL(l == 0 ? 4 : -1);
        ph_meta_norm(Ym, l == 0 ? p.in[1] : Hm, Hm, p.in[3] + l * DM, (float*)(ws + WS_META + M_RS), Um, wv);
        ph_normres2((const bf16_t*)(ws + WS_YB1), U, p.in[3] + l * DM, (float*)(ws + WS_RS), nullptr, wv);
        GRID_BAR_FILL(l == 0 ? 5 : -1);
        meta_gemm(Um, Wup, 2 * DFF, DM, EpiUpMeta{(bf16_t*)(ws + WS_META + M_HID), (float*)(ws + WS_GVM), p.in[22] + (size_t)l * 3 * DFF, p.in[23] + (size_t)l * DFF, (const float*)(ws + WS_META + M_RS)}, lds, wv);
        { pg8::Gemm g{U, Wup, MR, 2 * DFF, DM}; pg8::StaticOrder S; S.init(MR, 2 * DFF, (int)gridDim.x, (int)blockIdx.x);
          pg8::EpiUpPg E{(bf16_t*)(ws + WS_HID), p.in[22] + (size_t)l * 3 * DFF, p.in[23] + (size_t)l * DFF, (float*)(ws + WS_GH), (float*)(ws + WS_GT), (float*)(ws + WS_VH), (const float*)(ws + WS_RS)};
          pg8::gemm_phase<pg8::EpiUpPg, pg8::StaticOrder, true, true>((PG8_LAS unsigned char*)lds, g, S, E, wv); }
        GRID_BAR_FILL(l == 0 ? 6 : -1);
        ph_ffnfix(p, l, wv);
        GRID_BAR();
        meta_gemm((const bf16_t*)(ws + WS_META + M_HID), Wdn, DM, DFF, EpiF32{Ym, DM, 0}, lds, wv);
        { pg8::Gemm g{(const bf16_t*)(ws + WS_HID), Wdn, MR, DM, DFF}; pg8::StaticOrder S; S.init(MR, DM, (int)gridDim.x, (int)blockIdx.x);
          pg8::EpiBf16<0> E{(bf16_t*)(ws + WS_YB2), DM, nullptr, 0, 0, 1.f};
          pg8::gemm_phase<pg8::EpiBf16<0>, pg8::StaticOrder, true, true>((PG8_LAS unsigned char*)lds, g, S, E, wv); }
        GRID_BAR();
        if (l + 1 < DEPTH) ph_meta_norm(Ym, Hm, Hm, p.in[5] + l * DM, (float*)(ws + WS_META + M_RS), Um, wv);
        ph_normres2((const bf16_t*)(ws + WS_YB2), U, p.in[5] + l * DM, (float*)(ws + WS_RS), l + 1 < DEPTH ? nullptr : p.out, wv);
        if (l + 1 < DEPTH) GRID_BAR();
    }
}

extern "C" void kernel_launch(void* const* d_in, const int* in_sizes, int n_in, void* d_out, int out_size, void* d_ws, size_t ws_size, hipStream_t stream) {
    static int grid = 0;
    if (grid == 0) {
        if (n_in != 25 || ws_size < WS_END) { fprintf(stderr, "kernel_launch: unexpected n_in %d or ws_size %zu\n", n_in, ws_size); grid = -1; return; }
        int dev = 0, cus = 0, per_cu = 0;
        hipGetDevice(&dev);
        hipDeviceGetAttribute(&cus, hipDeviceAttributeMultiprocessorCount, dev);
        if (hipFuncSetAttribute((const void*)mk_fwd, hipFuncAttributeMaxDynamicSharedMemorySize, LDS_BYTES) != hipSuccess) { fprintf(stderr, "kernel_launch: hipFuncSetAttribute failed\n"); grid = -1; return; }
        hipOccupancyMaxActiveBlocksPerMultiprocessor(&per_cu, (const void*)mk_fwd, NT, LDS_BYTES);
        (void)hipGetLastError();
        if (per_cu < 1) { fprintf(stderr, "kernel_launch: occupancy query says %d blocks/CU\n", per_cu); per_cu = 1; }
        if (cus != 256) { fprintf(stderr, "kernel_launch: built for 256 CUs (one 256x256 unit per workgroup in the fused-norm GEMM phases), device has %d\n", cus); grid = -1; return; }
        grid = cus;
    }
    if (grid < 0) return;
    hipMemsetAsync(d_ws, 0, CTL_ZERO_BYTES, stream);
    P p{};
    for (int i = 0; i < 25; ++i) p.in[i] = (const float*)d_in[i];
    p.out = (float*)d_out; p.ws = (unsigned char*)d_ws;
    void* args[] = {&p};
    hipError_t e = hipLaunchCooperativeKernel((const void*)mk_fwd, dim3(grid), dim3(NT), args, LDS_BYTES, stream);
    if (e != hipSuccess) fprintf(stderr, "kernel_launch: cooperative launch failed: %s (grid %d)\n", hipGetErrorString(e), grid);
}
```

```cpp
#include <hip/hip_runtime.h>
#include <cstdint>
#include <cstdio>

typedef unsigned short bf16_t;
typedef short bf16x8 __attribute__((ext_vector_type(8)));
typedef float f32x4 __attribute__((ext_vector_type(4)));
typedef unsigned u32x2 __attribute__((ext_vector_type(2)));
typedef unsigned u32x4 __attribute__((ext_vector_type(4)));

constexpr int DM = 1024, NBATCH = 8, SEQ = 4096, NMETA = 16, TT = SEQ + NMETA, DEPTH = 2;
constexpr int MR = NBATCH * SEQ;
constexpr int LRUW = 512, NH = 4, DFF = 3072, INW = 2560;
constexpr int NT = 512;
constexpr float QSCALE = 0.125f * 1.4426950408889634f;

constexpr size_t MiB = 1u << 20;
constexpr size_t WS_W = 2 * MiB, W_LAYER = 25 * MiB;
constexpr size_t OFF_WIN = 0, OFF_WOUT = 5 * MiB, OFF_WUP = 7 * MiB, OFF_WDN = 19 * MiB;
constexpr size_t WS_ROPEC = 52 * MiB, WS_ROPES = 53 * MiB;
constexpr size_t WS_META = 54 * MiB;
constexpr size_t M_H = 0, M_U = 64 << 10, M_ZB = 128 << 10, M_T1 = 256 << 10, M_YC = 320 << 10, M_Y = 384 << 10, M_GV = 512 << 10, M_HID = 768 << 10;
constexpr size_t WS_WG = 55 * MiB;
constexpr size_t WS_CA = 56 * MiB, WS_CB = 58 * MiB;
constexpr size_t M_HME = 896 << 10;
constexpr size_t WS_GVM = 60 * MiB;
constexpr size_t WS_GH = 128 * MiB, WS_GT = 140 * MiB, WS_VH = 152 * MiB;
constexpr size_t WS_XA = 61 * MiB, WS_XB = 62 * MiB;
constexpr int CW_SEAM = 16384, SEAM_BANK = 128 * 64;
constexpr size_t WS_RS = 63 * MiB;
constexpr size_t M_RS = 960 << 10;
constexpr size_t WS_YB1 = 192 * MiB, WS_YB2 = 128 * MiB;
constexpr size_t WS_U = 64 * MiB, WS_YC = 128 * MiB, WS_ZB = 192 * MiB, WS_T1 = 352 * MiB, WS_Y1 = 384 * MiB;
constexpr size_t WS_GV = 128 * MiB, WS_HID = 320 * MiB, WS_Y2 = 128 * MiB, WS_END = 512 * MiB;

struct P { const float* in[25]; float* out; unsigned char* ws; };

__device__ __forceinline__ float bf2f(bf16_t v) { return __uint_as_float((unsigned)v << 16); }
__device__ __forceinline__ unsigned f2bf(float f) { unsigned u = __float_as_uint(f); return (u + 0x7fffu + ((u >> 16) & 1u)) >> 16; }
__device__ __forceinline__ unsigned pk2(float lo, float hi) { return f2bf(lo) | (f2bf(hi) << 16); }
__device__ __forceinline__ float shx(float v, int mask, int lane) { return __int_as_float(__builtin_amdgcn_ds_bpermute((lane ^ mask) << 2, __float_as_int(v))); }
__device__ __forceinline__ float wave_sum(float v, int lane) {
#pragma unroll
    for (int o = 1; o < 64; o <<= 1) v += shx(v, o, lane);
    return v;
}
__device__ __forceinline__ float wave_max(float v, int lane) {
#pragma unroll
    for (int o = 1; o < 64; o <<= 1) v = fmaxf(v, shx(v, o, lane));
    return v;
}
__device__ __forceinline__ int otid(int wv) { int l; asm volatile("v_mbcnt_lo_u32_b32 %0, -1, 0\n\tv_mbcnt_hi_u32_b32 %0, -1, %0" : "=v"(l)); return wv * 64 + l; }
__device__ __forceinline__ void wsync() { asm volatile("s_waitcnt lgkmcnt(0)" ::: "memory"); }
__device__ __forceinline__ float gelu_tanh(float x) { return 0.5f * x * (1.f + tanhf(0.7978845608028654f * (x + 0.044715f * x * x * x))); }
__device__ __forceinline__ float lambda_init_of(int l) { return l == 0 ? 0.2f : (0.8f - 0.6f * 0.7408182206817179f); }

__device__ __forceinline__ int win_col(int slot) { const int s = slot & 31, n = s >> 4, fq = (s >> 2) & 3, i = s & 3;
    if (slot >= 1024 && slot < 2048) return (slot & ~63) + 16 * ((slot >> 5) & 1) + 4 * fq + i + 32 * n;
    return (slot & ~31) + 8 * fq + 4 * n + i; }
__device__ __forceinline__ int wup_col(int slot) { const int s = slot & 255, hid = 128 * (slot >> 8) + 32 * ((s >> 5) & 3) + 8 * ((s >> 2) & 3) + 4 * ((s >> 7) & 1) + (s & 3); return ((s >> 4) & 1) ? DFF + hid : hid; }
__device__ __forceinline__ int wup_slot(int hid) { return 256 * (hid >> 7) + 128 * ((hid >> 2) & 1) + 32 * ((hid >> 5) & 3) + 4 * ((hid >> 3) & 3) + (hid & 3); }
template <int PERMQK, bool DEEP = false>
__device__ __forceinline__ void transpose_item(const float* W, int K, int N, bf16_t* WT, float* scr, int item, int lane, const float* gk = nullptr) {
    const int nblk = N / 32, kb = item / nblk, nb = item % nblk, k0 = 64 * kb, n0 = 32 * nb;
    if (DEEP) {
        float v[32];
#pragma unroll
        for (int i = 0; i < 32; ++i) { const int kk = 2 * i + (lane >> 5); v[i] = W[(size_t)(k0 + kk) * N + (PERMQK == 1 ? win_col(n0 + (lane & 31)) : PERMQK == 2 ? wup_col(n0 + (lane & 31)) : n0 + (lane & 31))]; }
        if (gk) {
#pragma unroll
            for (int i = 0; i < 32; ++i) v[i] *= gk[k0 + 2 * i + (lane >> 5)];
        }
#pragma unroll
        for (int i = 0; i < 32; ++i) scr[(2 * i + (lane >> 5)) * 33 + (lane & 31)] = v[i];
    } else
#pragma unroll 8
    for (int i = 0; i < 32; ++i) { const int kk = 2 * i + (lane >> 5); scr[kk * 33 + (lane & 31)] = W[(size_t)(k0 + kk) * N + (PERMQK == 1 ? win_col(n0 + (lane & 31)) : PERMQK == 2 ? wup_col(n0 + (lane & 31)) : n0 + (lane & 31))] * (gk ? gk[k0 + kk] : 1.f); }
    wsync();
    const int c = lane & 7;
#pragma unroll
    for (int j = 0; j < 4; ++j) { const int n = (lane >> 3) + 8 * j; const float* s = scr + (8 * c) * 33 + n;
        u32x4 o; o.x = pk2(s[0 * 33], s[1 * 33]); o.y = pk2(s[2 * 33], s[3 * 33]); o.z = pk2(s[4 * 33], s[5 * 33]); o.w = pk2(s[6 * 33], s[7 * 33]);
        *(u32x4*)(WT + (size_t)(n0 + n) * K + k0 + 8 * c) = o; }
    wsync();
}
__device__ __forceinline__ void row_to_bf16_rs(const float* xrow, bf16_t* orow, float* rs, int lane) {
    f32x4 v[4]; float s = 0.f;
#pragma unroll
    for (int j = 0; j < 4; ++j) { v[j] = *(const f32x4*)(xrow + 4 * lane + 256 * j); s += (v[j].x * v[j].x + v[j].y * v[j].y) + (v[j].z * v[j].z + v[j].w * v[j].w); }
    const float r = rsqrtf(wave_sum(s, lane) * (1.f / DM) + 1e-6f);
    if (lane == 0) *rs = r;
#pragma unroll
    for (int j = 0; j < 4; ++j) { u32x2 o; o.x = pk2(v[j].x, v[j].y); o.y = pk2(v[j].z, v[j].w); *(u32x2*)(orow + 4 * lane + 256 * j) = o; }
}
__device__ __forceinline__ void rms_row_to_bf16(const float* xrow, const float* gain, bf16_t* orow, int lane) {
    f32x4 v[4]; float s = 0.f;
#pragma unroll
    for (int j = 0; j < 4; ++j) { v[j] = *(const f32x4*)(xrow + 4 * lane + 256 * j); s += (v[j].x * v[j].x + v[j].y * v[j].y) + (v[j].z * v[j].z + v[j].w * v[j].w); }
    const float r = rsqrtf(wave_sum(s, lane) * (1.f / DM) + 1e-6f);
#pragma unroll
    for (int j = 0; j < 4; ++j) { const f32x4 g = *(const f32x4*)(gain + 4 * lane + 256 * j);
        u32x2 o; o.x = pk2(v[j].x * r * g.x, v[j].y * r * g.y); o.y = pk2(v[j].z * r * g.z, v[j].w * r * g.w);
        *(u32x2*)(orow + 4 * lane + 256 * j) = o; }
}
__device__ __forceinline__ void ph_prologue(const P& p, unsigned char* lds, int wv) {
    float* scr_all = (float*)lds;
    const int tid = otid(wv), lane = tid & 63, wave = tid >> 6;
    const int gw = blockIdx.x * 8 + wave, ngw = gridDim.x * 8;
    float* scr = scr_all + wave * 64 * 33;
    if (gw < NMETA) { const int m = gw; const float* src = p.in[1] + (size_t)m * DM;
        float* Hm = (float*)(p.ws + WS_META + M_H); bf16_t* Um = (bf16_t*)(p.ws + WS_META + M_U);
        f32x4 v[4]; float sq = 0.f;
#pragma unroll
        for (int j = 0; j < 4; ++j) v[j] = *(const f32x4*)(src + 4 * lane + 256 * j);
#pragma unroll
        for (int j = 0; j < 4; ++j) sq += (v[j].x * v[j].x + v[j].y * v[j].y) + (v[j].z * v[j].z + v[j].w * v[j].w);
        const float r = rsqrtf(wave_sum(sq, lane) * (1.f / DM) + 1e-6f);
        if (lane == 0) ((float*)(p.ws + WS_META + M_RS))[m] = r;
#pragma unroll
        for (int j = 0; j < 4; ++j) { *(f32x4*)(Hm + (size_t)m * DM + 4 * lane + 256 * j) = v[j];
            u32x2 o; o.x = pk2(v[j].x, v[j].y); o.y = pk2(v[j].z, v[j].w); *(u32x2*)(Um + (size_t)m * DM + 4 * lane + 256 * j) = o; }
    }
    constexpr int I_IN = 16 * 80, I_OUT = 16 * 32, I_UP = 16 * 192, I_DN = 48 * 32, I_L = I_IN + I_OUT + I_UP + I_DN;
    for (int it = gw; it < I_IN; it += ngw) transpose_item<1>(p.in[6], DM, INW, (bf16_t*)(p.ws + WS_W + OFF_WIN), scr, it, lane, p.in[2]);
    { bf16_t* WG = (bf16_t*)(p.ws + WS_WG);
      for (int i = blockIdx.x * NT + tid; i < DEPTH * 2 * 8 * 4096; i += gridDim.x * NT) {
          const int in_ = i & 63, out_ = (i >> 6) & 63, n = (i >> 12) & 7, g = (i >> 15) & 1, l = i >> 16;
          WG[i] = (bf16_t)f2bf(p.in[g ? 11 : 9][((size_t)(l * 8 + n) * 64 + in_) * 64 + out_]); } }
    float* rc = (float*)(p.ws + WS_ROPEC); float* rs = (float*)(p.ws + WS_ROPES);
    for (int i = blockIdx.x * NT + tid; i < TT * 32; i += gridDim.x * NT) {
        const int t = i >> 5, f = i & 31;
        const double inv = exp(-(double)f / 32.0 * log(10000.0));
        const double ang = (double)t * inv;
        rc[i] = (float)cos(ang); rs[i] = (float)sin(ang);
    }
    bf16_t* U = (bf16_t*)(p.ws + WS_U);
    float* RS = (float*)(p.ws + WS_RS);
    for (int m = gw; m < MR; m += 2 * ngw) {
        const float* x0 = p.in[0] + (size_t)m * DM; const float* x1 = p.in[0] + (size_t)(m + ngw) * DM;
        f32x4 v0[4], v1[4]; float s0 = 0.f, s1 = 0.f;
#pragma unroll
        for (int j = 0; j < 4; ++j) { v0[j] = *(const f32x4*)(x0 + 4 * lane + 256 * j); v1[j] = *(const f32x4*)(x1 + 4 * lane + 256 * j); }
#pragma unroll
        for (int j = 0; j < 4; ++j) { s0 += (v0[j].x * v0[j].x + v0[j].y * v0[j].y) + (v0[j].z * v0[j].z + v0[j].w * v0[j].w); s1 += (v1[j].x * v1[j].x + v1[j].y * v1[j].y) + (v1[j].z * v1[j].z + v1[j].w * v1[j].w); }
        const float r0 = rsqrtf(wave_sum(s0, lane) * (1.f / DM) + 1e-6f), r1 = rsqrtf(wave_sum(s1, lane) * (1.f / DM) + 1e-6f);
        if (lane == 0) { RS[m] = r0; RS[m + ngw] = r1; }
#pragma unroll
        for (int j = 0; j < 4; ++j) { u32x2 o; o.x = pk2(v0[j].x, v0[j].y); o.y = pk2(v0[j].z, v0[j].w); *(u32x2*)(U + (size_t)m * DM + 4 * lane + 256 * j) = o;
            u32x2 q; q.x = pk2(v1[j].x, v1[j].y); q.y = pk2(v1[j].z, v1[j].w); *(u32x2*)(U + (size_t)(m + ngw) * DM + 4 * lane + 256 * j) = q; }
    }
}

constexpr int FILL_PER_BAR = 256 * 7, FILL_ITEMS = 2 * (16 * 32 + 16 * 192 + 48 * 32) + 16 * 80;
__device__ __forceinline__ void fill_item(const P& p, unsigned char* lds, int k, int wv) {
    int it = k * FILL_PER_BAR + (int)blockIdx.x * 7 + (wv - 1);
    if (k < 0 || it >= FILL_ITEMS) return;
    const int lane = otid(wv) & 63;
    float* scr = (float*)lds + wv * 64 * 33;
    constexpr int I_IN = 16 * 80, I_OUT = 16 * 32, I_UP = 16 * 192, I_DN = 48 * 32;
    int l = 0;
    if (it >= I_OUT + I_UP + I_DN) { it -= I_OUT + I_UP + I_DN; l = 1;
        if (it < I_IN) { transpose_item<1, true>(p.in[6] + (size_t)DM * INW, DM, INW, (bf16_t*)(p.ws + WS_W + W_LAYER + OFF_WIN), scr, it, lane, p.in[2] + DM); return; }
        it -= I_IN; }
    unsigned char* wb = p.ws + WS_W + l * W_LAYER;
    if (it < I_OUT) { transpose_item<0, true>(p.in[20] + (size_t)l * DM * DM, DM, DM, (bf16_t*)(wb + OFF_WOUT), scr, it, lane); return; } it -= I_OUT;
    if (it < I_UP) { transpose_item<2, true>(p.in[21] + (size_t)l * DM * 2 * DFF, DM, 2 * DFF, (bf16_t*)(wb + OFF_WUP), scr, it, lane, p.in[4] + l * DM); return; } it -= I_UP;
    transpose_item<0, true>(p.in[24] + (size_t)l * DFF * DM, DFF, DM, (bf16_t*)(wb + OFF_WDN), scr, it, lane);
}

template <int MT, int NTL, class Epi>
__device__ __forceinline__ void gemm_naive(const bf16_t* A, const bf16_t* Bt, int M, int N, int K, const Epi& epi, int gw, int ngw, int lane) {
    const int fr = lane & 15, fq = lane >> 4;
    const int tilesM = M / (16 * MT), tilesN = N / (16 * NTL);
    for (int tile = gw; tile < tilesM * tilesN; tile += ngw) {
        const int tm = tile / tilesN, tn = tile % tilesN;
        f32x4 acc[MT][NTL];
#pragma unroll
        for (int m = 0; m < MT; ++m)
#pragma unroll
            for (int n = 0; n < NTL; ++n) acc[m][n] = (f32x4){0.f, 0.f, 0.f, 0.f};
        const bf16_t* Ap = A + (size_t)(tm * 16 * MT + fr) * K + fq * 8;
        const bf16_t* Bp = Bt + (size_t)(tn * 16 * NTL + fr) * K + fq * 8;
#pragma unroll 8
        for (int k = 0; k < K; k += 32) {
            bf16x8 a[MT], b[NTL];
#pragma unroll
            for (int m = 0; m < MT; ++m) a[m] = *(const bf16x8*)(Ap + (size_t)m * 16 * K + k);
#pragma unroll
            for (int n = 0; n < NTL; ++n) b[n] = *(const bf16x8*)(Bp + (size_t)n * 16 * K + k);
#pragma unroll
            for (int m = 0; m < MT; ++m)
#pragma unroll
                for (int n = 0; n < NTL; ++n) acc[m][n] = __builtin_amdgcn_mfma_f32_16x16x32_bf16(b[n], a[m], acc[m][n], 0, 0, 0);
        }
        epi.template run<MT, NTL>(acc, tm * 16 * MT, tn * 16 * NTL, fr, fq);
    }
}
struct EpiF32 {
    float* C; int ldc, pad;
    template <int MT, int NTL> __device__ __forceinline__ void run(const f32x4 (&acc)[MT][NTL], int row0, int col0, int fr, int fq) const {
#pragma unroll
        for (int m = 0; m < MT; ++m)
#pragma unroll
            for (int n = 0; n < NTL; ++n) *(f32x4*)(C + (size_t)(row0 + 16 * m + fr) * ldc + col0 + 16 * n + 4 * fq) = acc[m][n];
    }
};
struct EpiBf16 {
    bf16_t* C; int ldc, pad;
    template <int MT, int NTL> __device__ __forceinline__ void run(const f32x4 (&acc)[MT][NTL], int row0, int col0, int fr, int fq) const {
#pragma unroll
        for (int m = 0; m < MT; ++m)
#pragma unroll
            for (int n = 0; n < NTL; ++n) { u32x2 o; o.x = pk2(acc[m][n][0], acc[m][n][1]); o.y = pk2(acc[m][n][2], acc[m][n][3]);
                *(u32x2*)(C + (size_t)(row0 + 16 * m + fr) * ldc + col0 + 16 * n + 4 * fq) = o; }
    }
};
struct EpiWin {
    bf16_t* Z; const float* rc; const float* rs; const float* RSr; int meta, pad;
    template <int MT, int NTL> __device__ __forceinline__ void run(const f32x4 (&acc)[MT][NTL], int row0, int col0, int fr, int fq) const {
        static_assert(NTL == 2, "EpiWin: 32-slot tiles");
        int c0_ = col0; asm volatile("" : "+s"(c0_));
        const bool qk = col0 >= 1024 && col0 < 2048; const float sc = (c0_ < 1536) ? QSCALE : 1.f;
        const int fo = 16 * ((col0 >> 5) & 1) + 4 * fq;
#pragma unroll
        for (int m = 0; m < MT; ++m) {
            const int row = row0 + 16 * m + fr; const int t = meta ? row : 16 + (row & (SEQ - 1));
            const float rsr = RSr[row]; f32x4 v0 = acc[m][0] * rsr, v1 = acc[m][1] * rsr;
            if (qk) { const f32x4 c = *(const f32x4*)(rc + t * 32 + fo), s = *(const f32x4*)(rs + t * 32 + fo);
                const f32x4 x1 = v0, x2 = v1; v0 = (x1 * c - x2 * s) * sc; v1 = (x2 * c + x1 * s) * sc; }
            u32x4 o; o.x = pk2(v0[0], v0[1]); o.y = pk2(v0[2], v0[3]); o.z = pk2(v1[0], v1[1]); o.w = pk2(v1[2], v1[3]);
            *(u32x4*)(Z + (size_t)row * INW + col0 + 8 * fq) = o;
        }
    }
};
template <int MT, int NTL, class Epi>
__device__ __forceinline__ void ph_gemm(const bf16_t* A, const bf16_t* Bt, int M, int N, int K, Epi epi, int wv) {
    const int tid = otid(wv), lane = tid & 63, wave = tid >> 6;
    gemm_naive<MT, NTL, Epi>(A, Bt, M, N, K, epi, blockIdx.x * 8 + wave, gridDim.x * 8, lane);
}

__device__ __forceinline__ void ph_lru(const P& p, int l, unsigned char* lds, int wv) {
    if (blockIdx.x >= 8) return;
    const int lane = otid(wv) & 63, w = wv, n = blockIdx.x, ch = n * 64 + lane, t0 = 2 * w;
    float* xsT = (float*)lds;
    float* PG = (float*)lds + 1024;
    float* AB = (float*)lds + 1024 + 16384;
    float* HS = AB + 2048;
    const bf16_t* ZBm = (const bf16_t*)(p.ws + WS_META + M_ZB);
    float* T1m = (float*)(p.ws + WS_META + M_T1);
    const float cw0 = p.in[7][(l * 4 + 0) * LRUW + ch], cw1 = p.in[7][(l * 4 + 1) * LRUW + ch], cw2 = p.in[7][(l * 4 + 2) * LRUW + ch], cw3 = p.in[7][(l * 4 + 3) * LRUW + ch];
    const float cb = p.in[8][l * LRUW + ch];
    float xr[5];
#pragma unroll
    for (int k = 0; k < 5; ++k) { const int row = t0 - 3 + k; const float xv = bf2f(ZBm[(size_t)(row >= 0 ? row : 0) * INW + ch]); xr[k] = row >= 0 ? xv : 0.f; }
    const float g0 = bf2f(ZBm[(size_t)t0 * INW + LRUW + ch]), g1 = bf2f(ZBm[(size_t)(t0 + 1) * INW + LRUW + ch]);
    const float* wa = p.in[9] + (size_t)(l * 8 + n) * 4096 + lane; const float* wx = p.in[11] + (size_t)(l * 8 + n) * 4096 + lane;
    float wav[8], wxv[8];
#pragma unroll
    for (int ii = 0; ii < 8; ++ii) { wav[ii] = wa[(8 * w + ii) * 64]; wxv[ii] = wx[(8 * w + ii) * 64]; }
    const float ba = p.in[10][(l * 8 + n) * 64 + lane], bx = p.in[12][(l * 8 + n) * 64 + lane];
    constexpr float L2E_ = 1.4426950408889634f;
    const float la8 = -8.f * log1pf(expf(-p.in[13][l * LRUW + ch])) * L2E_;
    const float xc0 = cb + cw0 * xr[0] + cw1 * xr[1] + cw2 * xr[2] + cw3 * xr[3], xc1 = cb + cw0 * xr[1] + cw1 * xr[2] + cw2 * xr[3] + cw3 * xr[4];
    xsT[lane * 16 + t0] = xc0; xsT[lane * 16 + t0 + 1] = xc1;
    __syncthreads();
    float rp[16], ip[16];
#pragma unroll
    for (int t = 0; t < 16; ++t) { rp[t] = 0.f; ip[t] = 0.f; }
#pragma unroll
    for (int ii = 0; ii < 8; ++ii) {
#pragma unroll
        for (int q = 0; q < 4; ++q) { const f32x4 xv = *(const f32x4*)(xsT + (8 * w + ii) * 16 + 4 * q);
            rp[4 * q] += xv.x * wav[ii]; rp[4 * q + 1] += xv.y * wav[ii]; rp[4 * q + 2] += xv.z * wav[ii]; rp[4 * q + 3] += xv.w * wav[ii];
            ip[4 * q] += xv.x * wxv[ii]; ip[4 * q + 1] += xv.y * wxv[ii]; ip[4 * q + 2] += xv.z * wxv[ii]; ip[4 * q + 3] += xv.w * wxv[ii]; } }
#pragma unroll
    for (int t = 0; t < 16; ++t) { PG[((w * 2 + 0) * 16 + t) * 64 + lane] = rp[t]; PG[((w * 2 + 1) * 16 + t) * 64 + lane] = ip[t]; }
    __syncthreads();
    float r0 = ba, r1 = ba, i0 = bx, i1 = bx;
#pragma unroll
    for (int k = 0; k < 8; ++k) { r0 += PG[((k * 2 + 0) * 16 + t0) * 64 + lane]; r1 += PG[((k * 2 + 0) * 16 + t0 + 1) * 64 + lane]; i0 += PG[((k * 2 + 1) * 16 + t0) * 64 + lane]; i1 += PG[((k * 2 + 1) * 16 + t0 + 1) * 64 + lane]; }
    { const float r = __builtin_amdgcn_rcpf(1.f + __builtin_amdgcn_exp2f(-L2E_ * r0)), ig = __builtin_amdgcn_rcpf(1.f + __builtin_amdgcn_exp2f(-L2E_ * i0));
      const float a = __builtin_amdgcn_exp2f(la8 * r), mult = __builtin_amdgcn_sqrtf(fmaxf(1.f - a * a, 0.f));
      AB[t0 * 64 + lane] = a; AB[1024 + t0 * 64 + lane] = mult * (ig * xc0); }
    { const float r = __builtin_amdgcn_rcpf(1.f + __builtin_amdgcn_exp2f(-L2E_ * r1)), ig = __builtin_amdgcn_rcpf(1.f + __builtin_amdgcn_exp2f(-L2E_ * i1));
      const float a = __builtin_amdgcn_exp2f(la8 * r), mult = __builtin_amdgcn_sqrtf(fmaxf(1.f - a * a, 0.f));
      AB[(t0 + 1) * 64 + lane] = a; AB[1024 + (t0 + 1) * 64 + lane] = mult * (ig * xc1); }
    __syncthreads();
    if (w == 0) { float h = 0.f;
#pragma unroll
        for (int t = 0; t < 16; ++t) { h = AB[t * 64 + lane] * h + AB[1024 + t * 64 + lane]; HS[t * 64 + lane] = h; }
        ((float*)(p.ws + WS_META + M_HME))[ch] = h; }
    __syncthreads();
    T1m[t0 * LRUW + ch] = HS[t0 * 64 + lane] * g0 * __builtin_amdgcn_rcpf(1.f + __builtin_amdgcn_exp2f(-2.302208198f * (g0 + 0.044715f * g0 * g0 * g0)));
    T1m[(t0 + 1) * LRUW + ch] = HS[(t0 + 1) * 64 + lane] * g1 * __builtin_amdgcn_rcpf(1.f + __builtin_amdgcn_exp2f(-2.302208198f * (g1 + 0.044715f * g1 * g1 * g1)));
}
__device__ __forceinline__ void ph_lrunorm(const P& p, int l, int wv) {
    if (blockIdx.x < 8 || blockIdx.x >= 10) return;
    const int tid = otid(wv), lane = tid & 63, wave = tid >> 6, gw = ((int)blockIdx.x - 8) * 8 + wave, ngw = gridDim.x * 8;
    const float* g = p.in[14] + l * LRUW;
    for (int m = MR + gw; m < MR + NMETA; m += ngw) {
        const float* src = m < MR ? (const float*)(p.ws + WS_T1) + (size_t)m * LRUW : (const float*)(p.ws + WS_META + M_T1) + (size_t)(m - MR) * LRUW;
        bf16_t* dst = m < MR ? (bf16_t*)(p.ws + WS_YC) + (size_t)m * DM : (bf16_t*)(p.ws + WS_META + M_YC) + (size_t)(m - MR) * DM;
        f32x4 v[2]; float s = 0.f;
#pragma unroll
        for (int j = 0; j < 2; ++j) { v[j] = *(const f32x4*)(src + 4 * lane + 256 * j); s += (v[j].x * v[j].x + v[j].y * v[j].y) + (v[j].z * v[j].z + v[j].w * v[j].w); }
        const float r = rsqrtf(wave_sum(s, lane) * (1.f / LRUW) + 1e-6f);
#pragma unroll
        for (int j = 0; j < 2; ++j) { const f32x4 gg = *(const f32x4*)(g + 4 * lane + 256 * j);
            u32x2 o; o.x = pk2(v[j].x * r * gg.x, v[j].y * r * gg.y); o.y = pk2(v[j].z * r * gg.z, v[j].w * r * gg.w);
            *(u32x2*)(dst + 4 * lane + 256 * j) = o; }
    }
}

__device__ __forceinline__ void score2(const bf16_t* krow, const float* sm, float& s1, float& s2) {
    float a = 0.f, b = 0.f;
#pragma unroll
    for (int d = 0; d < 64; d += 8) {
        const bf16x8 k1 = *(const bf16x8*)(krow + d), k2 = *(const bf16x8*)(krow + 64 + d);
        const f32x4 qa = *(const f32x4*)(sm + d), qb = *(const f32x4*)(sm + d + 4), qc = *(const f32x4*)(sm + 64 + d), qd = *(const f32x4*)(sm + 64 + d + 4);
        a += qa.x * bf2f((bf16_t)k1[0]) + qa.y * bf2f((bf16_t)k1[1]) + qa.z * bf2f((bf16_t)k1[2]) + qa.w * bf2f((bf16_t)k1[3])
           + qb.x * bf2f((bf16_t)k1[4]) + qb.y * bf2f((bf16_t)k1[5]) + qb.z * bf2f((bf16_t)k1[6]) + qb.w * bf2f((bf16_t)k1[7]);
        b += qc.x * bf2f((bf16_t)k2[0]) + qc.y * bf2f((bf16_t)k2[1]) + qc.z * bf2f((bf16_t)k2[2]) + qc.w * bf2f((bf16_t)k2[3])
           + qd.x * bf2f((bf16_t)k2[4]) + qd.y * bf2f((bf16_t)k2[5]) + qd.z * bf2f((bf16_t)k2[6]) + qd.w * bf2f((bf16_t)k2[7]);
    }
    s1 = a; s2 = b;
}
__device__ __forceinline__ void ph_attn(const P& p, int l, unsigned char* lds, bool meta_only, int wv) {
    float* sm_all = (float*)(lds + 4096);
    const int tid = otid(wv), lane = tid & 63, wave = tid >> 6, gw = blockIdx.x * 8 + wave, ngw = gridDim.x * 8;
    float* sm = sm_all + wave * 192;
    const bf16_t* ZB = (const bf16_t*)(p.ws + WS_ZB); const bf16_t* ZBm = (const bf16_t*)(p.ws + WS_META + M_ZB);
    bf16_t* YC = (bf16_t*)(p.ws + WS_YC); bf16_t* YCm = (bf16_t*)(p.ws + WS_META + M_YC);
    const float li = lambda_init_of(l);
    const float lam = expf(wave_sum(p.in[15][l * 64 + lane] * p.in[16][l * 64 + lane], lane)) - expf(wave_sum(p.in[17][l * 64 + lane] * p.in[18][l * 64 + lane], lane)) + li;
    const float g0 = p.in[19][l * 128 + lane] * (1.f - li), g1 = p.in[19][l * 128 + 64 + lane] * (1.f - li);
    constexpr int NQR = NBATCH * NH * SEQ, NQ = NQR + NH * NMETA;
    for (int qi = (meta_only ? NQR : 0) + gw; qi < NQ; qi += ngw) {
        int b, h, t;
        if (qi < NQR) { b = qi / (NH * SEQ); h = (qi / SEQ) % NH; t = NMETA + qi % SEQ; } else { const int m = qi - NQR; b = 0; h = m / NMETA; t = m % NMETA; }
        const bf16_t* qrow = (t < NMETA ? ZBm + (size_t)t * INW : ZB + ((size_t)b * SEQ + (t - NMETA)) * INW) + 1024 + h * 128;
        sm[lane] = bf2f(qrow[lane]); sm[64 + lane] = bf2f(qrow[64 + lane]);
        wsync();
        const int nch = t < NMETA ? 0 : (t - NMETA) / 64 + 1;
        const bf16_t* kmeta = ZBm + 1536 + h * 128; const bf16_t* kreal = ZB + (size_t)b * SEQ * INW + 1536 + h * 128;
        float m1 = -1e30f, l1 = 0.f, m2 = -1e30f, l2 = 0.f;
        for (int c = -1; c < nch; ++c) {
            const bool valid = c >= 0 || lane < NMETA;
            if (valid) {
                const bf16_t* krow = c < 0 ? kmeta + (size_t)lane * INW : kreal + (size_t)(c * 64 + lane) * INW;
                float s1, s2; score2(krow, sm, s1, s2);
                float mn = fmaxf(m1, s1); l1 = l1 * exp2f(m1 - mn) + exp2f(s1 - mn); m1 = mn;
                mn = fmaxf(m2, s2); l2 = l2 * exp2f(m2 - mn) + exp2f(s2 - mn); m2 = mn;
            }
        }
        const float M1 = wave_max(m1, lane), M2 = wave_max(m2, lane);
        const float L1 = wave_sum(l1 * exp2f(m1 - M1), lane), L2 = wave_sum(l2 * exp2f(m2 - M2), lane);
        const float i1 = 1.f / L1, i2 = lam / L2;
        float acc0 = 0.f, acc1 = 0.f;
        for (int c = -1; c < nch; ++c) {
            const bool valid = c >= 0 || lane < NMETA;
            float w = 0.f;
            if (valid) {
                const bf16_t* krow = c < 0 ? kmeta + (size_t)lane * INW : kreal + (size_t)(c * 64 + lane) * INW;
                float s1, s2; score2(krow, sm, s1, s2);
                w = exp2f(s1 - M1) * i1 - exp2f(s2 - M2) * i2;
            }
            sm[128 + lane] = w; wsync();
            const int nk = c < 0 ? NMETA : 64;
            const bf16_t* vbase = (c < 0 ? kmeta : kreal + (size_t)(c * 64) * INW) + 512;
            for (int j = 0; j < nk; ++j) { const float wj = sm[128 + j]; const bf16_t* vr = vbase + (size_t)j * INW;
                acc0 += wj * bf2f(vr[lane]); acc1 += wj * bf2f(vr[64 + lane]); }
            wsync();
        }
        const float ss = wave_sum(acc0 * acc0 + acc1 * acc1, lane);
        const float r = rsqrtf(ss * (1.f / 128.f) + 1e-5f);
        bf16_t* orow = (t < NMETA ? YCm + (size_t)t * DM : YC + ((size_t)b * SEQ + (t - NMETA)) * DM) + 512 + h * 128;
        orow[lane] = (bf16_t)f2bf(acc0 * r * g0); orow[64 + lane] = (bf16_t)f2bf(acc1 * r * g1);
        wsync();
    }
}


__device__ __forceinline__ void ph_attn_meta(const P& p, int l, unsigned char* lds, int wv) {
    if (blockIdx.x >= 8) return;
    __syncthreads();
    const int lane = otid(wv) & 63, m = blockIdx.x * 8 + wv, h = m / NMETA, t = m % NMETA;
    float* sm = (float*)(lds + 4096) + wv * 192;
    unsigned char* wsl = p.ws; asm volatile("" : "+s"(wsl));
    const bf16_t* ZBm = (const bf16_t*)(wsl + WS_META + M_ZB); bf16_t* YCm = (bf16_t*)(wsl + WS_META + M_YC);
    const bf16_t* qrow = ZBm + (size_t)t * INW + 1024 + h * 128; const bf16_t* kmeta = ZBm + 1536 + h * 128;
    float v0[NMETA], v1[NMETA];
#pragma unroll
    for (int j = 0; j < NMETA; ++j) { v0[j] = bf2f(kmeta[(size_t)j * INW + 512 + lane]); v1[j] = bf2f(kmeta[(size_t)j * INW + 512 + 64 + lane]); }
    sm[lane] = bf2f(qrow[lane]); sm[64 + lane] = bf2f(qrow[64 + lane]);
    const float li = lambda_init_of(l);
    const float lam = expf(wave_sum(p.in[15][l * 64 + lane] * p.in[16][l * 64 + lane], lane)) - expf(wave_sum(p.in[17][l * 64 + lane] * p.in[18][l * 64 + lane], lane)) + li;
    const float g0 = p.in[19][l * 128 + lane] * (1.f - li), g1 = p.in[19][l * 128 + 64 + lane] * (1.f - li);
    wsync();
    float s1 = -1e30f, s2 = -1e30f;
    if (lane < NMETA) score2(kmeta + (size_t)lane * INW, sm, s1, s2);
    const float M1 = wave_max(s1, lane), M2 = wave_max(s2, lane);
    const float e1 = lane < NMETA ? exp2f(s1 - M1) : 0.f, e2 = lane < NMETA ? exp2f(s2 - M2) : 0.f;
    const float L1 = wave_sum(e1, lane), L2 = wave_sum(e2, lane);
    const float w = e1 * (1.f / L1) - e2 * (lam / L2);
    float acc0 = 0.f, acc1 = 0.f;
#pragma unroll
    for (int j = 0; j < NMETA; ++j) { const float wj = __int_as_float(__builtin_amdgcn_readlane(__float_as_int(w), j)); acc0 += wj * v0[j]; acc1 += wj * v1[j]; }
    const float ss = wave_sum(acc0 * acc0 + acc1 * acc1, lane);
    const float r = rsqrtf(ss * (1.f / 128.f) + 1e-5f);
    bf16_t* orow = YCm + (size_t)t * DM + 512 + h * 128;
    orow[lane] = (bf16_t)f2bf(acc0 * r * g0); orow[64 + lane] = (bf16_t)f2bf(acc1 * r * g1);
}


namespace att {
typedef float f32x16 __attribute__((ext_vector_type(16)));
typedef short s16x4 __attribute__((ext_vector_type(4)));
#define ATT_LAS __attribute__((address_space(3)))
constexpr float THR = 5.f;
__device__ __forceinline__ s16x4 vtr(const ATT_LAS unsigned char* p) { return __builtin_bit_cast(s16x4, __builtin_amdgcn_ds_read_tr16_b64_v4i16((ATT_LAS s16x4*)p)); }
__device__ __forceinline__ unsigned cvtpk(float lo, float hi) { typedef float f2 __attribute__((ext_vector_type(2))); typedef __bf16 b2 __attribute__((ext_vector_type(2))); f2 v = {lo, hi}; b2 b = __builtin_convertvector(v, b2); return __builtin_bit_cast(unsigned, b); }

template <bool META>
__device__ __forceinline__ void tile(const ATT_LAS unsigned char* Kb, const ATT_LAS unsigned char* Vb, const bf16x8 (&qf)[4], f32x16 (&o)[4], float& m, float& lsum, float (&prs)[16], int map, int lane) {
    const int r = lane & 31, hh = lane >> 5;
    f32x16 S0, S1;
#pragma unroll
    for (int i = 0; i < 16; ++i) { S0[i] = META ? 0.f : -m; S1[i] = META ? 0.f : -m; }
    {
        bf16x8 ka[4], kb[4];
#pragma unroll
        for (int s4 = 0; s4 < 4; ++s4) { const int chunk = map * 8 + 2 * s4 + hh;
            ka[s4] = *(const ATT_LAS bf16x8*)(Kb + r * 256 + ((chunk ^ (r & 15)) << 4));
            if (!META) kb[s4] = *(const ATT_LAS bf16x8*)(Kb + (32 + r) * 256 + ((chunk ^ (r & 15)) << 4)); }
        if (!META) {
            const float a0 = (prs[0] + prs[1]) + (prs[2] + prs[3]), a1 = (prs[4] + prs[5]) + (prs[6] + prs[7]), a2 = (prs[8] + prs[9]) + (prs[10] + prs[11]), a3 = (prs[12] + prs[13]) + (prs[14] + prs[15]);
            lsum += (a0 + a1) + (a2 + a3); }
#pragma unroll
        for (int s4 = 0; s4 < 4; ++s4) { S0 = __builtin_amdgcn_mfma_f32_32x32x16_bf16(ka[s4], qf[s4], S0, 0, 0, 0);
            if (!META) S1 = __builtin_amdgcn_mfma_f32_32x32x16_bf16(kb[s4], qf[s4], S1, 0, 0, 0); }
    }
    float mt = -1e30f;
    if (META) {
#pragma unroll
        for (int i = 0; i < 8; ++i) mt = fmaxf(mt, S0[i]);
    } else {
        {
            float q0 = fmaxf(fmaxf(S0[0], S0[1]), S1[0]), q1 = fmaxf(fmaxf(S0[2], S0[3]), S1[1]), q2 = fmaxf(fmaxf(S0[4], S0[5]), S1[2]), q3 = fmaxf(fmaxf(S0[6], S0[7]), S1[3]);
            q0 = fmaxf(fmaxf(q0, S0[8]), S0[9]); q1 = fmaxf(fmaxf(q1, S0[10]), S0[11]); q2 = fmaxf(fmaxf(q2, S0[12]), S0[13]); q3 = fmaxf(fmaxf(q3, S0[14]), S0[15]);
            q0 = fmaxf(fmaxf(q0, S1[4]), S1[5]); q1 = fmaxf(fmaxf(q1, S1[6]), S1[7]); q2 = fmaxf(fmaxf(q2, S1[8]), S1[9]); q3 = fmaxf(fmaxf(q3, S1[10]), S1[11]);
            q0 = fmaxf(fmaxf(q0, S1[12]), S1[13]); q1 = fmaxf(fmaxf(q1, S1[14]), S1[15]);
            mt = fmaxf(fmaxf(q0, q1), fmaxf(q2, q3)); }
    }
    { auto rr = __builtin_amdgcn_permlane32_swap(__float_as_uint(mt), __float_as_uint(mt), false, false); mt = fmaxf(__uint_as_float(rr[0]), __uint_as_float(rr[1])); }
    if (META) {
        if (__any(mt > m + THR)) {
            const float mn = fmaxf(m, mt), alpha = __builtin_amdgcn_exp2f(m - mn);
            lsum *= alpha; m = mn;
#pragma unroll
            for (int e = 0; e < 4; ++e) o[e] = o[e] * alpha;
        }
#pragma unroll
        for (int i = 0; i < 8; ++i) S0[i] -= m;
    } else if (__any(mt > THR)) {
        const float d = fmaxf(mt, 0.f), alpha = __builtin_amdgcn_exp2f(-d);
        lsum *= alpha; m += d;
#pragma unroll
        for (int e = 0; e < 4; ++e) o[e] = o[e] * alpha;
#pragma unroll
        for (int i = 0; i < 16; ++i) { S0[i] -= d; S1[i] -= d; }
    }
    unsigned pw[4][4];
#pragma unroll
    for (int i = 0; i < 16; i += 2) {
        if (META && i >= 8) { prs[i >> 1] = 0.f; continue; }
        const float p0 = __builtin_amdgcn_exp2f(S0[i]), p1 = __builtin_amdgcn_exp2f(S0[i + 1]); prs[i >> 1] = p0 + p1; pw[i >> 3][(i >> 1) & 3] = cvtpk(p0, p1); }
#pragma unroll
    for (int i = 0; i < 16; i += 2) {
        if (META) { prs[8 + (i >> 1)] = 0.f; continue; }
        const float p0 = __builtin_amdgcn_exp2f(S1[i]), p1 = __builtin_amdgcn_exp2f(S1[i + 1]); prs[8 + (i >> 1)] = p0 + p1; pw[2 + (i >> 3)][(i >> 1) & 3] = cvtpk(p0, p1); }
    const int g = (lane >> 4) & 1, q = (lane & 15) >> 2, pp = lane & 3;
    const ATT_LAS unsigned char* vbase = Vb + (4 * hh + q) * 256 + (pp & 1) * 8;
    int cho[4];
#pragma unroll
    for (int eb = 0; eb < 4; ++eb) cho[eb] = ((4 * eb + 2 * g + (pp >> 1)) ^ (q << 2)) << 4;
    constexpr int NKS = META ? 1 : 4;
    s16x4 lo[2][4], hi[2][4];
#pragma unroll
    for (int eb = 0; eb < 4; ++eb) { lo[0][eb] = vtr(vbase + cho[eb]); hi[0][eb] = vtr(vbase + cho[eb] + 8 * 256); }
#pragma unroll
    for (int ks = 0; ks < NKS; ++ks) {
        if (ks + 1 < NKS) {
#pragma unroll
            for (int eb = 0; eb < 4; ++eb) { lo[(ks + 1) & 1][eb] = vtr(vbase + (ks + 1) * 16 * 256 + cho[eb]); hi[(ks + 1) & 1][eb] = vtr(vbase + (ks + 1) * 16 * 256 + cho[eb] + 8 * 256); }
        }
        const u32x4 pu = {pw[ks][0], pw[ks][1], pw[ks][2], pw[ks][3]};
        const bf16x8 pf = __builtin_bit_cast(bf16x8, pu);
#pragma unroll
        for (int eb = 0; eb < 4; ++eb) { const s16x4 a = lo[ks & 1][eb], c = hi[ks & 1][eb];
            const bf16x8 vf = {a[0], a[1], a[2], a[3], c[0], c[1], c[2], c[3]};
            o[eb] = __builtin_amdgcn_mfma_f32_32x32x16_bf16(vf, pf, o[eb], 0, 0, 0); }
    }
}

__device__ __forceinline__ void unit(const P& p, int l, unsigned char* lds_, int b, int h, int qb, float lam, float li, int wv) {
    const ATT_LAS unsigned char* lds = (const ATT_LAS unsigned char*)lds_;
    ATT_LAS unsigned char* ldsw = (ATT_LAS unsigned char*)lds_;
    const int tid = otid(wv), lane = tid & 63, wid = __builtin_amdgcn_readfirstlane(tid >> 6), r = lane & 31, hh = lane >> 5;
    const int map = wid >> 2, qs = wid & 3;
    const bf16_t* ZB = (const bf16_t*)(p.ws + WS_ZB); const bf16_t* ZBm = (const bf16_t*)(p.ws + WS_META + M_ZB);
    const size_t rowbase = (size_t)b * SEQ;
    const int q0 = qb * 128 + qs * 32;
    const int nt_unit = 2 * qb + 2, nt_wave = 2 * qb + 1 + (qs >> 1);
    bf16x8 qf[4];
    { const bf16_t* qp = ZB + (rowbase + q0 + r) * INW + 1024 + h * 128 + map * 64 + hh * 8;
#pragma unroll
      for (int s4 = 0; s4 < 4; ++s4) qf[s4] = *(const bf16x8*)(qp + 16 * s4); }
    f32x16 o[4] = {}; float m = -1e30f, lsum = 0.f;
    float prs[16];
#pragma unroll
    for (int i = 0; i < 16; ++i) prs[i] = 0.f;
#define ATT_DMA(tt, img) do { _Pragma("unroll") for (int j_ = 0; j_ < 2; ++j_) { const int q_ = 2 * wid + j_, row_ = 4 * q_ + (lane >> 4), slot_ = lane & 15; \
        const bf16_t* rp_ = (tt) == 0 ? ZBm + (size_t)(row_ & 15) * INW : ZB + (rowbase + 64 * ((tt) - 1) + row_) * INW; \
        __builtin_amdgcn_global_load_lds((const unsigned*)(rp_ + 1536 + h * 128 + (slot_ ^ (row_ & 15)) * 8), (ATT_LAS unsigned*)(ldsw + (img) * 32768 + q_ * 1024), 16, 0, 0); \
        __builtin_amdgcn_global_load_lds((const unsigned*)(rp_ + 2048 + h * 128 + (slot_ ^ ((row_ & 3) << 2)) * 8), (ATT_LAS unsigned*)(ldsw + (img) * 32768 + 16384 + q_ * 1024), 16, 0, 0); } } while (0)
    ATT_DMA(0, 0);
    asm volatile("s_waitcnt vmcnt(0)" ::: "memory");
    __syncthreads();
    for (int tt = 0; tt <= nt_unit; ++tt) {
        const int buf = tt & 1;
        if (tt < nt_unit) ATT_DMA(tt + 1, buf ^ 1);
        if (tt <= nt_wave) {
            if (tt == 0) tile<true>(lds + buf * 32768, lds + buf * 32768 + 16384, qf, o, m, lsum, prs, map, lane);
            else tile<false>(lds + buf * 32768, lds + buf * 32768 + 16384, qf, o, m, lsum, prs, map, lane);
        }
        asm volatile("s_waitcnt vmcnt(0)" ::: "memory");
        __syncthreads();
    }
#undef ATT_DMA
    lsum += ((prs[0] + prs[1]) + (prs[2] + prs[3])) + ((prs[4] + prs[5]) + (prs[6] + prs[7])) + (((prs[8] + prs[9]) + (prs[10] + prs[11])) + ((prs[12] + prs[13]) + (prs[14] + prs[15])));
    { auto rr = __builtin_amdgcn_permlane32_swap(__float_as_uint(lsum), __float_as_uint(lsum), false, false); lsum = __uint_as_float(rr[0]) + __uint_as_float(rr[1]); }
    const float inv = 1.f / lsum;
    ATT_LAS float* X = (ATT_LAS float*)ldsw;
    if (map == 1) {
        const float f = inv * lam;
#pragma unroll
        for (int eb = 0; eb < 4; ++eb)
#pragma unroll
            for (int i = 0; i < 16; ++i) X[(eb * 16 + i) * 256 + qs * 64 + lane] = o[eb][i] * f;
    }
    __syncthreads();
    if (map == 0) {
        float ss = 0.f;
#pragma unroll
        for (int eb = 0; eb < 4; ++eb)
#pragma unroll
            for (int i = 0; i < 16; ++i) { const float v = o[eb][i] * inv - X[(eb * 16 + i) * 256 + qs * 64 + lane]; o[eb][i] = v; ss += v * v; }
        { auto rr = __builtin_amdgcn_permlane32_swap(__float_as_uint(ss), __float_as_uint(ss), false, false); ss = __uint_as_float(rr[0]) + __uint_as_float(rr[1]); }
        const float rs = rsqrtf(ss * (1.f / 128.f) + 1e-5f) * (1.f - li);
        const float* gsub = p.in[19] + l * 128;
        bf16_t* orow = (bf16_t*)(p.ws + WS_YC) + (rowbase + q0 + r) * DM + 512 + h * 128;
#pragma unroll
        for (int eb = 0; eb < 4; ++eb)
#pragma unroll
            for (int i4 = 0; i4 < 4; ++i4) { const int e0 = 32 * eb + 8 * i4 + 4 * hh; const f32x4 g = *(const f32x4*)(gsub + e0);
                u32x2 w; w.x = cvtpk(o[eb][4 * i4] * rs * g.x, o[eb][4 * i4 + 1] * rs * g.y); w.y = cvtpk(o[eb][4 * i4 + 2] * rs * g.z, o[eb][4 * i4 + 3] * rs * g.w);
                *(u32x2*)(orow + e0) = w; }
    }
    __syncthreads();
}

__device__ __forceinline__ void phase(const P& p, int l, unsigned char* lds, int wv) {
    const int lane = otid(wv) & 63;
    const float li = lambda_init_of(l);
    const float lam = expf(wave_sum(p.in[15][l * 64 + lane] * p.in[16][l * 64 + lane], lane)) - expf(wave_sum(p.in[17][l * 64 + lane] * p.in[18][l * 64 + lane], lane)) + li;
    const int G = gridDim.x, bx = blockIdx.x;
    const int vcu = (G % 8 == 0) ? (bx % 8) * (G / 8) + bx / 8 : bx;
    if (G == 256) {
        const int x = vcu >> 5, c = vcu & 31;
#pragma unroll 1
        for (int j = 0; j < 4; ++j) { const int bh = 4 * x + j; unit(p, l, lds, bh >> 2, bh & 3, (j & 1) ? 31 - c : c, lam, li, wv); }
    } else {
        for (int it = vcu; it < 32 * 32; it += G) unit(p, l, lds, (it >> 5) >> 2, (it >> 5) & 3, it & 31, lam, li, wv);
    }
}
}


namespace lru {
#define LRU_LAS __attribute__((address_space(3)))
typedef float f32x16 __attribute__((ext_vector_type(16)));
constexpr float L2E = 1.4426950408889634f;
__device__ __forceinline__ float sigm(float x) { return __builtin_amdgcn_rcpf(1.f + __builtin_amdgcn_exp2f(-L2E * x)); }
__device__ __forceinline__ float gelu_t(float x) { return x * sigm(1.5957691216057308f * (x + 0.044715f * x * x * x)); }
__device__ __forceinline__ float bc_lo(float v) { auto rr = __builtin_amdgcn_permlane32_swap(__float_as_uint(v), __float_as_uint(v), false, false); return __uint_as_float(rr[0]); }
__device__ __forceinline__ float bc_hi(float v) { auto rr = __builtin_amdgcn_permlane32_swap(__float_as_uint(v), __float_as_uint(v), false, false); return __uint_as_float(rr[1]); }
constexpr int PART_OFF = 131072 + 1024;

constexpr size_t WS_AB = 416 * MiB;
template <int PASS>
__device__ __forceinline__ void unit(const P& p, int l, unsigned char* lds_, int b, int c, int par, int wv) {
    const int tid = otid(wv), lane = tid & 63, n = __builtin_amdgcn_readfirstlane(tid >> 6), r = lane & 31, hh = lane >> 5, tq = lane >> 3, cq = lane & 7;
    LRU_LAS unsigned char* T = (LRU_LAS unsigned char*)lds_ + n * 16384;
    const bf16_t* ZB = (const bf16_t*)(p.ws + WS_ZB); const bf16_t* ZBm = (const bf16_t*)(p.ws + WS_META + M_ZB);
    unsigned* AB = (unsigned*)(p.ws + WS_AB) + ((size_t)((b * 64 + c) * 8 + n)) * 4096 + lane;
    float hc[2] = {0.f, 0.f}, aprod[2] = {1.f, 1.f};
    if (PASS == 0) {
        bf16x8 wf[2][2][4];
        { const bf16_t* WG = (const bf16_t*)(p.ws + WS_WG);
#pragma unroll
          for (int g = 0; g < 2; ++g)
#pragma unroll
            for (int ob = 0; ob < 2; ++ob)
#pragma unroll
                for (int s = 0; s < 4; ++s) wf[g][ob][s] = *(const bf16x8*)(WG + ((size_t)((l * 2 + g) * 8 + n)) * 4096 + (32 * ob + r) * 64 + 16 * s + 8 * hh); }
        float ba_[2], bx_[2], la8_[2];
#pragma unroll
        for (int ob = 0; ob < 2; ++ob) { const int ch = n * 64 + 32 * ob + r;
            ba_[ob] = p.in[10][l * LRUW + ch]; bx_[ob] = p.in[12][l * LRUW + ch];
            la8_[ob] = -8.f * log1pf(expf(-p.in[13][l * LRUW + ch])) * L2E; }
        {
            const float* cw = p.in[7] + (size_t)l * 4 * LRUW + n * 64 + 8 * cq; const float* cb = p.in[8] + (size_t)l * LRUW + n * 64 + 8 * cq;
            bf16x8 xr[11];
#pragma unroll
            for (int k = 0; k < 11; ++k) { const int grow = 64 * c + 8 * tq - 3 + k;
                const bf16_t* ptr = grow >= 0 ? ZB + ((size_t)b * SEQ + grow) * INW : ZBm + (size_t)(NMETA + grow) * INW;
                xr[k] = *(const bf16x8*)(ptr + n * 64 + 8 * cq); }
            float w[4][8], bia[8];
#pragma unroll
            for (int k = 0; k < 4; ++k) { const f32x4 a = *(const f32x4*)(cw + k * LRUW), bq = *(const f32x4*)(cw + k * LRUW + 4);
                w[k][0] = a.x; w[k][1] = a.y; w[k][2] = a.z; w[k][3] = a.w; w[k][4] = bq.x; w[k][5] = bq.y; w[k][6] = bq.z; w[k][7] = bq.w; }
            { const f32x4 a = *(const f32x4*)cb, bq = *(const f32x4*)(cb + 4); bia[0] = a.x; bia[1] = a.y; bia[2] = a.z; bia[3] = a.w; bia[4] = bq.x; bia[5] = bq.y; bia[6] = bq.z; bia[7] = bq.w; }
#pragma unroll
            for (int j = 0; j < 8; ++j) { const int tok = 8 * tq + j; float o[8];
#pragma unroll
                for (int e = 0; e < 8; ++e) o[e] = bia[e] + w[0][e] * bf2f((bf16_t)xr[j][e]) + w[1][e] * bf2f((bf16_t)xr[j + 1][e]) + w[2][e] * bf2f((bf16_t)xr[j + 2][e]) + w[3][e] * bf2f((bf16_t)xr[j + 3][e]);
                *(LRU_LAS f32x4*)(T + tok * 256 + (((2 * cq) ^ (tok & 15)) << 4)) = (f32x4){o[0], o[1], o[2], o[3]};
                *(LRU_LAS f32x4*)(T + tok * 256 + (((2 * cq + 1) ^ (tok & 15)) << 4)) = (f32x4){o[4], o[5], o[6], o[7]}; }
        }
        wsync();
#pragma unroll
        for (int tb = 0; tb < 2; ++tb) {
            bf16x8 af[4];
            { const int tok = 32 * tb + r;
#pragma unroll
              for (int s = 0; s < 4; ++s) { const int c0 = 4 * s + 2 * hh;
                  const f32x4 v0 = *(const LRU_LAS f32x4*)(T + tok * 256 + ((c0 ^ (tok & 15)) << 4)), v1 = *(const LRU_LAS f32x4*)(T + tok * 256 + (((c0 + 1) ^ (tok & 15)) << 4));
                  u32x4 pk; pk.x = pk2(v0.x, v0.y); pk.y = pk2(v0.z, v0.w); pk.z = pk2(v1.x, v1.y); pk.w = pk2(v1.z, v1.w); af[s] = __builtin_bit_cast(bf16x8, pk); } }
#pragma unroll
            for (int ob = 0; ob < 2; ++ob) {
                f32x16 R = {}, I = {};
#pragma unroll
                for (int s = 0; s < 4; ++s) { R = __builtin_amdgcn_mfma_f32_32x32x16_bf16(af[s], wf[0][ob][s], R, 0, 0, 0); I = __builtin_amdgcn_mfma_f32_32x32x16_bf16(af[s], wf[1][ob][s], I, 0, 0, 0); }
                float a[16], bb[16];
#pragma unroll
                for (int i = 0; i < 16; ++i) { const int tok = 32 * tb + 8 * (i >> 2) + 4 * hh + (i & 3);
                    const float xcv = *(const LRU_LAS float*)(T + tok * 256 + (((8 * ob + (r >> 2)) ^ (tok & 15)) << 4) + (r & 3) * 4);
                    const float rg = sigm(R[i] + ba_[ob]), ig = sigm(I[i] + bx_[ob]);
                    const float la = la8_[ob] * rg, av = __builtin_amdgcn_exp2f(la);
                    a[i] = av; bb[i] = __builtin_amdgcn_sqrtf(fmaxf(1.f - av * av, 0.f)) * ig * xcv;
                    AB[((tb * 2 + ob) * 16 + i) * 64] = pk2(bb[i], la); }
#pragma unroll
                for (int G = 0; G < 4; ++G)
#pragma unroll
                    for (int j = 1; j < 4; ++j) { bb[4 * G + j] = a[4 * G + j] * bb[4 * G + j - 1] + bb[4 * G + j]; a[4 * G + j] = a[4 * G + j] * a[4 * G + j - 1]; }
#pragma unroll
                for (int G = 0; G < 4; ++G) { const float AG = a[4 * G + 3], BG = bb[4 * G + 3];
                    const float x = bc_lo(AG * hc[ob] + BG);
                    hc[ob] = bc_hi(AG * x + BG);
                    aprod[ob] *= AG; }
            }
        }
#pragma unroll
        for (int ob = 0; ob < 2; ++ob) { const float at = bc_lo(aprod[ob]) * bc_hi(aprod[ob]); const size_t idx = ((size_t)b * 64 + c) * LRUW + n * 64 + 32 * ob + r;
            if (hh == 0) { ((float*)(p.ws + WS_CA))[idx] = at; ((float*)(p.ws + WS_CB))[idx] = hc[ob]; } }
        return;
    }
    unsigned abv[2][2][16];
#pragma unroll
    for (int q = 0; q < 4; ++q)
#pragma unroll
        for (int i = 0; i < 16; ++i) abv[q >> 1][q & 1][i] = AB[(q * 16 + i) * 64];
    bf16x8 g8v[8];
#pragma unroll
    for (int j = 0; j < 8; ++j) g8v[j] = *(const bf16x8*)(ZB + ((size_t)b * SEQ + 64 * c + 8 * j + tq) * INW + LRUW + n * 64 + 8 * cq);
    const float* gain = p.in[14] + (size_t)l * LRUW + n * 64 + 8 * cq;
    const f32x4 g0 = *(const f32x4*)gain, g1 = *(const f32x4*)(gain + 4);
    {
        const float* CA = (const float*)(p.ws + WS_CA) + (size_t)b * 64 * LRUW + n * 64 + r; const float* CB = (const float*)(p.ws + WS_CB) + (size_t)b * 64 * LRUW + n * 64 + r;
        const int mid = c >> 1, lo = hh ? mid : 0, hi = hh ? c : mid;
        float fa0 = 1.f, fb0 = 0.f, fa1 = 1.f, fb1 = 0.f;
#pragma unroll 8
        for (int cc = lo; cc < hi; ++cc) { const float a0 = CA[(size_t)cc * LRUW], b0 = CB[(size_t)cc * LRUW], a1 = CA[(size_t)cc * LRUW + 32], b1 = CB[(size_t)cc * LRUW + 32];
            fb0 = a0 * fb0 + b0; fa0 *= a0; fb1 = a1 * fb1 + b1; fa1 *= a1; }
        const float* HME = (const float*)(p.ws + WS_META + M_HME) + n * 64 + r;
        hc[0] = bc_hi(fa0) * (bc_lo(fa0) * HME[0] + bc_lo(fb0)) + bc_hi(fb0);
        hc[1] = bc_hi(fa1) * (bc_lo(fa1) * HME[32] + bc_lo(fb1)) + bc_hi(fb1);
    }
#pragma unroll
    for (int tb = 0; tb < 2; ++tb) {
#pragma unroll
        for (int ob = 0; ob < 2; ++ob) {
            float a[16], bb[16];
#pragma unroll
            for (int i = 0; i < 16; ++i) { const unsigned w = abv[tb][ob][i]; a[i] = __builtin_amdgcn_exp2f(__uint_as_float(w & 0xffff0000u)); bb[i] = __uint_as_float(w << 16); }
#pragma unroll
            for (int G = 0; G < 4; ++G)
#pragma unroll
                for (int j = 1; j < 4; ++j) { bb[4 * G + j] = a[4 * G + j] * bb[4 * G + j - 1] + bb[4 * G + j]; a[4 * G + j] = a[4 * G + j] * a[4 * G + j - 1]; }
            float hin[4];
#pragma unroll
            for (int G = 0; G < 4; ++G) { const float AG = a[4 * G + 3], BG = bb[4 * G + 3];
                const float x = bc_lo(AG * hc[ob] + BG); hin[G] = hh ? x : hc[ob];
                hc[ob] = bc_hi(AG * x + BG); }
#pragma unroll
            for (int i = 0; i < 16; ++i) { const int tok = 32 * tb + 8 * (i >> 2) + 4 * hh + (i & 3);
                *(LRU_LAS float*)(T + tok * 256 + (((8 * ob + (r >> 2)) ^ (tok & 15)) << 4) + (r & 3) * 4) = bb[i] + a[i] * hin[i >> 2]; }
        }
    }
    wsync();
    LRU_LAS float* PART = (LRU_LAS float*)((LRU_LAS unsigned char*)lds_ + PART_OFF) + par * 512;
    float y[8][8];
#pragma unroll
    for (int j = 0; j < 8; ++j) { const int tok = 8 * j + tq;
        const f32x4 v0 = *(const LRU_LAS f32x4*)(T + tok * 256 + (((2 * cq) ^ (tok & 15)) << 4)), v1 = *(const LRU_LAS f32x4*)(T + tok * 256 + (((2 * cq + 1) ^ (tok & 15)) << 4));
        const bf16x8 g8 = g8v[j];
        const float hv[8] = {v0.x, v0.y, v0.z, v0.w, v1.x, v1.y, v1.z, v1.w}; float ss = 0.f;
#pragma unroll
        for (int e = 0; e < 8; ++e) { y[j][e] = hv[e] * gelu_t(bf2f((bf16_t)g8[e])); ss += y[j][e] * y[j][e]; }
        ss += shx(ss, 1, lane); ss += shx(ss, 2, lane); ss += shx(ss, 4, lane);
        if (cq == 0) PART[n * 64 + tok] = ss; }
    __syncthreads();
    bf16_t* YC = (bf16_t*)(p.ws + WS_YC);
#pragma unroll
    for (int j = 0; j < 8; ++j) { const int tok = 8 * j + tq; float tot = 0.f;
#pragma unroll
        for (int k = 0; k < 8; ++k) tot += PART[k * 64 + tok];
        const float rs = rsqrtf(tot * (1.f / LRUW) + 1e-6f);
        u32x4 o; o.x = pk2(y[j][0] * rs * g0.x, y[j][1] * rs * g0.y); o.y = pk2(y[j][2] * rs * g0.z, y[j][3] * rs * g0.w); o.z = pk2(y[j][4] * rs * g1.x, y[j][5] * rs * g1.y); o.w = pk2(y[j][6] * rs * g1.z, y[j][7] * rs * g1.w);
        *(u32x4*)(YC + ((size_t)b * SEQ + 64 * c + tok) * DM + n * 64 + 8 * cq) = o; }
}
template <int PASS>
__device__ __forceinline__ void phase(const P& p, int l, unsigned char* lds, int wv) {
    int par = 0;
    for (int u = blockIdx.x; u < NBATCH * 64; u += gridDim.x) {
        const int c = (PASS == 1 && u >= NBATCH * 32) ? 63 - (u & 63) : (u & 63); unit<PASS>(p, l, lds, u >> 6, c, par, wv); par ^= 1; }
    __syncthreads();
}
}

__device__ __forceinline__ void ph_normres(const float* Y, const float* Ym, const float* base, float* out, float* Hm, const float* Hm_base, const float* gpost, const float* gnext, bf16_t* U, bf16_t* Um, int wv) {
    const int tid = otid(wv), lane = tid & 63, wave = tid >> 6, gw = blockIdx.x * 8 + wave, ngw = gridDim.x * 8;
    for (int m = MR + gw; m < MR + NMETA; m += ngw) {
        const bool meta = m >= MR; const int r_ = meta ? m - MR : m;
        const float* y = (meta ? Ym : Y) + (size_t)r_ * DM; const float* bs = (meta ? Hm_base : base) + (size_t)r_ * DM; float* o = (meta ? Hm : out) + (size_t)r_ * DM;
        f32x4 v[4]; float s = 0.f;
#pragma unroll
        for (int j = 0; j < 4; ++j) { v[j] = *(const f32x4*)(y + 4 * lane + 256 * j); s += (v[j].x * v[j].x + v[j].y * v[j].y) + (v[j].z * v[j].z + v[j].w * v[j].w); }
        const float r = rsqrtf(wave_sum(s, lane) * (1.f / DM) + 1e-6f);
        float s2 = 0.f;
#pragma unroll
        for (int j = 0; j < 4; ++j) { const f32x4 g = *(const f32x4*)(gpost + 4 * lane + 256 * j), bb = *(const f32x4*)(bs + 4 * lane + 256 * j);
            v[j] = bb + v[j] * r * g; *(f32x4*)(o + 4 * lane + 256 * j) = v[j];
            s2 += (v[j].x * v[j].x + v[j].y * v[j].y) + (v[j].z * v[j].z + v[j].w * v[j].w); }
        if (gnext) {
            const float r2 = rsqrtf(wave_sum(s2, lane) * (1.f / DM) + 1e-6f);
            bf16_t* u = (meta ? Um : U) + (size_t)r_ * DM;
#pragma unroll
            for (int j = 0; j < 4; ++j) { const f32x4 g = *(const f32x4*)(gnext + 4 * lane + 256 * j);
                u32x2 w; w.x = pk2(v[j].x * r2 * g.x, v[j].y * r2 * g.y); w.y = pk2(v[j].z * r2 * g.z, v[j].w * r2 * g.w);
                *(u32x2*)(u + 4 * lane + 256 * j) = w; }
        }
    }
}


__device__ __forceinline__ void ph_normres2(const bf16_t* Y, bf16_t* HB, const float* gpost, float* RS, float* outf, int wv) {
    const int tid = otid(wv), lane = tid & 63, gw = blockIdx.x * 8 + (tid >> 6), ngw = gridDim.x * 8;
    const f32x4 g0 = *(const f32x4*)(gpost + 8 * lane), g1 = *(const f32x4*)(gpost + 8 * lane + 4), g2 = *(const f32x4*)(gpost + 512 + 8 * lane), g3 = *(const f32x4*)(gpost + 512 + 8 * lane + 4);
    bf16x8 ny0 = *(const bf16x8*)(Y + (size_t)gw * DM + 8 * lane), ny1 = *(const bf16x8*)(Y + (size_t)gw * DM + 512 + 8 * lane);
    bf16x8 nb0 = *(const bf16x8*)(HB + (size_t)gw * DM + 8 * lane), nb1 = *(const bf16x8*)(HB + (size_t)gw * DM + 512 + 8 * lane);
    for (int m = gw; m < MR; m += ngw) {
        const bf16x8 y0 = ny0, y1 = ny1, b0 = nb0, b1 = nb1;
        if (m + ngw < MR) { const size_t mn = (size_t)(m + ngw);
            ny0 = *(const bf16x8*)(Y + mn * DM + 8 * lane); ny1 = *(const bf16x8*)(Y + mn * DM + 512 + 8 * lane);
            nb0 = *(const bf16x8*)(HB + mn * DM + 8 * lane); nb1 = *(const bf16x8*)(HB + mn * DM + 512 + 8 * lane); }
        float v[16], hb[16];
#pragma unroll
        for (int e = 0; e < 8; ++e) { v[e] = bf2f((bf16_t)y0[e]); v[8 + e] = bf2f((bf16_t)y1[e]); hb[e] = bf2f((bf16_t)b0[e]); hb[8 + e] = bf2f((bf16_t)b1[e]); }
        float s = 0.f;
#pragma unroll
        for (int e = 0; e < 16; ++e) s += v[e] * v[e];
        const float r = rsqrtf(wave_sum(s, lane) * (1.f / DM) + 1e-6f);
        const float gg[16] = {g0.x, g0.y, g0.z, g0.w, g1.x, g1.y, g1.z, g1.w, g2.x, g2.y, g2.z, g2.w, g3.x, g3.y, g3.z, g3.w};
        float s2 = 0.f;
#pragma unroll
        for (int e = 0; e < 16; ++e) { hb[e] += v[e] * r * gg[e]; s2 += hb[e] * hb[e]; }
        if (outf) { float* o = outf + (size_t)m * DM;
            *(f32x4*)(o + 8 * lane) = (f32x4){hb[0], hb[1], hb[2], hb[3]}; *(f32x4*)(o + 8 * lane + 4) = (f32x4){hb[4], hb[5], hb[6], hb[7]};
            *(f32x4*)(o + 512 + 8 * lane) = (f32x4){hb[8], hb[9], hb[10], hb[11]}; *(f32x4*)(o + 512 + 8 * lane + 4) = (f32x4){hb[12], hb[13], hb[14], hb[15]};
        } else {
            const float r2 = rsqrtf(wave_sum(s2, lane) * (1.f / DM) + 1e-6f);
            if (lane == 0) RS[m] = r2;
            u32x4 w0, w1;
            w0.x = pk2(hb[0], hb[1]); w0.y = pk2(hb[2], hb[3]); w0.z = pk2(hb[4], hb[5]); w0.w = pk2(hb[6], hb[7]);
            w1.x = pk2(hb[8], hb[9]); w1.y = pk2(hb[10], hb[11]); w1.z = pk2(hb[12], hb[13]); w1.w = pk2(hb[14], hb[15]);
            *(u32x4*)(HB + (size_t)m * DM + 8 * lane) = w0; *(u32x4*)(HB + (size_t)m * DM + 512 + 8 * lane) = w1;
        }
    }
}

namespace pg8 {
#define PG8_LAS __attribute__((address_space(3)))
typedef unsigned short bf16_t;
typedef short bf16x8 __attribute__((ext_vector_type(8)));
typedef float f32x4 __attribute__((ext_vector_type(4)));
typedef unsigned u32x4 __attribute__((ext_vector_type(4)));
constexpr int BM = 256, BK = 64, HALF = 128, HTB = HALF * BK * 2  , STAGE_BYTES = 8 * HTB, NXCD = 8, WGM = 8;

__host__ __device__ __forceinline__ int lds_byte(int r, int c) { const int st = (r >> 4) * 2 + (c >> 5), rr = r & 15, cc = c & 31, ob = rr * 64 + cc * 2; return st * 1024 + (ob ^ (((ob >> 9) & 1) << 5)); }
__host__ __device__ __forceinline__ void stage_rc(int b, int& R, int& C) { const int st = b / 1024, sb = b % 1024, swz = sb ^ (((sb >> 9) & 1) << 5); R = (st >> 1) * 16 + swz / 64; C = (st & 1) * 32 + (swz % 64) / 2; }
__host__ __device__ __forceinline__ int perm32(int rho) { const int n = rho >> 4, i = rho & 15; return 8 * (i >> 2) + 4 * n + (i & 3); }

struct Unit { int pm, pn; };
struct Gemm { const bf16_t* A; const bf16_t* Bt; int M, N, K; };

struct StaticOrder {
    int nM, nN, nwg, G, c;
    __host__ __device__ void init(int M, int N, int G_, int c_) { nM = M / BM; nN = N / BM; nwg = nM * nN; G = G_; c = c_; }
    __host__ __device__ bool next(int i, Unit& u) const {
        const long L = (long)i * G + c; if (L >= nwg) return false;
        int wgid = (int)L; { const int q = nwg / NXCD, r = nwg % NXCD, xcd = wgid % NXCD, off = wgid / NXCD; wgid = (xcd < r ? xcd * (q + 1) : r * (q + 1) + (xcd - r) * q) + off; }
        const int nig = WGM * nN, gid = wgid / nig, fm = gid * WGM, gsz = (nM - fm) < WGM ? (nM - fm) : WGM;
        u.pm = fm + ((wgid % nig) % gsz); u.pn = (wgid % nig) / gsz; return true;
    }
    __device__ __forceinline__ void a_ready(const Unit&) const {}
    __device__ __forceinline__ void done(const Unit&) const {}
};

__device__ __forceinline__ unsigned cvt_pk_bf16(float lo, float hi) { unsigned r; asm volatile("v_cvt_pk_bf16_f32 %0, %1, %2" : "=v"(r) : "v"(lo), "v"(hi)); return r; }
typedef float f32x2 __attribute__((ext_vector_type(2)));
__device__ __forceinline__ f32x2 gelu_pk(f32x2 v) {
    const f32x2 av = __builtin_elementwise_abs(v), d = av * 0.2316418882f + 1.0f;
    f32x2 t; t.x = __builtin_amdgcn_rcpf(d.x); t.y = __builtin_amdgcn_rcpf(d.y);
    f32x2 q = t * 0.5307027145f + (-0.7265760135f); q = q * t + 0.7107068705f; q = q * t + (-0.142248368f); q = q * t + 0.127414796f; q = q * t;
    const f32x2 s = (v * v) * (-0.72134752044f);
    f32x2 e; e.x = __builtin_amdgcn_exp2f(s.x); e.y = __builtin_amdgcn_exp2f(s.y);
    const f32x2 m = v * (q * e), r = v - m;
    f32x2 o; o.x = v.x < 0.f ? m.x : r.x; o.y = v.y < 0.f ? m.y : r.y; return o;
}

template <int ACT  > struct EpiBf16 {
    static constexpr bool PERM = true, AFTER_DRAIN = false; static_assert(ACT == 0 || ACT == 1, "EpiBf16: ACT is 0 (none) or 1 (gelu_pk)");
    bf16_t* O; int ldc; const float* bias; int split_cols; size_t split_stride; float scale0;
    __device__ __forceinline__ void operator()(const f32x4 (&acc)[2][2][4][2], const Unit& u, int wr, int wc, int fr, int fq) const {
        const int row0 = u.pm * BM + wr * 64 + fr; int colt = u.pn * BM; bf16_t* base = O;
        float sc = 1.f; if (split_cols) { const int t = colt / split_cols; base += (size_t)t * split_stride; colt -= t * split_cols; if (t == 0) sc = scale0; }
        const int col0 = colt + wc * 32 + 8 * fq, bcol0 = u.pn * BM + wc * 32 + 8 * fq;
        f32x4 bv[2][2];
#pragma unroll
        for (int bj = 0; bj < 2; ++bj)
#pragma unroll
            for (int n = 0; n < 2; ++n) bv[bj][n] = bias ? *(const f32x4*)(bias + bcol0 + bj * HALF + 4 * n) : (f32x4){0.f, 0.f, 0.f, 0.f};
#pragma unroll
        for (int ai = 0; ai < 2; ++ai)
#pragma unroll
            for (int m = 0; m < 4; ++m) { bf16_t* rowp = base + (size_t)(row0 + ai * HALF + m * 16) * ldc + col0;
#pragma unroll
                for (int bj = 0; bj < 2; ++bj) { f32x4 v0 = acc[ai][bj][m][0] + bv[bj][0], v1 = acc[ai][bj][m][1] + bv[bj][1];
                    if (ACT == 1) { f32x2 a = gelu_pk((f32x2){v0[0], v0[1]}), b = gelu_pk((f32x2){v0[2], v0[3]}), c = gelu_pk((f32x2){v1[0], v1[1]}), d = gelu_pk((f32x2){v1[2], v1[3]});
                        v0 = (f32x4){a.x, a.y, b.x, b.y}; v1 = (f32x4){c.x, c.y, d.x, d.y}; }
                    v0 = v0 * sc; v1 = v1 * sc; u32x4 w; w.x = cvt_pk_bf16(v0[0], v0[1]); w.y = cvt_pk_bf16(v0[2], v0[3]); w.z = cvt_pk_bf16(v1[0], v1[1]); w.w = cvt_pk_bf16(v1[2], v1[3]);
                    *(u32x4*)(rowp + bj * HALF) = w; } }
    }
};

struct PanelStats {
    unsigned* xbuf;
    unsigned* cnt;
    unsigned* tmo;
    int ntn; float eps;
    unsigned code;
    __device__ __forceinline__ bool run(const f32x4 (&v)[2][2][4][2], const Unit& u, int wr, int wc, int fr, int fq, PG8_LAS unsigned char* lds, int wid, int lane) const {
        typedef float f32x2v __attribute__((ext_vector_type(2)));
        PG8_LAS f32x2v* P = (PG8_LAS f32x2v*)lds;
        PG8_LAS f32x2v* S = (PG8_LAS f32x2v*)(lds + 8192);
        PG8_LAS unsigned* flag = (PG8_LAS unsigned*)(lds + 8192 + 2048);
#pragma unroll
        for (int ai = 0; ai < 2; ++ai)
#pragma unroll
            for (int m = 0; m < 4; ++m) {
                float s = 0.f;
#pragma unroll
                for (int bj = 0; bj < 2; ++bj)
#pragma unroll
                    for (int n = 0; n < 2; ++n) { const f32x4 x = v[ai][bj][m][n]; s += (x[0] + x[1]) + (x[2] + x[3]); }
                s += __shfl_xor(s, 16); s += __shfl_xor(s, 32);
                const float mw = s * (1.0f / 64.0f); float q = 0.f;
#pragma unroll
                for (int bj = 0; bj < 2; ++bj)
#pragma unroll
                    for (int n = 0; n < 2; ++n) { const f32x4 d = v[ai][bj][m][n] - mw; q += (d[0] * d[0] + d[1] * d[1]) + (d[2] * d[2] + d[3] * d[3]); }
                q += __shfl_xor(q, 16); q += __shfl_xor(q, 32);
                if (fq == 0) P[(ai * HALF + wr * 64 + m * 16 + fr) * 4 + wc] = (f32x2v){mw, q};
            }
        asm volatile("s_waitcnt lgkmcnt(0)" ::: "memory"); __builtin_amdgcn_s_barrier(); asm volatile("" ::: "memory");
#if defined(BROKEN_EXCHANGE_NO_WAIT)
#warning BROKEN CONTROL BUILD: the row-statistics exchange does not wait; results are wrong by design
        if (blockIdx.x >= 64) { const long long t0_ = clock64(); while (clock64() - t0_ < 60000) __builtin_amdgcn_s_sleep(8); }
#endif
        const int row = wid * 32 + (lane & 31);
        if (lane < 32) {
            const f32x2v a = P[row * 4 + 0], b = P[row * 4 + 1], c = P[row * 4 + 2], d = P[row * 4 + 3];
            const float mt = (a.x + b.x + c.x + d.x) * 0.25f;
            const float da = a.x - mt, db = b.x - mt, dc = c.x - mt, dd = d.x - mt;
            const float m2 = (a.y + b.y) + (c.y + d.y) + 64.0f * ((da * da + db * db) + (dc * dc + dd * dd));
            unsigned long long* slot = (unsigned long long*)xbuf + ((size_t)(u.pm * BM + row) * 4 + u.pn);
            __hip_atomic_store(slot, ((unsigned long long)__float_as_uint(m2) << 32) | __float_as_uint(mt), __ATOMIC_RELAXED, __HIP_MEMORY_SCOPE_AGENT);
        }
        asm volatile("s_waitcnt vmcnt(0)" ::: "memory");
        if (lane == 0) __hip_atomic_fetch_add(cnt + 64 * u.pm, 1u, __ATOMIC_RELAXED, __HIP_MEMORY_SCOPE_AGENT);
        if (wid == 0) {
            bool dead = false; const unsigned long long t0 = __builtin_amdgcn_s_memrealtime(); const unsigned want = 8u * (unsigned)ntn;
            for (;;) {
#if defined(BROKEN_EXCHANGE_NO_WAIT)
                break;
#endif
                if ((unsigned)__builtin_amdgcn_readfirstlane(__hip_atomic_load(cnt + 64 * u.pm, __ATOMIC_RELAXED, __HIP_MEMORY_SCOPE_AGENT)) >= want) break;
                if (__builtin_amdgcn_s_memrealtime() - t0 > 2000000ull) {
                    if (lane == 0) { unsigned expect = 0u; __hip_atomic_compare_exchange_strong(tmo + 1, &expect, code | (unsigned)(u.pm & 0xff), __ATOMIC_RELAXED, __ATOMIC_RELAXED, __HIP_MEMORY_SCOPE_AGENT);
                                     __hip_atomic_store(tmo, 1u, __ATOMIC_RELAXED, __HIP_MEMORY_SCOPE_AGENT); }
                    dead = true; break; }
                __builtin_amdgcn_s_sleep(2);
            }
            __builtin_amdgcn_fence(__ATOMIC_ACQUIRE, "agent");
            if (lane == 0) flag[0] = dead ? 1u : 0u;
        }
        asm volatile("s_waitcnt vmcnt(0) lgkmcnt(0)" ::: "memory"); __builtin_amdgcn_s_barrier(); asm volatile("" ::: "memory");
        const bool bad = flag[0] != 0u;
        if (lane < 32) {
            const unsigned long long* slot = (const unsigned long long*)xbuf + (size_t)(u.pm * BM + row) * 4; float mt[4], m2[4]; float ms = 0.f;
#pragma unroll
            for (int t = 0; t < 4; ++t) { if (t < ntn) { const unsigned long long w = __hip_atomic_load(slot + t, __ATOMIC_RELAXED, __HIP_MEMORY_SCOPE_AGENT); mt[t] = __uint_as_float((unsigned)w); m2[t] = __uint_as_float((unsigned)(w >> 32)); } else { mt[t] = 0.f; m2[t] = 0.f; } ms += mt[t]; }
            const float mean = ms / (float)ntn; float q = 0.f;
#pragma unroll
            for (int t = 0; t < 4; ++t) if (t < ntn) { const float dm = mt[t] - mean; q += m2[t] + 256.0f * dm * dm; }
            S[row] = (f32x2v){mean, 1.0f / sqrtf(q / (256.0f * (float)ntn) + eps)};
        }
        asm volatile("s_waitcnt lgkmcnt(0)" ::: "memory"); __builtin_amdgcn_s_barrier(); asm volatile("" ::: "memory");
        return bad;
    }
};
struct EpiLnRes {
    static constexpr bool PERM = false, AFTER_DRAIN = true;
    const float* base; float* out; int ldc; const float* bias; PanelStats st; unsigned poison;
    __device__ __forceinline__ void fused(f32x4 (&acc)[2][2][4][2], const Unit& u, int wr, int wc, int fr, int fq, PG8_LAS unsigned char* lds, int wid, int lane) const {
        typedef float f32x2v __attribute__((ext_vector_type(2)));
        const PG8_LAS f32x2v* S = (const PG8_LAS f32x2v*)(lds + 8192);
        const int col0 = u.pn * BM + wc * 32 + 4 * fq;
#pragma unroll
        for (int bj = 0; bj < 2; ++bj)
#pragma unroll
            for (int n = 0; n < 2; ++n) { const f32x4 bv = bias ? *(const f32x4*)(bias + col0 + bj * HALF + n * 16) : (f32x4){0.f, 0.f, 0.f, 0.f};
#pragma unroll
                for (int ai = 0; ai < 2; ++ai)
#pragma unroll
                    for (int m = 0; m < 4; ++m) acc[ai][bj][m][n] += bv; }
        f32x4 pre[4][2][2];
#pragma unroll
        for (int m = 0; m < 4; ++m) { const size_t off = (size_t)(u.pm * BM + wr * 64 + m * 16 + fr) * ldc + col0;
#pragma unroll
            for (int bj = 0; bj < 2; ++bj)
#pragma unroll
                for (int n = 0; n < 2; ++n) pre[m][bj][n] = *(const f32x4*)(base + off + bj * HALF + n * 16); }
        const bool bad = st.run(acc, u, wr, wc, fr, fq, lds, wid, lane) || poison != 0u;
        const float qnan = __builtin_nanf("");
#pragma unroll
        for (int ai = 0; ai < 2; ++ai)
#pragma unroll
            for (int m = 0; m < 4; ++m) { const int r = ai * HALF + wr * 64 + m * 16 + fr; const f32x2v sr = S[r]; const size_t off = (size_t)(u.pm * BM + r) * ldc + col0;
#pragma unroll
                for (int bj = 0; bj < 2; ++bj)
#pragma unroll
                    for (int n = 0; n < 2; ++n) { const f32x4 bs = ai == 0 ? pre[m][bj][n] : *(const f32x4*)(base + off + bj * HALF + n * 16); f32x4 o = bs + (acc[ai][bj][m][n] - sr.x) * sr.y;
                        if (bad) o = (f32x4){qnan, qnan, qnan, qnan}; *(f32x4*)(out + off + bj * HALF + n * 16) = o; }
                if (m & 1) asm volatile("" ::: "memory"); }
    }
};
struct EpiLnResLn {
    static constexpr bool PERM = false, AFTER_DRAIN = true;
    const float* base; float* out; bf16_t* xn; int ldc; const float* bias; PanelStats st1, st2; unsigned poison;
    __device__ __forceinline__ void fused(f32x4 (&acc)[2][2][4][2], const Unit& u, int wr, int wc, int fr, int fq, PG8_LAS unsigned char* lds, int wid, int lane) const {
        typedef float f32x2v __attribute__((ext_vector_type(2))); typedef unsigned u32x2v __attribute__((ext_vector_type(2)));
        const PG8_LAS f32x2v* S = (const PG8_LAS f32x2v*)(lds + 8192);
        const int col0 = u.pn * BM + wc * 32 + 4 * fq;
#pragma unroll
        for (int bj = 0; bj < 2; ++bj)
#pragma unroll
            for (int n = 0; n < 2; ++n) { const f32x4 bv = bias ? *(const f32x4*)(bias + col0 + bj * HALF + n * 16) : (f32x4){0.f, 0.f, 0.f, 0.f};
#pragma unroll
                for (int ai = 0; ai < 2; ++ai)
#pragma unroll
                    for (int m = 0; m < 4; ++m) acc[ai][bj][m][n] += bv; }
        bool bad = st1.run(acc, u, wr, wc, fr, fq, lds, wid, lane) || poison != 0u;
        const float qnan = __builtin_nanf("");
#pragma unroll
        for (int ai = 0; ai < 2; ++ai)
#pragma unroll
            for (int m = 0; m < 4; ++m) { const int r = ai * HALF + wr * 64 + m * 16 + fr; const f32x2v sr = S[r]; const size_t off = (size_t)(u.pm * BM + r) * ldc + col0;
#pragma unroll
                for (int bj = 0; bj < 2; ++bj)
#pragma unroll
                    for (int n = 0; n < 2; ++n) { const f32x4 bs = *(const f32x4*)(base + off + bj * HALF + n * 16); acc[ai][bj][m][n] = bs + (acc[ai][bj][m][n] - sr.x) * sr.y; }
                asm volatile("" : "+v"(acc[ai][0][m][0]), "+v"(acc[ai][0][m][1]), "+v"(acc[ai][1][m][0]), "+v"(acc[ai][1][m][1]));
                if (m & 1) asm volatile("" ::: "memory"); }
        const bool bad1 = bad;
        bad = st2.run(acc, u, wr, wc, fr, fq, lds, wid, lane) || bad;
#pragma unroll
        for (int ai = 0; ai < 2; ++ai)
#pragma unroll
            for (int m = 0; m < 4; ++m) { const int r = ai * HALF + wr * 64 + m * 16 + fr; const f32x2v sr = S[r]; const size_t off = (size_t)(u.pm * BM + r) * ldc + col0;
#pragma unroll
                for (int bj = 0; bj < 2; ++bj)
#pragma unroll
                    for (int n = 0; n < 2; ++n) { const f32x4 x1 = acc[ai][bj][m][n]; *(f32x4*)(out + off + bj * HALF + n * 16) = bad1 ? (f32x4){qnan, qnan, qnan, qnan} : x1;
                        const f32x4 o = (x1 - sr.x) * sr.y; u32x2v w; w.x = cvt_pk_bf16(o[0], o[1]); w.y = cvt_pk_bf16(o[2], o[3]);
                        if (bad) { w.x = 0x7fc07fc0u; w.y = 0x7fc07fc0u; } *(u32x2v*)(xn + off + bj * HALF + n * 16) = w; }
                asm volatile("" ::: "memory"); }
    }
};

template <class Epi, class Sched, bool ALIGN_EPI = false, bool SP2 = false>
__device__ __forceinline__ void gemm_phase(PG8_LAS unsigned char* lds, const Gemm g, const Sched& S, const Epi& E, int wv) {
    const int tid = otid(wv), wid = __builtin_amdgcn_readfirstlane(tid >> 6), lane = tid & 63, wr = wid >> 2, wc = wid & 3, fr = lane & 15, fq = lane >> 4;
    const int K = g.K, nt = K / BK;
    unsigned voffA[2], voffB[2];
#pragma unroll
    for (int i = 0; i < 2; ++i) { int R, C; stage_rc(tid * 16 + i * 8192, R, C); const int Rb = Epi::PERM ? ((R & ~31) + perm32(R & 31)) : R;
        voffA[i] = (unsigned)(R * K + C) * 2u; voffB[i] = (unsigned)(Rb * K + C) * 2u; }
    const size_t kstep = (size_t)(BK * 2);
    const size_t hstep = (size_t)HALF * K * 2;
    const size_t tstep = 2 * hstep;
    const unsigned ldsw = (unsigned)wid * 1024u;
    const int aoff = lds_byte(wr * 64 + fr, fq * 8), boff = lds_byte(wc * 32 + fr, fq * 8);
#define PG8_SA(b, h) (((b) * 2 + (h)) * HTB)
#define PG8_SB(b, h) ((4 + (b) * 2 + (h)) * HTB)
#define PG8_STAGE(bufoff, gbase, voff) do { _Pragma("unroll") for (int _i = 0; _i < 2; ++_i) \
        __builtin_amdgcn_global_load_lds((const unsigned*)((const char*)(gbase) + (voff)[_i]), (PG8_LAS unsigned*)(lds + (bufoff) + ldsw + _i * 8192), 16, 0, 0); } while (0)
#define PG8_LDA(dst, b, h) do { _Pragma("unroll") for (int m = 0; m < 4; ++m) _Pragma("unroll") for (int k = 0; k < 2; ++k) dst[m][k] = *(const PG8_LAS bf16x8*)(lds + PG8_SA(b, h) + aoff + m * 2048 + k * 1024); } while (0)
#define PG8_LDB(dst, b, h) do { _Pragma("unroll") for (int n = 0; n < 2; ++n) _Pragma("unroll") for (int k = 0; k < 2; ++k) dst[n][k] = *(const PG8_LAS bf16x8*)(lds + PG8_SB(b, h) + boff + n * 2048 + k * 1024); } while (0)
#define PG8_MMA(ai, bj, At, Bt) do { __builtin_amdgcn_s_setprio(1); _Pragma("unroll") for (int m = 0; m < 4; ++m) _Pragma("unroll") for (int n = 0; n < 2; ++n) _Pragma("unroll") for (int k = 0; k < 2; ++k) \
        acc[ai][bj][m][n] = __builtin_amdgcn_mfma_f32_16x16x32_bf16(Bt[n][k], At[m][k], acc[ai][bj][m][n], 0, 0, 0); __builtin_amdgcn_s_setprio(0); } while (0)
#define PG8_WAIT_V(n) asm volatile("s_waitcnt vmcnt(" #n ")" ::: "memory")
#define PG8_WAIT_L(n) asm volatile("s_waitcnt lgkmcnt(" #n ")" ::: "memory")
#define PG8_BAR __builtin_amdgcn_s_barrier()
#define PG8_SCHED __builtin_amdgcn_sched_barrier(0)
    Unit cur, nxt; int ui = 0;
    if (!S.next(0, cur)) return;
    f32x4 acc[2][2][4][2];
#pragma unroll
    for (int a = 0; a < 2; ++a)
#pragma unroll
        for (int b = 0; b < 2; ++b)
#pragma unroll
            for (int m = 0; m < 4; ++m)
#pragma unroll
                for (int n = 0; n < 2; ++n) acc[a][b][m][n] = (f32x4){0.f, 0.f, 0.f, 0.f};
    bf16x8 At[4][2], B0[2][2], B1[2][2];
    const char* cA = (const char*)g.A + (size_t)cur.pm * tstep; const char* cB = (const char*)g.Bt + (size_t)cur.pn * tstep;
    S.a_ready(cur);
    if constexpr (SP2) {
        PG8_STAGE(PG8_SB(0, 0), cB, voffB); PG8_STAGE(PG8_SB(0, 1), cB + hstep, voffB); PG8_STAGE(PG8_SA(0, 0), cA, voffA); PG8_STAGE(PG8_SA(0, 1), cA + hstep, voffA);
        if (wr == 1) PG8_BAR;
        PG8_WAIT_V(2); PG8_BAR;
        PG8_STAGE(PG8_SB(1, 0), cB + kstep, voffB); PG8_STAGE(PG8_SA(1, 0), cA + kstep, voffA); PG8_STAGE(PG8_SB(1, 1), cB + hstep + kstep, voffB);
        PG8_WAIT_V(6); PG8_BAR;
    } else {
        PG8_STAGE(PG8_SB(0, 0), cB, voffB); PG8_STAGE(PG8_SA(0, 0), cA, voffA); PG8_STAGE(PG8_SB(0, 1), cB + hstep, voffB); PG8_STAGE(PG8_SA(0, 1), cA + hstep, voffA);
        if (wr == 1) PG8_BAR;
        PG8_WAIT_V(4); PG8_BAR;
        PG8_STAGE(PG8_SB(1, 0), cB + kstep, voffB); PG8_STAGE(PG8_SA(1, 0), cA + kstep, voffA); PG8_STAGE(PG8_SB(1, 1), cB + hstep + kstep, voffB);
        PG8_WAIT_V(6); PG8_BAR;
    }
    for (;;) {
        const bool has_next = S.next(ui + 1, nxt);
        const char* nA = has_next ? (const char*)g.A + (size_t)nxt.pm * tstep : cA; const char* nB = has_next ? (const char*)g.Bt + (size_t)nxt.pn * tstep : cB;
        for (int t = 0; t < nt; t += 2) {
            const bool last = (t == nt - 2);
            const char* a1 = cA + (size_t)(t + 1) * kstep;
            const char* a2 = last ? nA : cA + (size_t)(t + 2) * kstep; const char* b2 = last ? nB : cB + (size_t)(t + 2) * kstep;
            const char* a3 = a2 + kstep; const char* b3 = b2 + kstep;
            if (last && has_next) S.a_ready(nxt);
            if constexpr (SP2) {
            PG8_LDB(B0, 0, 0); PG8_LDB(B1, 0, 1); PG8_SCHED; PG8_LDA(At, 0, 0); PG8_STAGE(PG8_SA(1, 1), a1 + hstep, voffA);
            PG8_WAIT_V(8); PG8_WAIT_L(0); PG8_BAR; PG8_MMA(0, 0, At, B0); PG8_MMA(0, 1, At, B1); PG8_BAR; PG8_SCHED;
            PG8_LDA(At, 0, 1); PG8_STAGE(PG8_SB(0, 0), b2, voffB); PG8_STAGE(PG8_SB(0, 1), b2 + hstep, voffB); PG8_STAGE(PG8_SA(0, 0), a2, voffA);
            PG8_WAIT_V(8); PG8_WAIT_L(0); PG8_BAR; PG8_MMA(1, 0, At, B0); PG8_MMA(1, 1, At, B1); PG8_BAR; PG8_SCHED;
            PG8_LDB(B0, 1, 0); PG8_LDB(B1, 1, 1); PG8_SCHED; PG8_LDA(At, 1, 0); PG8_STAGE(PG8_SA(0, 1), a2 + hstep, voffA);
            PG8_WAIT_V(8); PG8_WAIT_L(0); PG8_BAR; PG8_MMA(0, 0, At, B0); PG8_MMA(0, 1, At, B1); PG8_BAR; PG8_SCHED;
            PG8_LDA(At, 1, 1); PG8_STAGE(PG8_SB(1, 0), b3, voffB); PG8_STAGE(PG8_SB(1, 1), b3 + hstep, voffB); PG8_STAGE(PG8_SA(1, 0), a3, voffA);
            PG8_WAIT_V(8); PG8_WAIT_L(0); PG8_BAR; PG8_MMA(1, 0, At, B0); PG8_MMA(1, 1, At, B1); PG8_BAR; PG8_SCHED;
            } else {
            PG8_LDB(B0, 0, 0); PG8_SCHED; PG8_LDA(At, 0, 0); PG8_STAGE(PG8_SA(1, 1), a1 + hstep, voffA);
            PG8_WAIT_L(8); PG8_BAR; PG8_WAIT_L(0); PG8_MMA(0, 0, At, B0); PG8_BAR; PG8_SCHED;
            PG8_LDB(B1, 0, 1); PG8_STAGE(PG8_SB(0, 0), b2, voffB);
            PG8_BAR; PG8_WAIT_L(0); PG8_MMA(0, 1, At, B1); PG8_BAR;
            PG8_LDA(At, 0, 1); PG8_STAGE(PG8_SA(0, 0), a2, voffA);
            PG8_BAR; PG8_WAIT_L(0); PG8_MMA(1, 0, At, B0); PG8_BAR; PG8_SCHED;
            PG8_STAGE(PG8_SB(0, 1), b2 + hstep, voffB);
            PG8_WAIT_V(6); PG8_BAR; PG8_MMA(1, 1, At, B1); PG8_BAR;
            PG8_LDB(B0, 1, 0); PG8_SCHED; PG8_LDA(At, 1, 0); PG8_STAGE(PG8_SA(0, 1), a2 + hstep, voffA);
            PG8_WAIT_L(8); PG8_BAR; PG8_WAIT_L(0); PG8_MMA(0, 0, At, B0); PG8_BAR; PG8_SCHED;
            PG8_LDB(B1, 1, 1); PG8_STAGE(PG8_SB(1, 0), b3, voffB);
            PG8_BAR; PG8_WAIT_L(0); PG8_MMA(0, 1, At, B1); PG8_BAR;
            PG8_LDA(At, 1, 1); PG8_STAGE(PG8_SA(1, 0), a3, voffA);
            PG8_BAR; PG8_WAIT_L(0); PG8_MMA(1, 0, At, B0); PG8_BAR; PG8_SCHED;
            PG8_STAGE(PG8_SB(1, 1), b3 + hstep, voffB);
            PG8_WAIT_V(6); PG8_BAR; PG8_MMA(1, 1, At, B1); PG8_BAR;
            }
        }
        if constexpr (ALIGN_EPI) { if (wr == 0) PG8_BAR; }
        if constexpr (!Epi::AFTER_DRAIN) { E(acc, cur, wr, wc, fr, fq); S.done(cur); }
        if (!has_next) break;
#pragma unroll
        for (int a = 0; a < 2; ++a)
#pragma unroll
            for (int b = 0; b < 2; ++b)
#pragma unroll
                for (int m = 0; m < 4; ++m)
#pragma unroll
                    for (int n = 0; n < 2; ++n) acc[a][b][m][n] = (f32x4){0.f, 0.f, 0.f, 0.f};
        cur = nxt; cA = nA; cB = nB; ++ui;
        if constexpr (ALIGN_EPI) { if (wr == 1) PG8_BAR; }
    }
    PG8_WAIT_V(0);
    if constexpr (!ALIGN_EPI) { if (wr == 0) PG8_BAR; }
    PG8_BAR;
    if constexpr (Epi::AFTER_DRAIN) { E.fused(acc, cur, wr, wc, fr, fq, lds, wid, lane); S.done(cur); }
#undef PG8_SA
#undef PG8_SB
#undef PG8_STAGE
#undef PG8_LDA
#undef PG8_LDB
#undef PG8_MMA
#undef PG8_WAIT_V
#undef PG8_WAIT_L
#undef PG8_BAR
#undef PG8_SCHED
}
}

namespace pg8 {
struct EpiWinPg {
    static constexpr bool PERM = false, AFTER_DRAIN = false;
    bf16_t* Z; const float* rc; const float* rs; const float* RSr;
    __device__ __forceinline__ void operator()(const f32x4 (&acc)[2][2][4][2], const Unit& u, int wr, int wc, int fr, int fq) const {
        const bool qk = u.pn >= 4 && u.pn < 8; int pn_ = u.pn; asm volatile("" : "+s"(pn_)); const float sc = pn_ < 6 ? QSCALE : 1.f;
        const int fo = 16 * (wc & 1) + 4 * fq, rowb = u.pm * BM + wr * 64 + fr;
        f32x4 cn = (f32x4){1.f, 1.f, 1.f, 1.f}, sn = (f32x4){0.f, 0.f, 0.f, 0.f}; float rn = RSr[rowb];
        if (qk) { const int t = 16 + (rowb & 4095); cn = *(const f32x4*)(rc + t * 32 + fo); sn = *(const f32x4*)(rs + t * 32 + fo); }
#pragma unroll
        for (int k = 0; k < 8; ++k) { const int ai = k >> 2, m = k & 3; const int row = rowb + ai * HALF + m * 16;
                const f32x4 c = cn, s = sn; const float rsr = rn;
                if (k + 1 < 8) { const int rown = rowb + ((k + 1) >> 2) * HALF + ((k + 1) & 3) * 16; rn = RSr[rown];
                    if (qk) { const int t = 16 + (rown & 4095); cn = *(const f32x4*)(rc + t * 32 + fo); sn = *(const f32x4*)(rs + t * 32 + fo); } }
                __builtin_amdgcn_sched_barrier(0);
                bf16_t* rowp = Z + (size_t)row * 2560 + u.pn * BM + wc * 32 + 8 * fq;
#pragma unroll
                for (int bj = 0; bj < 2; ++bj) { f32x4 v0 = acc[ai][bj][m][0] * rsr, v1 = acc[ai][bj][m][1] * rsr;
                    if (qk) { const f32x4 x1 = v0, x2 = v1; v0 = (x1 * c - x2 * s) * sc; v1 = (x2 * c + x1 * s) * sc; }
                    u32x4 w; w.x = cvt_pk_bf16(v0[0], v0[1]); w.y = cvt_pk_bf16(v0[2], v0[3]); w.z = cvt_pk_bf16(v1[0], v1[1]); w.w = cvt_pk_bf16(v1[2], v1[3]);
                    *(u32x4*)(rowp + bj * HALF) = w; } }
    }
};
template <int CTRL> __device__ __forceinline__ f32x4 dppv(f32x4 v) { f32x4 r;
#pragma unroll
    for (int i = 0; i < 4; ++i) r[i] = __builtin_bit_cast(float, __builtin_amdgcn_update_dpp(0, __builtin_bit_cast(int, v[i]), CTRL, 0xf, 0xf, true));
    return r; }
__device__ __forceinline__ float gelu_fast(float x) { return x * __builtin_amdgcn_rcpf(1.f + __builtin_amdgcn_exp2f(-2.302208198f * (x + 0.044715f * x * x * x))); }
struct EpiUpPg {
    static constexpr bool PERM = false, AFTER_DRAIN = false;
    bf16_t* HID; const float* cw; const float* cb; float* GH; float* GT; float* VH; const float* RSr;
    __device__ __forceinline__ void operator()(const f32x4 (&acc)[2][2][4][2], const Unit& u, int wr, int wc, int fr, int fq) const {
        const int hb = 128 * u.pn + 32 * wc + 8 * fq;
        f32x4 w0[2], w1[2], w2[2], bb[2];
#pragma unroll
        for (int bj = 0; bj < 2; ++bj) { w0[bj] = *(const f32x4*)(cw + hb + 4 * bj); w1[bj] = *(const f32x4*)(cw + 3072 + hb + 4 * bj); w2[bj] = *(const f32x4*)(cw + 6144 + hb + 4 * bj); bb[bj] = *(const f32x4*)(cb + hb + 4 * bj); }
        const int a1 = (fq * 16 + ((fr - 1) & 15)) << 2, a2 = (fq * 16 + ((fr - 2) & 15)) << 2;
        float rsv[2][4];
#pragma unroll
        for (int ai = 0; ai < 2; ++ai)
#pragma unroll
            for (int m = 0; m < 4; ++m) rsv[ai][m] = RSr[u.pm * BM + ai * HALF + wr * 64 + m * 16 + fr];
#pragma unroll
        for (int ai = 0; ai < 2; ++ai) { f32x4 xp[2] = {{0.f, 0.f, 0.f, 0.f}, {0.f, 0.f, 0.f, 0.f}};
#pragma unroll
            for (int m = 0; m < 4; ++m) { const int row = u.pm * BM + ai * HALF + wr * 64 + m * 16 + fr; const int blk = row >> 6; const float rsr = rsv[ai][m];
                u32x4 w;
#pragma unroll
                for (int bj = 0; bj < 2; ++bj) { const int hc = hb + 4 * bj;
                    const f32x4 x = acc[ai][bj][m][0] * rsr, v = acc[ai][bj][m][1] * rsr;
                    f32x4 p1, p2;
#pragma unroll
                    for (int i = 0; i < 4; ++i) { const float s1 = fr == 15 ? xp[bj][i] : x[i], s2 = fr >= 14 ? xp[bj][i] : x[i];
                        p1[i] = __builtin_bit_cast(float, __builtin_amdgcn_update_dpp(0, __builtin_bit_cast(int, s1), 0x121, 0xf, 0xf, false));
                        p2[i] = __builtin_bit_cast(float, __builtin_amdgcn_update_dpp(0, __builtin_bit_cast(int, s2), 0x122, 0xf, 0xf, false)); }
                    const f32x4 gc = bb[bj] + w2[bj] * x + w1[bj] * p1 + w0[bj] * p2;
                    const unsigned lo = cvt_pk_bf16(gelu_fast(gc[0]) * v[0], gelu_fast(gc[1]) * v[1]), hi = cvt_pk_bf16(gelu_fast(gc[2]) * v[2], gelu_fast(gc[3]) * v[3]);
                    if (bj == 0) { w.x = lo; w.y = hi; } else { w.z = lo; w.w = hi; }
                    if (m == 0 && fr < 2) { *(f32x4*)(GH + ((size_t)blk * 2 + fr) * 3072 + hc) = x; *(f32x4*)(VH + ((size_t)blk * 2 + fr) * 3072 + hc) = v; }
                    if (m == 3 && fr >= 14) *(f32x4*)(GT + ((size_t)blk * 2 + (fr - 14)) * 3072 + hc) = x;
                    xp[bj] = x; }
                *(u32x4*)(HID + (size_t)row * 3072 + hb) = w; } }
    }
};

struct PanelRms {
    unsigned* xbuf; unsigned* cnt; unsigned* tmo; float eps; unsigned code;
    __device__ __forceinline__ bool run(const f32x4 (&v)[2][2][4][2], int gpm, int pn, int wr, int wc, int fr, int fq, PG8_LAS unsigned char* lds, int wid, int lane) const {
        PG8_LAS float* Pp = (PG8_LAS float*)lds;
        PG8_LAS float* S = (PG8_LAS float*)(lds + 8192);
        PG8_LAS unsigned* flag = (PG8_LAS unsigned*)(lds + 8192 + 2048);
#pragma unroll
        for (int ai = 0; ai < 2; ++ai)
#pragma unroll
            for (int m = 0; m < 4; ++m) { float q = 0.f;
#pragma unroll
                for (int bj = 0; bj < 2; ++bj)
#pragma unroll
                    for (int n = 0; n < 2; ++n) { const f32x4 x = v[ai][bj][m][n]; q += (x[0] * x[0] + x[1] * x[1]) + (x[2] * x[2] + x[3] * x[3]); }
                q += __int_as_float(__builtin_amdgcn_ds_bpermute((lane ^ 16) << 2, __float_as_int(q))); q += __int_as_float(__builtin_amdgcn_ds_bpermute((lane ^ 32) << 2, __float_as_int(q)));
                if (fq == 0) Pp[(ai * HALF + wr * 64 + m * 16 + fr) * 4 + wc] = q; }
        asm volatile("s_waitcnt lgkmcnt(0)" ::: "memory"); __builtin_amdgcn_s_barrier(); asm volatile("" ::: "memory");
        const int row = wid * 32 + (lane & 31);
        if (lane < 32) { const float t = (Pp[row * 4 + 0] + Pp[row * 4 + 1]) + (Pp[row * 4 + 2] + Pp[row * 4 + 3]);
            __hip_atomic_store(xbuf + ((size_t)(gpm * BM + row) * 4 + pn), __float_as_uint(t), __ATOMIC_RELAXED, __HIP_MEMORY_SCOPE_AGENT); }
        asm volatile("s_waitcnt vmcnt(0)" ::: "memory");
        if (lane == 0) __hip_atomic_fetch_add(cnt + 64 * gpm, 1u, __ATOMIC_RELAXED, __HIP_MEMORY_SCOPE_AGENT);
        if (wid == 0) {
            bool dead = false; const unsigned long long t0 = __builtin_amdgcn_s_memrealtime();
            for (;;) {
                if ((unsigned)__builtin_amdgcn_readfirstlane(__hip_atomic_load(cnt + 64 * gpm, __ATOMIC_RELAXED, __HIP_MEMORY_SCOPE_AGENT)) >= 32u) break;
                if (__builtin_amdgcn_s_memrealtime() - t0 > 2000000ull) {
                    if (lane == 0) { unsigned expect = 0u; __hip_atomic_compare_exchange_strong(tmo + 1, &expect, code | (unsigned)(gpm & 0xff), __ATOMIC_RELAXED, __ATOMIC_RELAXED, __HIP_MEMORY_SCOPE_AGENT);
                                     __hip_atomic_store(tmo, 1u, __ATOMIC_RELAXED, __HIP_MEMORY_SCOPE_AGENT); }
                    dead = true; break; }
                __builtin_amdgcn_s_sleep(2);
            }
            __builtin_amdgcn_fence(__ATOMIC_ACQUIRE, "agent");
            if (lane == 0) flag[0] = dead ? 1u : 0u;
        }
        asm volatile("s_waitcnt vmcnt(0) lgkmcnt(0)" ::: "memory"); __builtin_amdgcn_s_barrier(); asm volatile("" ::: "memory");
        const bool bad = flag[0] != 0u;
        if (lane < 32) { const unsigned* slot = xbuf + (size_t)(gpm * BM + row) * 4; float t = 0.f;
#pragma unroll
            for (int k = 0; k < 4; ++k) t += __uint_as_float(__hip_atomic_load(slot + k, __ATOMIC_RELAXED, __HIP_MEMORY_SCOPE_AGENT));
            S[row] = 1.0f / sqrtf(t * (1.0f / 1024.0f) + eps); }
        asm volatile("s_waitcnt lgkmcnt(0)" ::: "memory"); __builtin_amdgcn_s_barrier(); asm volatile("" ::: "memory");
        return bad;
    }
};
template <bool HASNEXT> struct EpiRmsRes {
    static constexpr bool PERM = false, AFTER_DRAIN = true;
    const float* base; float* out; bf16_t* xn; const float* gpost; const float* gnext; PanelRms st1, st2; int pm_off, pad;
    __device__ __forceinline__ void fused(f32x4 (&acc)[2][2][4][2], const Unit& u, int wr, int wc, int fr, int fq, PG8_LAS unsigned char* lds, int wid, int lane) const {
        typedef unsigned u32x2v __attribute__((ext_vector_type(2)));
        const PG8_LAS float* S = (const PG8_LAS float*)(lds + 8192);
        const int gpm = u.pm + pm_off, col0 = u.pn * BM + wc * 32 + 4 * fq;
        bool bad = st1.run(acc, gpm, u.pn, wr, wc, fr, fq, lds, wid, lane);
        const float qnan = __builtin_nanf("");
#pragma unroll
        for (int ai = 0; ai < 2; ++ai)
#pragma unroll
            for (int m = 0; m < 4; ++m) { int r = ai * HALF + wr * 64 + m * 16 + fr; asm volatile("" : "+v"(r)); const float rs = S[r]; const size_t off = (size_t)(gpm * BM + r) * 1024 + col0;
#pragma unroll
                for (int bj = 0; bj < 2; ++bj)
#pragma unroll
                    for (int n = 0; n < 2; ++n) { const f32x4 bs = *(const f32x4*)(base + off + bj * HALF + n * 16), gq = *(const f32x4*)(gpost + col0 + bj * HALF + n * 16); acc[ai][bj][m][n] = bs + acc[ai][bj][m][n] * rs * gq; }
                asm volatile("" : "+v"(acc[ai][0][m][0]), "+v"(acc[ai][0][m][1]), "+v"(acc[ai][1][m][0]), "+v"(acc[ai][1][m][1]));
                asm volatile("" ::: "memory"); }
        if constexpr (!HASNEXT) {
#pragma unroll
            for (int ai = 0; ai < 2; ++ai)
#pragma unroll
                for (int m = 0; m < 4; ++m) { int r = ai * HALF + wr * 64 + m * 16 + fr; asm volatile("" : "+v"(r)); const size_t off = (size_t)(gpm * BM + r) * 1024 + col0;
#pragma unroll
                    for (int bj = 0; bj < 2; ++bj)
#pragma unroll
                        for (int n = 0; n < 2; ++n) *(f32x4*)(out + off + bj * HALF + n * 16) = bad ? (f32x4){qnan, qnan, qnan, qnan} : acc[ai][bj][m][n]; }
            return;
        }
        if constexpr (HASNEXT) {
        const bool bad1 = bad;
        bad = st2.run(acc, gpm, u.pn, wr, wc, fr, fq, lds, wid, lane) || bad;
#pragma unroll
        for (int ai = 0; ai < 2; ++ai)
#pragma unroll
            for (int m = 0; m < 4; ++m) { int r = ai * HALF + wr * 64 + m * 16 + fr; asm volatile("" : "+v"(r)); const float rs = S[r]; const size_t off = (size_t)(gpm * BM + r) * 1024 + col0;
#pragma unroll
                for (int bj = 0; bj < 2; ++bj)
#pragma unroll
                    for (int n = 0; n < 2; ++n) { const f32x4 x1 = acc[ai][bj][m][n]; *(f32x4*)(out + off + bj * HALF + n * 16) = bad1 ? (f32x4){qnan, qnan, qnan, qnan} : x1;
                        const f32x4 o = x1 * rs * *(const f32x4*)(gnext + col0 + bj * HALF + n * 16); u32x2v w; w.x = cvt_pk_bf16(o[0], o[1]); w.y = cvt_pk_bf16(o[2], o[3]);
                        if (bad) { w.x = 0x7fc07fc0u; w.y = 0x7fc07fc0u; } *(u32x2v*)(xn + off + bj * HALF + n * 16) = w; }
                asm volatile("" ::: "memory"); }
        }
    }
};
struct EpiF32Pg {
    static constexpr bool PERM = false, AFTER_DRAIN = false;
    float* C; int ldc;
    __device__ __forceinline__ void operator()(const f32x4 (&acc)[2][2][4][2], const Unit& u, int wr, int wc, int fr, int fq) const {
        const int row0 = u.pm * BM + wr * 64 + fr, col0 = u.pn * BM + wc * 32 + 4 * fq;
#pragma unroll
        for (int ai = 0; ai < 2; ++ai)
#pragma unroll
            for (int m = 0; m < 4; ++m) { float* rowp = C + (size_t)(row0 + ai * HALF + m * 16) * ldc + col0;
#pragma unroll
                for (int bj = 0; bj < 2; ++bj)
#pragma unroll
                    for (int n = 0; n < 2; ++n) *(f32x4*)(rowp + bj * HALF + n * 16) = acc[ai][bj][m][n]; }
    }
};
}


constexpr int CW_META = 8192;
template <class Epi>
__device__ __forceinline__ void meta_gemm(const bf16_t* A, const bf16_t* Bt, int N, int K, const Epi& epi, unsigned char* lds, int wv) {
    const int tile = blockIdx.x;
    if (tile >= N / 32) return;
    const int lane = otid(wv) & 63, fr = lane & 15, fq = lane >> 4;
    f32x4 acc[1][2]; acc[0][0] = (f32x4){0.f, 0.f, 0.f, 0.f}; acc[0][1] = (f32x4){0.f, 0.f, 0.f, 0.f};
    const int kw = K / 8;
    const bf16_t* Ap = A + (size_t)fr * K + fq * 8 + wv * kw;
    const bf16_t* Bp = Bt + (size_t)(tile * 32 + fr) * K + fq * 8 + wv * kw;
    if (K == 1024) {
        bf16x8 a[4], b0[4], b1[4];
#pragma unroll
        for (int i = 0; i < 4; ++i) { a[i] = *(const bf16x8*)(Ap + 32 * i); b0[i] = *(const bf16x8*)(Bp + 32 * i); b1[i] = *(const bf16x8*)(Bp + (size_t)16 * 1024 + 32 * i); }
        __builtin_amdgcn_sched_barrier(0);
#pragma unroll
        for (int i = 0; i < 4; ++i) { acc[0][0] = __builtin_amdgcn_mfma_f32_16x16x32_bf16(b0[i], a[i], acc[0][0], 0, 0, 0); acc[0][1] = __builtin_amdgcn_mfma_f32_16x16x32_bf16(b1[i], a[i], acc[0][1], 0, 0, 0); }
    } else {
        bf16x8 a[12], b0[12], b1[12];
#pragma unroll
        for (int i = 0; i < 12; ++i) { a[i] = *(const bf16x8*)(Ap + 32 * i); b0[i] = *(const bf16x8*)(Bp + 32 * i); b1[i] = *(const bf16x8*)(Bp + (size_t)16 * 3072 + 32 * i); }
        __builtin_amdgcn_sched_barrier(0);
#pragma unroll
        for (int i = 0; i < 12; ++i) { acc[0][0] = __builtin_amdgcn_mfma_f32_16x16x32_bf16(b0[i], a[i], acc[0][0], 0, 0, 0); acc[0][1] = __builtin_amdgcn_mfma_f32_16x16x32_bf16(b1[i], a[i], acc[0][1], 0, 0, 0); }
    }
    f32x4* red = (f32x4*)lds;
    red[(wv * 2 + 0) * 64 + lane] = acc[0][0]; red[(wv * 2 + 1) * 64 + lane] = acc[0][1];
    __syncthreads();
    if (wv == 0) {
#pragma unroll
        for (int w = 1; w < 8; ++w) { acc[0][0] += red[(w * 2 + 0) * 64 + lane]; acc[0][1] += red[(w * 2 + 1) * 64 + lane]; }
        epi.template run<1, 2>(acc, 0, tile * 32, fr, fq);
    }
    __syncthreads();
}
__device__ __forceinline__ void meta_norm_last(unsigned* cnt, int ntiles, const float* Ym, const float* Hm_base, float* Hm, const float* gpost, float* RSm, bf16_t* Um, unsigned char* lds, int wv) {
    if ((int)blockIdx.x >= ntiles) return;
    const int lane = otid(wv) & 63;
    volatile unsigned* flag = (volatile unsigned*)(lds + 16384);
    if (wv == 0) {
        asm volatile("s_waitcnt vmcnt(0)" ::: "memory");
        __builtin_amdgcn_fence(__ATOMIC_RELEASE, "agent");
        asm volatile("s_waitcnt vmcnt(0)" ::: "memory");
        unsigned old = 0u;
        if (lane == 0) old = __hip_atomic_fetch_add(cnt, 1u, __ATOMIC_RELAXED, __HIP_MEMORY_SCOPE_AGENT);
        old = (unsigned)__builtin_amdgcn_readfirstlane((int)old);
        const bool last = old == (unsigned)(ntiles - 1);
        if (last) { __builtin_amdgcn_fence(__ATOMIC_ACQUIRE, "agent"); asm volatile("s_waitcnt vmcnt(0)" ::: "memory"); }
        if (lane == 0) *flag = last ? 1u : 0u;
    }
    __syncthreads();
    const bool last = *flag != 0u;
    __syncthreads();
    if (!last) return;
#pragma unroll
    for (int rr = 0; rr < 2; ++rr) { const int row = 2 * wv + rr;
        const float* y = Ym + row * DM; const float* bs = Hm_base + row * DM; float* ho = Hm + row * DM;
        f32x4 v[4]; float s = 0.f;
#pragma unroll
        for (int j = 0; j < 4; ++j) { v[j] = *(const f32x4*)(y + 4 * lane + 256 * j); s += (v[j].x * v[j].x + v[j].y * v[j].y) + (v[j].z * v[j].z + v[j].w * v[j].w); }
        const float r = rsqrtf(wave_sum(s, lane) * (1.f / DM) + 1e-6f);
        float s2 = 0.f;
#pragma unroll
        for (int j = 0; j < 4; ++j) { const f32x4 g = *(const f32x4*)(gpost + 4 * lane + 256 * j), bb = *(const f32x4*)(bs + 4 * lane + 256 * j);
            v[j] = bb + v[j] * r * g; *(f32x4*)(ho + 4 * lane + 256 * j) = v[j];
            s2 += (v[j].x * v[j].x + v[j].y * v[j].y) + (v[j].z * v[j].z + v[j].w * v[j].w); }
        if (RSm) {
            const float r2 = rsqrtf(wave_sum(s2, lane) * (1.f / DM) + 1e-6f);
            if (lane == 0) RSm[row] = r2;
            bf16_t* uo = Um + row * DM;
#pragma unroll
            for (int j = 0; j < 4; ++j) { u32x2 w; w.x = pk2(v[j].x, v[j].y); w.y = pk2(v[j].z, v[j].w); *(u32x2*)(uo + 4 * lane + 256 * j) = w; }
        }
    }
}
__device__ __forceinline__ void ph_meta_norm(const float* Ym, const float* Hm_base, float* Hm, const float* gpost, float* RSm, bf16_t* Um, int wv) {
    const int row = ((int)gridDim.x - 1 - (int)blockIdx.x) * 8 + wv;
    if (row >= NMETA) return;
    const int lane = otid(wv) & 63;
    const float* y = Ym + row * DM; const float* bs = Hm_base + row * DM; float* ho = Hm + row * DM;
    f32x4 v[4], g[4], bb[4]; float s = 0.f;
#pragma unroll
    for (int j = 0; j < 4; ++j) { v[j] = *(const f32x4*)(y + 4 * lane + 256 * j); g[j] = *(const f32x4*)(gpost + 4 * lane + 256 * j); bb[j] = *(const f32x4*)(bs + 4 * lane + 256 * j); }
#pragma unroll
    for (int j = 0; j < 4; ++j) s += (v[j].x * v[j].x + v[j].y * v[j].y) + (v[j].z * v[j].z + v[j].w * v[j].w);
    const float r = rsqrtf(wave_sum(s, lane) * (1.f / DM) + 1e-6f);
    float s2 = 0.f;
#pragma unroll
    for (int j = 0; j < 4; ++j) { v[j] = bb[j] + v[j] * r * g[j]; *(f32x4*)(ho + 4 * lane + 256 * j) = v[j];
        s2 += (v[j].x * v[j].x + v[j].y * v[j].y) + (v[j].z * v[j].z + v[j].w * v[j].w); }
    if (RSm) {
        const float r2 = rsqrtf(wave_sum(s2, lane) * (1.f / DM) + 1e-6f);
        if (lane == 0) RSm[row] = r2;
        bf16_t* uo = Um + row * DM;
#pragma unroll
        for (int j = 0; j < 4; ++j) { u32x2 w; w.x = pk2(v[j].x, v[j].y); w.y = pk2(v[j].z, v[j].w); *(u32x2*)(uo + 4 * lane + 256 * j) = w; }
    }
}
struct EpiUpMeta {
    bf16_t* HIDm; float* GM; const float* cw; const float* cb; const float* RSr;
    template <int MT, int NTL> __device__ __forceinline__ void run(const f32x4 (&acc)[MT][NTL], int row0, int col0, int fr, int fq) const {
        const int s = col0 & 255, hc = 128 * (col0 >> 8) + 32 * ((s >> 5) & 3) + 8 * fq + 4 * ((s >> 7) & 1);
        const float rsr = RSr[fr]; const f32x4 x = acc[0][0] * rsr, v = acc[0][1] * rsr;
        const int a1 = (fq * 16 + ((fr - 1) & 15)) << 2, a2 = (fq * 16 + ((fr - 2) & 15)) << 2;
        f32x4 p1, p2;
#pragma unroll
        for (int i = 0; i < 4; ++i) { const float t1 = __int_as_float(__builtin_amdgcn_ds_bpermute(a1, __float_as_int(x[i]))), t2 = __int_as_float(__builtin_amdgcn_ds_bpermute(a2, __float_as_int(x[i])));
            p1[i] = fr >= 1 ? t1 : 0.f; p2[i] = fr >= 2 ? t2 : 0.f; }
        const f32x4 w0 = *(const f32x4*)(cw + hc), w1 = *(const f32x4*)(cw + DFF + hc), w2 = *(const f32x4*)(cw + 2 * DFF + hc), bb = *(const f32x4*)(cb + hc);
        const f32x4 gc = bb + w2 * x + w1 * p1 + w0 * p2;
        u32x2 w; w.x = pk2(gelu_tanh(gc[0]) * v[0], gelu_tanh(gc[1]) * v[1]); w.y = pk2(gelu_tanh(gc[2]) * v[2], gelu_tanh(gc[3]) * v[3]);
        *(u32x2*)(HIDm + (size_t)fr * DFF + hc) = w;
        if (fr >= 14) *(f32x4*)(GM + (size_t)(fr - 14) * DFF + hc) = x;
    }
};
__device__ __forceinline__ float gelu_fast(float x) { return x * __builtin_amdgcn_rcpf(1.f + __builtin_amdgcn_exp2f(-2.302208198f * (x + 0.044715f * x * x * x))); }
__device__ __forceinline__ void ph_ffnfix(const P& p, int l, int wv) {
    constexpr int Q = DFF / 4;
    const int tg = blockIdx.x * NT + otid(wv);
    if (tg >= Q * 128) return;
    const int c = (tg % Q) * 4, grp = tg / Q;
    const float* GH = (const float*)(p.ws + WS_GH); const float* GT = (const float*)(p.ws + WS_GT); const float* VH = (const float*)(p.ws + WS_VH); const float* GM = (const float*)(p.ws + WS_GVM);
    bf16_t* HID = (bf16_t*)(p.ws + WS_HID);
    const float* cw = p.in[22] + (size_t)l * 3 * DFF; const float* cb = p.in[23] + (size_t)l * DFF;
    f32x4 h0[4], h1[4], t0[4], t1[4], v0[4], v1[4];
#pragma unroll
    for (int k = 0; k < 4; ++k) { const int blk = grp * 4 + k;
        const float* tp0 = (blk & 63) == 0 ? GM + c : GT + ((size_t)(blk - 1) * 2 + 0) * DFF + c;
        const float* tp1 = (blk & 63) == 0 ? GM + DFF + c : GT + ((size_t)(blk - 1) * 2 + 1) * DFF + c;
        t0[k] = *(const f32x4*)tp0; t1[k] = *(const f32x4*)tp1;
        h0[k] = *(const f32x4*)(GH + ((size_t)blk * 2 + 0) * DFF + c); h1[k] = *(const f32x4*)(GH + ((size_t)blk * 2 + 1) * DFF + c);
        v0[k] = *(const f32x4*)(VH + ((size_t)blk * 2 + 0) * DFF + c); v1[k] = *(const f32x4*)(VH + ((size_t)blk * 2 + 1) * DFF + c); }
    const f32x4 w0 = *(const f32x4*)(cw + c), w1 = *(const f32x4*)(cw + DFF + c), w2 = *(const f32x4*)(cw + 2 * DFF + c), bb = *(const f32x4*)(cb + c);
#pragma unroll
    for (int k = 0; k < 4; ++k) { const int blk = grp * 4 + k;
        const f32x4 xa = bb + w2 * h0[k] + w1 * t1[k] + w0 * t0[k], xb = bb + w2 * h1[k] + w1 * h0[k] + w0 * t1[k];
        u32x2 wa; wa.x = pk2(gelu_fast(xa[0]) * v0[k][0], gelu_fast(xa[1]) * v0[k][1]); wa.y = pk2(gelu_fast(xa[2]) * v0[k][2], gelu_fast(xa[3]) * v0[k][3]);
        u32x2 wb; wb.x = pk2(gelu_fast(xb[0]) * v1[k][0], gelu_fast(xb[1]) * v1[k][1]); wb.y = pk2(gelu_fast(xb[2]) * v1[k][2], gelu_fast(xb[3]) * v1[k][3]);
        *(u32x2*)(HID + ((size_t)blk * 64 + 0) * DFF + c) = wa; *(u32x2*)(HID + ((size_t)blk * 64 + 1) * DFF + c) = wb; }
}

#define LAS __attribute__((address_space(3)))
#define XB_TMO      128
#define XB_XCNT(j)  (256  + 64 * (j))
#define XB_XSUB(j)  (1280 + 64 * (j))
#define XB_XGEN(j)  (2304 + 64 * (j))
#define XB_TOP      3328
#define XB_TOPGEN   3392
#define XCD_BAR_WORDS 3456
#define XB_SPIN_CAP (1u << 22)
__device__ __forceinline__ unsigned xb_ld(unsigned* p)              { return __hip_atomic_load(p, __ATOMIC_RELAXED, __HIP_MEMORY_SCOPE_AGENT); }
__device__ __forceinline__ unsigned xb_add(unsigned* p, unsigned v) { return __hip_atomic_fetch_add(p, v, __ATOMIC_RELAXED, __HIP_MEMORY_SCOPE_AGENT); }
__device__ __forceinline__ unsigned xb_xcc_id() { return (unsigned)__builtin_amdgcn_s_getreg((3 << 11) | 20) & 0xFu; }
#define XB_SPIN(cond, bar) do { unsigned _sp = 0; while (cond) { __builtin_amdgcn_s_sleep(1); \
    if ((++_sp & 255u) == 0u) { if (xb_ld(&(bar)[XB_TMO])) break; if (_sp > XB_SPIN_CAP) { atomicAdd(&(bar)[XB_TMO], 1u); break; } } } } while (0)
struct XcdBarrier { unsigned* bar; unsigned x; volatile LAS unsigned* st; };
__device__ __forceinline__ XcdBarrier xcd_barrier_post(unsigned* bar, volatile LAS unsigned* st) {
    XcdBarrier b; b.bar = bar; b.x = xb_xcc_id(); b.st = st;
    if (threadIdx.x == 0) (void)xb_add(&bar[XB_XCNT(b.x)], 1u);
    return b;
}
__device__ __forceinline__ void xcd_barrier_complete(unsigned* bar, unsigned x, unsigned& nloc, unsigned& nx) {
    const unsigned G = gridDim.x * gridDim.y * gridDim.z;
    unsigned sum, cnt, mine, sp = 0u;
    for (;;) {
        sum = 0u; cnt = 0u; mine = 0u;
#pragma unroll
        for (unsigned j = 0; j < 16; ++j) { const unsigned c = xb_ld(&bar[XB_XCNT(j)]); sum += c; cnt += (c > 0u) ? 1u : 0u; mine = (j == x) ? c : mine; }
        if (sum == G) break;
        __builtin_amdgcn_s_sleep(1);
        if ((++sp & 255u) == 0u) { if (xb_ld(&bar[XB_TMO])) break; if (sp > XB_SPIN_CAP) { atomicAdd(&bar[XB_TMO], 1u); break; } }
    }
    nloc = mine > 0u ? mine : 1u; nx = cnt > 0u ? cnt : 1u;
}
template <bool FILL>
__device__ __forceinline__ void xcd_barrier(const XcdBarrier& b, int wv, const P* pp = nullptr, unsigned char* ldsf = nullptr, int fk = -1) {
    const bool t0 = otid(wv) == 0;
    asm volatile("s_waitcnt vmcnt(0)" ::: "memory");
    __syncthreads();
    if (FILL && wv != 0) fill_item(*pp, ldsf, fk, wv);
    if (t0) {
        unsigned* bar = b.bar;
        __builtin_amdgcn_s_waitcnt(0);
        unsigned nloc = b.st[0], nx = b.st[1];
        if (nloc == 0u) { xcd_barrier_complete(bar, b.x, nloc, nx); b.st[0] = nloc; b.st[1] = nx; }
        const unsigned old = xb_add(&bar[XB_XSUB(b.x)], 1u);
        const unsigned gen = old / nloc;
        if (old + 1u == (gen + 1u) * nloc) {
            __builtin_amdgcn_fence(__ATOMIC_RELEASE, "agent");
            asm volatile("s_waitcnt vmcnt(0)" ::: "memory");
            const unsigned og = xb_add(&bar[XB_TOP], 1u);
            const unsigned tg = og / nx;
            if (og + 1u == (tg + 1u) * nx) xb_add(&bar[XB_TOPGEN], 1u);
            else XB_SPIN(xb_ld(&bar[XB_TOPGEN]) == tg, bar);
            __builtin_amdgcn_fence(__ATOMIC_ACQUIRE, "agent");
            xb_add(&bar[XB_XGEN(b.x)], 1u);
            asm volatile("s_waitcnt vmcnt(0)" ::: "memory");
        } else {
            XB_SPIN(xb_ld(&bar[XB_XGEN(b.x)]) == gen, bar);
            __builtin_amdgcn_fence(__ATOMIC_ACQUIRE, "agent");
            asm volatile("s_waitcnt vmcnt(0)" ::: "memory");
        }
    }
    __syncthreads();
}

constexpr int LDS_BYTES = 147456;
constexpr int MISC_OFF = 131072 + 320;
constexpr size_t CTL_ZERO_BYTES = 512 << 10;

__global__ void __launch_bounds__(NT, 2) mk_fwd(P p) {
    extern __shared__ __attribute__((aligned(16))) unsigned char lds[];
    volatile LAS unsigned* MISC = (volatile LAS unsigned*)((LAS unsigned char*)lds + MISC_OFF);
    const int wv = __builtin_amdgcn_readfirstlane(threadIdx.x >> 6);
    if (threadIdx.x < 32) MISC[threadIdx.x] = 0u;
    __syncthreads();
    { unsigned* bp0_ = (unsigned*)p.ws; asm volatile("" : "+s"(bp0_)); (void)xcd_barrier_post(bp0_, MISC + 8); }
#define GRID_BAR() do { XcdBarrier b_; unsigned* bp_ = (unsigned*)p.ws; asm volatile("" : "+s"(bp_)); b_.bar = bp_; b_.x = xb_xcc_id(); b_.st = MISC + 8; xcd_barrier<false>(b_, wv); } while (0)
#define GRID_BAR_FILL(k) do { XcdBarrier b_; unsigned* bp_ = (unsigned*)p.ws; asm volatile("" : "+s"(bp_)); b_.bar = bp_; b_.x = xb_xcc_id(); b_.st = MISC + 8; xcd_barrier<true>(b_, wv, &p, lds, (k)); } while (0)
    unsigned char* ws = p.ws;
    bf16_t* U = (bf16_t*)(ws + WS_U); bf16_t* Um = (bf16_t*)(ws + WS_META + M_U);
    bf16_t* YC = (bf16_t*)(ws + WS_YC); bf16_t* YCm = (bf16_t*)(ws + WS_META + M_YC);
    float* Hm = (float*)(ws + WS_META + M_H); float* Ym = (float*)(ws + WS_META + M_Y);
    const float* rc = (const float*)(ws + WS_ROPEC); const float* rs = (const float*)(ws + WS_ROPES);

    ph_prologue(p, lds, wv);
    GRID_BAR();
#pragma unroll 1
    for (int l = 0; l < DEPTH; ++l) {
        unsigned char* wb = ws + WS_W + l * W_LAYER;
        const bf16_t* Win = (const bf16_t*)(wb + OFF_WIN); const bf16_t* Wout = (const bf16_t*)(wb + OFF_WOUT); const bf16_t* Wup = (const bf16_t*)(wb + OFF_WUP); const bf16_t* Wdn = (const bf16_t*)(wb + OFF_WDN);
        { int wv2 = wv; asm volatile("" : "+s"(wv2)); unsigned char* wsl = ws; asm volatile("" : "+s"(wsl));
          meta_gemm(Um, Win, INW, DM, EpiWin{(bf16_t*)(wsl + WS_META + M_ZB), rc, rs, (const float*)(wsl + WS_META + M_RS), 1, 0}, lds, wv2); }
        { pg8::Gemm g{U, Win, MR, INW, DM}; pg8::StaticOrder S; S.init(MR, INW, (int)gridDim.x, (int)blockIdx.x);
          pg8::EpiWinPg E{(bf16_t*)(ws + WS_ZB), rc, rs, (const float*)(ws + WS_RS)};
          pg8::gemm_phase<pg8::EpiWinPg, pg8::StaticOrder, true, true>((PG8_LAS unsigned char*)lds, g, S, E, wv); }
        GRID_BAR_FILL(l == 0 ? 0 : -1);
        lru::phase<0>(p, l, lds, wv);
        ph_lru(p, l, lds, wv);
        GRID_BAR_FILL(l == 0 ? 1 : -1);
        att::phase(p, l, lds, wv);
        ph_attn_meta(p, l, lds, wv);
        __syncthreads();
        lru::phase<1>(p, l, lds, wv);
        ph_lrunorm(p, l, wv);
        GRID_BAR_FILL(l == 0 ? 2 : -1);
        meta_gemm(YCm, Wout, DM, DM, EpiF32{Ym, DM, 0}, lds, wv);
        { pg8::Gemm g{YC, Wout, MR, DM, DM}; pg8::StaticOrder S; S.init(MR, DM, (int)gridDim.x, (int)blockIdx.x);
          pg8::EpiBf16<0> E{(bf16_t*)(ws + WS_YB1), DM, nullptr, 0, 0, 1.f};
          pg8::gemm_phase<pg8::EpiBf16<0>, pg8::StaticOrder, true, true>((PG8_LAS unsigned char*)lds, g, S, E, wv); }
        GRID_BAR_FILL(l == 0 ? 3 : -1);
        ph_meta_norm(Ym, l == 0 ? p.in[1] : Hm, Hm, p.in[3] + l * DM, (float*)(ws + WS_META + M_RS), Um, wv);
        ph_normres2((const bf16_t*)(ws + WS_YB1), U, p.in[3] + l * DM, (float*)(ws + WS_RS), nullptr, wv);
        GRID_BAR_FILL(l == 0 ? 4 : -1);
        meta_gemm(Um, Wup, 2 * DFF, DM, EpiUpMeta{(bf16_t*)(ws + WS_META + M_HID), (float*)(ws + WS_GVM), p.in[22] + (size_t)l * 3 * DFF, p.in[23] + (size_t)l * DFF, (const float*)(ws + WS_META + M_RS)}, lds, wv);
        { pg8::Gemm g{U, Wup, MR, 2 * DFF, DM}; pg8::StaticOrder S; S.init(MR, 2 * DFF, (int)gridDim.x, (int)blockIdx.x);
          pg8::EpiUpPg E{(bf16_t*)(ws + WS_HID), p.in[22] + (size_t)l * 3 * DFF, p.in[23] + (size_t)l * DFF, (float*)(ws + WS_GH), (float*)(ws + WS_GT), (float*)(ws + WS_VH), (const float*)(ws + WS_RS)};
          pg8::gemm_phase<pg8::EpiUpPg, pg8::StaticOrder, true, true>((PG8_LAS unsigned char*)lds, g, S, E, wv); }
        GRID_BAR_FILL(l == 0 ? 5 : -1);
        ph_ffnfix(p, l, wv);
        GRID_BAR_FILL(l == 0 ? 6 : -1);
        meta_gemm((const bf16_t*)(ws + WS_META + M_HID), Wdn, DM, DFF, EpiF32{Ym, DM, 0}, lds, wv);
        { pg8::Gemm g{(const bf16_t*)(ws + WS_HID), Wdn, MR, DM, DFF}; pg8::StaticOrder S; S.init(MR, DM, (int)gridDim.x, (int)blockIdx.x);
          pg8::EpiBf16<0> E{(bf16_t*)(ws + WS_YB2), DM, nullptr, 0, 0, 1.f};
          pg8::gemm_phase<pg8::EpiBf16<0>, pg8::StaticOrder, true, true>((PG8_LAS unsigned char*)lds, g, S, E, wv); }
        GRID_BAR();
        if (l + 1 < DEPTH) ph_meta_norm(Ym, Hm, Hm, p.in[5] + l * DM, (float*)(ws + WS_META + M_RS), Um, wv);
        ph_normres2((const bf16_t*)(ws + WS_YB2), U, p.in[5] + l * DM, (float*)(ws + WS_RS), l + 1 < DEPTH ? nullptr : p.out, wv);
        if (l + 1 < DEPTH) GRID_BAR();
    }
}

extern "C" void kernel_launch(void* const* d_in, const int* in_sizes, int n_in, void* d_out, int out_size, void* d_ws, size_t ws_size, hipStream_t stream) {
    static int grid = 0;
    if (grid == 0) {
        if (n_in != 25 || ws_size < WS_END) { fprintf(stderr, "kernel_launch: unexpected n_in %d or ws_size %zu\n", n_in, ws_size); grid = -1; return; }
        int dev = 0, cus = 0, per_cu = 0;
        hipGetDevice(&dev);
        hipDeviceGetAttribute(&cus, hipDeviceAttributeMultiprocessorCount, dev);
        if (hipFuncSetAttribute((const void*)mk_fwd, hipFuncAttributeMaxDynamicSharedMemorySize, LDS_BYTES) != hipSuccess) { fprintf(stderr, "kernel_launch: hipFuncSetAttribute failed\n"); grid = -1; return; }
        hipOccupancyMaxActiveBlocksPerMultiprocessor(&per_cu, (const void*)mk_fwd, NT, LDS_BYTES);
        (void)hipGetLastError();
        if (per_cu < 1) { fprintf(stderr, "kernel_launch: occupancy query says %d blocks/CU\n", per_cu); per_cu = 1; }
        if (cus != 256) { fprintf(stderr, "kernel_launch: built for 256 CUs (one 256x256 unit per workgroup in the fused-norm GEMM phases), device has %d\n", cus); grid = -1; return; }
        grid = cus;
    }
    if (grid < 0) return;
    hipMemsetAsync(d_ws, 0, CTL_ZERO_BYTES, stream);
    P p{};
    for (int i = 0; i < 25; ++i) p.in[i] = (const float*)d_in[i];
    p.out = (float*)d_out; p.ws = (unsigned char*)d_ws;
    void* args[] = {&p};
    hipError_t e = hipLaunchCooperativeKernel((const void*)mk_fwd, dim3(grid), dim3(NT), args, LDS_BYTES, stream);
    if (e != hipSuccess) fprintf(stderr, "kernel_launch: cooperative launch failed: %s (grid %d)\n", hipGetErrorString(e), grid);
}
```
